# Optimizing an MI355X kernel written in HIP

```python
import jax, jax.numpy as jnp
from jax import lax
import numpy as np

D_MODEL = 1024
BATCH = 32
SEQ = 256
DEPTH = 4
DEC_BATCH = 2
DEC_SEQ = 1024
PAST_LEN = 256

GRID_W = 64
D_SSM = 1024
HEAD_DIM_SSM = 64
N_HEADS_SSM = D_SSM // HEAD_DIM_SSM
N_GROUPS_SSM = 4
D_STATE = 128
D_CONV = 5
SSD_CHUNK = 128
CONV_DIM = D_SSM + 2 * N_GROUPS_SSM * D_STATE
D_GMLP = 1024
N_GROUPS_GMLP = 8
GMLP_GROUP_DIM = D_GMLP // N_GROUPS_GMLP
GMLP_CHUNK = 128
IN_SIZES = (CONV_DIM, D_SSM, 2 * N_HEADS_SSM, D_GMLP, D_GMLP, D_GMLP, D_MODEL, D_MODEL)
D_IN = CONV_DIM + D_SSM + 2 * N_HEADS_SSM + 3 * D_GMLP + 2 * D_MODEL
EPS = 1e-6

kernel_name = 'hybrid_ssd_gmlp_diffusion_step'


def _split_points(sizes):
    pts, acc = [], 0
    for s in sizes[:-1]:
        acc += s
        pts.append(acc)
    return pts


def rms_norm(x, w):
    xf = x.astype(jnp.float32)
    y = xf * lax.rsqrt(jnp.mean(xf * xf, axis=-1, keepdims=True) + EPS)
    return (y * w.astype(jnp.float32)).astype(x.dtype)


def layer_norm(x, w, b):
    xf = x.astype(jnp.float32)
    mu = jnp.mean(xf, axis=-1, keepdims=True)
    xc = xf - mu
    y = xc * lax.rsqrt(jnp.mean(xc * xc, axis=-1, keepdims=True) + EPS)
    return (y * w.astype(jnp.float32) + b.astype(jnp.float32)).astype(x.dtype)


def _dwconv(x, w, b):
    y = lax.conv_general_dilated(x, w[:, None, :], window_strides=(1,), padding='SAME',
                                 dimension_numbers=('NWC', 'WIO', 'NWC'),
                                 feature_group_count=x.shape[-1])
    return y + b


def _grid_to_col_major(t, rows):
    b, l = t.shape[:2]
    rest = t.shape[2:]
    return t.reshape((b, rows, GRID_W) + rest).swapaxes(1, 2).reshape((b, l) + rest)


def _col_major_to_grid(t, rows):
    b, l = t.shape[:2]
    rest = t.shape[2:]
    return t.reshape((b, GRID_W, rows) + rest).swapaxes(1, 2).reshape((b, l) + rest)


def _segsum(a):
    cs = jnp.cumsum(a, axis=-1)
    diff = cs[..., :, None] - cs[..., None, :]
    t = a.shape[-1]
    mask = jnp.tril(jnp.ones((t, t), dtype=bool))
    return jnp.where(mask, diff, -jnp.inf)


def _ssd_scan(x, dt, a, b_mat, c_mat, h0):
    bsz, l, h, p = x.shape
    n = b_mat.shape[-1]
    rep = h // b_mat.shape[2]
    nc = l // SSD_CHUNK
    bh = jnp.repeat(b_mat, rep, axis=2).reshape(bsz, nc, SSD_CHUNK, h, n)
    chh = jnp.repeat(c_mat, rep, axis=2).reshape(bsz, nc, SSD_CHUNK, h, n)
    xc = (x * dt[..., None]).reshape(bsz, nc, SSD_CHUNK, h, p)
    a_dt = (dt * a).reshape(bsz, nc, SSD_CHUNK, h).transpose(0, 3, 1, 2)
    a_cum = jnp.cumsum(a_dt, axis=-1)
    lmat = jnp.exp(_segsum(a_dt))
    y_diag = jnp.einsum('bclhn,bcshn,bhcls,bcshp->bclhp', chh, bh, lmat, xc)
    decay_states = jnp.exp(a_cum[..., -1:] - a_cum)
    states = jnp.einsum('bcshn,bhcs,bcshp->bchpn', bh, decay_states, xc)
    states = jnp.concatenate([h0[:, None], states], axis=1)
    chunk_decay = jnp.exp(_segsum(jnp.pad(a_cum[..., -1], ((0, 0), (0, 0), (1, 0)))))
    new_states = jnp.einsum('bhzc,bchpn->bzhpn', chunk_decay, states)
    states_in, final = new_states[:, :-1], new_states[:, -1]
    y_off = jnp.einsum('bclhn,bchpn,bhcl->bclhp', chh, states_in, jnp.exp(a_cum))
    return (y_diag + y_off).reshape(bsz, l, h, p), final


def _ssd_branch(xbc_raw, dt_raw, z, h0, conv_w, conv_b, dt_bias, a_log, d_skip, ssm_norm_w, rows):
    col_major = rows is not None
    if col_major:
        xbc_raw = _grid_to_col_major(xbc_raw, rows)
        dt_raw = _grid_to_col_major(dt_raw, rows)
    xbc = jax.nn.silu(_dwconv(xbc_raw, conv_w, conv_b))
    bsz, l, _ = xbc.shape
    xs, bm, cm = jnp.split(xbc, [D_SSM, D_SSM + N_GROUPS_SSM * D_STATE], axis=-1)
    f32 = jnp.float32
    xs = xs.reshape(bsz, l, N_HEADS_SSM, HEAD_DIM_SSM).astype(f32)
    bm = bm.reshape(bsz, l, N_GROUPS_SSM, D_STATE).astype(f32)
    cm = cm.reshape(bsz, l, N_GROUPS_SSM, D_STATE).astype(f32)
    dt = jax.nn.softplus(dt_raw.astype(f32).reshape(bsz, l, 2, N_HEADS_SSM) + dt_bias.astype(f32))
    a = -jnp.exp(a_log.astype(f32))
    h0 = h0.astype(f32)
    y_f, h_f = _ssd_scan(xs, dt[:, :, 0], a[0], bm, cm, h0[:, 0])
    y_b, h_b = _ssd_scan(jnp.flip(xs, 1), jnp.flip(dt[:, :, 1], 1), a[1],
                         jnp.flip(bm, 1), jnp.flip(cm, 1), h0[:, 1])
    y = y_f + jnp.flip(y_b, 1) + d_skip.astype(f32)[:, None] * xs
    y = y.reshape(bsz, l, D_SSM).astype(z.dtype)
    if col_major:
        y = _col_major_to_grid(y, rows)
    y = rms_norm(y * jax.nn.silu(z), ssm_norm_w)
    return y, jnp.stack([h_f, h_b], axis=1)


def _gmlp_branch(u_raw, v_raw, z, ln_w, ln_b, w_sp, b_sp):
    u = jax.nn.gelu(u_raw)
    v = layer_norm(jax.nn.gelu(v_raw), ln_w, ln_b)
    bsz, l, _ = v.shape
    vg = v.reshape(bsz, l // GMLP_CHUNK, GMLP_CHUNK, N_GROUPS_GMLP, GMLP_GROUP_DIM)
    s = jnp.einsum('gts,bnsgc->bntgc', w_sp, vg) + b_sp.T[None, None, :, :, None]
    return u * s.reshape(bsz, l, D_GMLP) * jax.nn.silu(z)


def _layer(x, mod, h0, lw, rows):
    (w_in, norm_w, conv_w, conv_b, dt_bias, a_log, d_skip, ssm_norm_w, w_out_m,
     sgu_ln_w, sgu_ln_b, w_sp, b_sp, w_out_g, w_out) = lw
    shift, scale, gate = jnp.split(mod, 3, axis=-1)
    h = rms_norm(x, norm_w) * (1 + scale[:, None]) + shift[:, None]
    proj = h @ w_in
    xbc_raw, z_m, dt_raw, u_raw, v_raw, z_g, gl_m, gl_g = jnp.split(
        proj, _split_points(IN_SIZES), axis=-1)
    y_m, h_fin = _ssd_branch(xbc_raw, dt_raw, z_m, h0, conv_w, conv_b, dt_bias, a_log,
                             d_skip, ssm_norm_w, rows)
    y_g = _gmlp_branch(u_raw, v_raw, z_g, sgu_ln_w, sgu_ln_b, w_sp, b_sp)
    merged = jax.nn.sigmoid(gl_m) * (y_m @ w_out_m) + jax.nn.sigmoid(gl_g) * (y_g @ w_out_g)
    return x + gate[:, None] * (merged @ w_out), h_fin


def setup_inputs(seed: int = 0) -> dict:
    key = jax.random.key(seed)
    ks = jax.random.split(key, 24)
    nrm = jax.random.normal
    f32 = jnp.float32
    dt_lo = CONV_DIM + D_SSM
    dt_hi = dt_lo + 2 * N_HEADS_SSM
    w_in = nrm(ks[5], (DEPTH, D_MODEL, D_IN), f32) * D_MODEL ** -0.5
    w_in = w_in.at[:, :, dt_lo:dt_hi].multiply(0.1)
    dt_init = jnp.exp(jax.random.uniform(ks[8], (DEPTH, 2, N_HEADS_SSM), f32,
                                         np.log(1e-3), np.log(1e-1)))
    dt_bias = dt_init + jnp.log(-jnp.expm1(-dt_init))
    return {
        'x_prompt': nrm(ks[0], (BATCH, SEQ, D_MODEL), f32),
        'x_sample': nrm(ks[1], (DEC_BATCH, DEC_SEQ, D_MODEL), f32),
        'state_ssm': 0.5 * nrm(ks[2], (DEC_BATCH, DEPTH, 2, N_HEADS_SSM, HEAD_DIM_SSM, D_STATE), f32),
        'c': nrm(ks[3], (DEC_BATCH, D_MODEL), f32),
        'c_ctx': nrm(ks[4], (D_MODEL,), f32),
        'w_ada': nrm(ks[6], (DEPTH, D_MODEL, 3 * D_MODEL), f32) * 0.5 * D_MODEL ** -0.5,
        'b_ada': 0.01 * nrm(ks[7], (DEPTH, 3 * D_MODEL), f32),
        'norm_w': 1.0 + 0.1 * nrm(ks[9], (DEPTH, D_MODEL), f32),
        'w_in': w_in,
        'conv_w': nrm(ks[10], (DEPTH, D_CONV, CONV_DIM), f32) * D_CONV ** -0.5,
        'conv_b': 0.01 * nrm(ks[11], (DEPTH, CONV_DIM), f32),
        'dt_bias': dt_bias,
        'a_log': jnp.log(jax.random.uniform(ks[12], (DEPTH, 2, N_HEADS_SSM), f32, 1.0, 16.0)),
        'd_skip': 1.0 + 0.1 * nrm(ks[13], (DEPTH, N_HEADS_SSM), f32),
        'ssm_norm_w': 1.0 + 0.1 * nrm(ks[14], (DEPTH, D_SSM), f32),
        'w_out_m': nrm(ks[15], (DEPTH, D_SSM, D_MODEL), f32) * D_SSM ** -0.5,
        'sgu_ln_w': 1.0 + 0.1 * nrm(ks[16], (DEPTH, D_GMLP), f32),
        'sgu_ln_b': 0.1 * nrm(ks[17], (DEPTH, D_GMLP), f32),
        'w_sp': nrm(ks[18], (DEPTH, N_GROUPS_GMLP, GMLP_CHUNK, GMLP_CHUNK), f32) * GMLP_CHUNK ** -0.5,
        'b_sp': 1.0 + 0.1 * nrm(ks[19], (DEPTH, N_GROUPS_GMLP, GMLP_CHUNK), f32),
        'w_out_g': nrm(ks[20], (DEPTH, D_GMLP, D_MODEL), f32) * D_GMLP ** -0.5,
        'w_out': nrm(ks[21], (DEPTH, D_MODEL, D_MODEL), f32) * D_MODEL ** -0.5,
        'final_norm_w': 1.0 + 0.1 * nrm(ks[22], (D_MODEL,), f32),
    }


def reference(x_prompt, x_sample, state_ssm, c, c_ctx, w_ada, b_ada, norm_w, w_in, conv_w,
              conv_b, dt_bias, a_log, d_skip, ssm_norm_w, w_out_m, sgu_ln_w, sgu_ln_b,
              w_sp, b_sp, w_out_g, w_out, final_norm_w):
    rows = x_sample.shape[1] // GRID_W
    h_ctx = x_prompt
    h_lat = x_sample
    h0_ctx = jnp.zeros((x_prompt.shape[0], 2, N_HEADS_SSM, HEAD_DIM_SSM, D_STATE), jnp.float32)
    silu_c = jax.nn.silu(c)
    silu_cctx = jax.nn.silu(c_ctx)[None, :]
    ctx_states = []
    for i in range(DEPTH):
        lw = (w_in[i], norm_w[i], conv_w[i], conv_b[i], dt_bias[i], a_log[i], d_skip[i],
              ssm_norm_w[i], w_out_m[i], sgu_ln_w[i], sgu_ln_b[i], w_sp[i], b_sp[i],
              w_out_g[i], w_out[i])
        mod_ctx = silu_cctx @ w_ada[i] + b_ada[i]
        mod_lat = silu_c @ w_ada[i] + b_ada[i]
        h_ctx, st = _layer(h_ctx, mod_ctx, h0_ctx, lw, None)
        ctx_states.append(st.astype(x_prompt.dtype))
        h_lat, _ = _layer(h_lat, mod_lat, state_ssm[:, i], lw, rows if i % 2 == 1 else None)
    new_state_ssm = jnp.stack(ctx_states, axis=1)
    y_prompt = rms_norm(h_ctx, final_norm_w)
    y_sample = rms_norm(h_lat, final_norm_w)
    return (y_prompt, y_sample, new_state_ssm)
```

```cpp
#include <hip/hip_runtime.h>
#include <cstdio>
#include <cstdint>
namespace pg8 {
#define PG8_LAS __attribute__((address_space(3)))
typedef unsigned short bf16_t;
typedef short bf16x8 __attribute__((ext_vector_type(8)));
typedef float f32x4 __attribute__((ext_vector_type(4)));
typedef unsigned u32x4 __attribute__((ext_vector_type(4)));
constexpr int BM = 256, BK = 64, HALF = 128, HTB = HALF * BK * 2  , STAGE_BYTES = 8 * HTB, NXCD = 8, WGM = 8;

__host__ __device__ __forceinline__ int lds_byte(int r, int c) { const int st = (r >> 4) * 2 + (c >> 5), rr = r & 15, cc = c & 31, ob = rr * 64 + cc * 2; return st * 1024 + (ob ^ (((ob >> 9) & 1) << 5)); }
__host__ __device__ __forceinline__ void stage_rc(int b, int& R, int& C) { const int st = b / 1024, sb = b % 1024, swz = sb ^ (((sb >> 9) & 1) << 5); R = (st >> 1) * 16 + swz / 64; C = (st & 1) * 32 + (swz % 64) / 2; }
__host__ __device__ __forceinline__ int perm32(int rho) { const int n = rho >> 4, i = rho & 15; return 8 * (i >> 2) + 4 * n + (i & 3); }

struct Unit { int pm, pn; };
struct Gemm { const bf16_t* A; const bf16_t* Bt; int M, N, K; };

struct StaticOrder {
    int nM, nN, nwg, G, c;
    __host__ __device__ void init(int M, int N, int G_, int c_) { nM = M / BM; nN = N / BM; nwg = nM * nN; G = G_; c = c_; }
    __host__ __device__ bool next(int i, Unit& u) const {
        const long L = (long)i * G + c; if (L >= nwg) return false;
        int wgid = (int)L; { const int q = nwg / NXCD, r = nwg % NXCD, xcd = wgid % NXCD, off = wgid / NXCD; wgid = (xcd < r ? xcd * (q + 1) : r * (q + 1) + (xcd - r) * q) + off; }
        const int nig = WGM * nN, gid = wgid / nig, fm = gid * WGM, gsz = (nM - fm) < WGM ? (nM - fm) : WGM;
        u.pm = fm + ((wgid % nig) % gsz); u.pn = (wgid % nig) / gsz; return true;
    }
    __device__ __forceinline__ void a_ready(const Unit&) const {}
    __device__ __forceinline__ void done(const Unit&) const {}
};

__device__ __forceinline__ unsigned cvt_pk_bf16(float lo, float hi) { unsigned r; asm volatile("v_cvt_pk_bf16_f32 %0, %1, %2" : "=v"(r) : "v"(lo), "v"(hi)); return r; }
typedef float f32x2 __attribute__((ext_vector_type(2)));
__device__ __forceinline__ f32x2 gelu_pk(f32x2 v) {
    const f32x2 av = __builtin_elementwise_abs(v), d = av * 0.2316418882f + 1.0f;
    f32x2 t; t.x = __builtin_amdgcn_rcpf(d.x); t.y = __builtin_amdgcn_rcpf(d.y);
    f32x2 q = t * 0.5307027145f + (-0.7265760135f); q = q * t + 0.7107068705f; q = q * t + (-0.142248368f); q = q * t + 0.127414796f; q = q * t;
    const f32x2 s = (v * v) * (-0.72134752044f);
    f32x2 e; e.x = __builtin_amdgcn_exp2f(s.x); e.y = __builtin_amdgcn_exp2f(s.y);
    const f32x2 m = v * (q * e), r = v - m;
    f32x2 o; o.x = v.x < 0.f ? m.x : r.x; o.y = v.y < 0.f ? m.y : r.y; return o;
}

template <int ACT  > struct EpiBf16 {
    static constexpr bool PERM = true, AFTER_DRAIN = false; static_assert(ACT == 0 || ACT == 1, "EpiBf16: ACT is 0 (none) or 1 (gelu_pk)");
    bf16_t* O; int ldc; const float* bias; int split_cols; size_t split_stride; float scale0;
    __device__ __forceinline__ void operator()(const f32x4 (&acc)[2][2][4][2], const Unit& u, int wr, int wc, int fr, int fq) const {
        const int row0 = u.pm * BM + wr * 64 + fr; int colt = u.pn * BM; bf16_t* base = O;
        float sc = 1.f; if (split_cols) { const int t = colt / split_cols; base += (size_t)t * split_stride; colt -= t * split_cols; if (t == 0) sc = scale0; }
        const int col0 = colt + wc * 32 + 8 * fq, bcol0 = u.pn * BM + wc * 32 + 8 * fq;
        f32x4 bv[2][2];
#pragma unroll
        for (int bj = 0; bj < 2; ++bj)
#pragma unroll
            for (int n = 0; n < 2; ++n) bv[bj][n] = bias ? *(const f32x4*)(bias + bcol0 + bj * HALF + 4 * n) : (f32x4){0.f, 0.f, 0.f, 0.f};
#pragma unroll
        for (int ai = 0; ai < 2; ++ai)
#pragma unroll
            for (int m = 0; m < 4; ++m) { bf16_t* rowp = base + (size_t)(row0 + ai * HALF + m * 16) * ldc + col0;
#pragma unroll
                for (int bj = 0; bj < 2; ++bj) { f32x4 v0 = acc[ai][bj][m][0] + bv[bj][0], v1 = acc[ai][bj][m][1] + bv[bj][1];
                    if (ACT == 1) { f32x2 a = gelu_pk((f32x2){v0[0], v0[1]}), b = gelu_pk((f32x2){v0[2], v0[3]}), c = gelu_pk((f32x2){v1[0], v1[1]}), d = gelu_pk((f32x2){v1[2], v1[3]});
                        v0 = (f32x4){a.x, a.y, b.x, b.y}; v1 = (f32x4){c.x, c.y, d.x, d.y}; }
                    v0 = v0 * sc; v1 = v1 * sc; u32x4 w; w.x = cvt_pk_bf16(v0[0], v0[1]); w.y = cvt_pk_bf16(v0[2], v0[3]); w.z = cvt_pk_bf16(v1[0], v1[1]); w.w = cvt_pk_bf16(v1[2], v1[3]);
                    *(u32x4*)(rowp + bj * HALF) = w; } }
    }
};
struct EpiF32 {
    static constexpr bool PERM = false, AFTER_DRAIN = false;
    float* C; int ldc; const float* bias;
    __device__ __forceinline__ void operator()(const f32x4 (&acc)[2][2][4][2], const Unit& u, int wr, int wc, int fr, int fq) const {
        const int row0 = u.pm * BM + wr * 64 + fr, col0 = u.pn * BM + wc * 32 + 4 * fq;
        f32x4 bv[2][2];
#pragma unroll
        for (int bj = 0; bj < 2; ++bj)
#pragma unroll
            for (int n = 0; n < 2; ++n) bv[bj][n] = bias ? *(const f32x4*)(bias + col0 + bj * HALF + n * 16) : (f32x4){0.f, 0.f, 0.f, 0.f};
#pragma unroll
        for (int ai = 0; ai < 2; ++ai)
#pragma unroll
            for (int m = 0; m < 4; ++m) { float* rowp = C + (size_t)(row0 + ai * HALF + m * 16) * ldc + col0;
#pragma unroll
                for (int bj = 0; bj < 2; ++bj)
#pragma unroll
                    for (int n = 0; n < 2; ++n) *(f32x4*)(rowp + bj * HALF + n * 16) = acc[ai][bj][m][n] + bv[bj][n]; }
    }
};
template <class Epi, class Sched, bool ALIGN_EPI = false, bool SP2 = false>
__device__ __forceinline__ void gemm_phase(PG8_LAS unsigned char* lds, const Gemm g, const Sched& S, const Epi& E) {
    const int tid = threadIdx.x, wid = __builtin_amdgcn_readfirstlane(tid >> 6), lane = tid & 63, wr = wid >> 2, wc = wid & 3, fr = lane & 15, fq = lane >> 4;
    const int K = g.K, nt = K / BK;
    unsigned voffA[2], voffB[2];
#pragma unroll
    for (int i = 0; i < 2; ++i) { int R, C; stage_rc(tid * 16 + i * 8192, R, C); const int Rb = Epi::PERM ? ((R & ~31) + perm32(R & 31)) : R;
        voffA[i] = (unsigned)(R * K + C) * 2u; voffB[i] = (unsigned)(Rb * K + C) * 2u; }
    const size_t kstep = (size_t)(BK * 2);
    const size_t hstep = (size_t)HALF * K * 2;
    const size_t tstep = 2 * hstep;
    const unsigned ldsw = (unsigned)wid * 1024u;
    const int aoff = lds_byte(wr * 64 + fr, fq * 8), boff = lds_byte(wc * 32 + fr, fq * 8);
#define PG8_SA(b, h) (((b) * 2 + (h)) * HTB)
#define PG8_SB(b, h) ((4 + (b) * 2 + (h)) * HTB)
#define PG8_STAGE(bufoff, gbase, voff) do { _Pragma("unroll") for (int _i = 0; _i < 2; ++_i) \
        __builtin_amdgcn_global_load_lds((const unsigned*)((const char*)(gbase) + (voff)[_i]), (PG8_LAS unsigned*)(lds + (bufoff) + ldsw + _i * 8192), 16, 0, 0); } while (0)
#define PG8_LDA(dst, b, h) do { _Pragma("unroll") for (int m = 0; m < 4; ++m) _Pragma("unroll") for (int k = 0; k < 2; ++k) dst[m][k] = *(const PG8_LAS bf16x8*)(lds + PG8_SA(b, h) + aoff + m * 2048 + k * 1024); } while (0)
#define PG8_LDB(dst, b, h) do { _Pragma("unroll") for (int n = 0; n < 2; ++n) _Pragma("unroll") for (int k = 0; k < 2; ++k) dst[n][k] = *(const PG8_LAS bf16x8*)(lds + PG8_SB(b, h) + boff + n * 2048 + k * 1024); } while (0)
#define PG8_MMA(ai, bj, At, Bt) do { __builtin_amdgcn_s_setprio(1); _Pragma("unroll") for (int m = 0; m < 4; ++m) _Pragma("unroll") for (int n = 0; n < 2; ++n) _Pragma("unroll") for (int k = 0; k < 2; ++k) \
        acc[ai][bj][m][n] = __builtin_amdgcn_mfma_f32_16x16x32_bf16(Bt[n][k], At[m][k], acc[ai][bj][m][n], 0, 0, 0); __builtin_amdgcn_s_setprio(0); } while (0)
#define PG8_WAIT_V(n) asm volatile("s_waitcnt vmcnt(" #n ")" ::: "memory")
#define PG8_WAIT_L(n) asm volatile("s_waitcnt lgkmcnt(" #n ")" ::: "memory")
#define PG8_BAR __builtin_amdgcn_s_barrier()
#define PG8_SCHED __builtin_amdgcn_sched_barrier(0)
    Unit cur, nxt; int ui = 0;
    if (!S.next(0, cur)) return;
    f32x4 acc[2][2][4][2];
#pragma unroll
    for (int a = 0; a < 2; ++a)
#pragma unroll
        for (int b = 0; b < 2; ++b)
#pragma unroll
            for (int m = 0; m < 4; ++m)
#pragma unroll
                for (int n = 0; n < 2; ++n) acc[a][b][m][n] = (f32x4){0.f, 0.f, 0.f, 0.f};
    bf16x8 At[4][2], B0[2][2], B1[2][2];
    const char* cA = (const char*)g.A + (size_t)cur.pm * tstep; const char* cB = (const char*)g.Bt + (size_t)cur.pn * tstep;
    S.a_ready(cur);
    if constexpr (SP2) {
        PG8_STAGE(PG8_SB(0, 0), cB, voffB); PG8_STAGE(PG8_SB(0, 1), cB + hstep, voffB); PG8_STAGE(PG8_SA(0, 0), cA, voffA); PG8_STAGE(PG8_SA(0, 1), cA + hstep, voffA);
        if (wr == 1) PG8_BAR;
        PG8_WAIT_V(2); PG8_BAR;
        PG8_STAGE(PG8_SB(1, 0), cB + kstep, voffB); PG8_STAGE(PG8_SA(1, 0), cA + kstep, voffA); PG8_STAGE(PG8_SB(1, 1), cB + hstep + kstep, voffB);
        PG8_WAIT_V(6); PG8_BAR;
    } else {
        PG8_STAGE(PG8_SB(0, 0), cB, voffB); PG8_STAGE(PG8_SA(0, 0), cA, voffA); PG8_STAGE(PG8_SB(0, 1), cB + hstep, voffB); PG8_STAGE(PG8_SA(0, 1), cA + hstep, voffA);
        if (wr == 1) PG8_BAR;
        PG8_WAIT_V(4); PG8_BAR;
        PG8_STAGE(PG8_SB(1, 0), cB + kstep, voffB); PG8_STAGE(PG8_SA(1, 0), cA + kstep, voffA); PG8_STAGE(PG8_SB(1, 1), cB + hstep + kstep, voffB);
        PG8_WAIT_V(6); PG8_BAR;
    }
    for (;;) {
        const bool has_next = S.next(ui + 1, nxt);
        const char* nA = has_next ? (const char*)g.A + (size_t)nxt.pm * tstep : cA; const char* nB = has_next ? (const char*)g.Bt + (size_t)nxt.pn * tstep : cB;
        for (int t = 0; t < nt; t += 2) {
            const bool last = (t == nt - 2);
            const char* a1 = cA + (size_t)(t + 1) * kstep;
            const char* a2 = last ? nA : cA + (size_t)(t + 2) * kstep; const char* b2 = last ? nB : cB + (size_t)(t + 2) * kstep;
            const char* a3 = a2 + kstep; const char* b3 = b2 + kstep;
            if (last && has_next) S.a_ready(nxt);
            if constexpr (SP2) {
            PG8_LDB(B0, 0, 0); PG8_LDB(B1, 0, 1); PG8_SCHED; PG8_LDA(At, 0, 0); PG8_STAGE(PG8_SA(1, 1), a1 + hstep, voffA);
            PG8_WAIT_V(8); PG8_WAIT_L(0); PG8_BAR; PG8_MMA(0, 0, At, B0); PG8_MMA(0, 1, At, B1); PG8_BAR; PG8_SCHED;
            PG8_LDA(At, 0, 1); PG8_STAGE(PG8_SB(0, 0), b2, voffB); PG8_STAGE(PG8_SB(0, 1), b2 + hstep, voffB); PG8_STAGE(PG8_SA(0, 0), a2, voffA);
            PG8_WAIT_V(8); PG8_WAIT_L(0); PG8_BAR; PG8_MMA(1, 0, At, B0); PG8_MMA(1, 1, At, B1); PG8_BAR; PG8_SCHED;
            PG8_LDB(B0, 1, 0); PG8_LDB(B1, 1, 1); PG8_SCHED; PG8_LDA(At, 1, 0); PG8_STAGE(PG8_SA(0, 1), a2 + hstep, voffA);
            PG8_WAIT_V(8); PG8_WAIT_L(0); PG8_BAR; PG8_MMA(0, 0, At, B0); PG8_MMA(0, 1, At, B1); PG8_BAR; PG8_SCHED;
            PG8_LDA(At, 1, 1); PG8_STAGE(PG8_SB(1, 0), b3, voffB); PG8_STAGE(PG8_SB(1, 1), b3 + hstep, voffB); PG8_STAGE(PG8_SA(1, 0), a3, voffA);
            PG8_WAIT_V(8); PG8_WAIT_L(0); PG8_BAR; PG8_MMA(1, 0, At, B0); PG8_MMA(1, 1, At, B1); PG8_BAR; PG8_SCHED;
            } else {
            PG8_LDB(B0, 0, 0); PG8_SCHED; PG8_LDA(At, 0, 0); PG8_STAGE(PG8_SA(1, 1), a1 + hstep, voffA);
            PG8_WAIT_L(8); PG8_BAR; PG8_WAIT_L(0); PG8_MMA(0, 0, At, B0); PG8_BAR; PG8_SCHED;
            PG8_LDB(B1, 0, 1); PG8_STAGE(PG8_SB(0, 0), b2, voffB);
            PG8_BAR; PG8_WAIT_L(0); PG8_MMA(0, 1, At, B1); PG8_BAR;
            PG8_LDA(At, 0, 1); PG8_STAGE(PG8_SA(0, 0), a2, voffA);
            PG8_BAR; PG8_WAIT_L(0); PG8_MMA(1, 0, At, B0); PG8_BAR; PG8_SCHED;
            PG8_STAGE(PG8_SB(0, 1), b2 + hstep, voffB);
            PG8_WAIT_V(6); PG8_BAR; PG8_MMA(1, 1, At, B1); PG8_BAR;
            PG8_LDB(B0, 1, 0); PG8_SCHED; PG8_LDA(At, 1, 0); PG8_STAGE(PG8_SA(0, 1), a2 + hstep, voffA);
            PG8_WAIT_L(8); PG8_BAR; PG8_WAIT_L(0); PG8_MMA(0, 0, At, B0); PG8_BAR; PG8_SCHED;
            PG8_LDB(B1, 1, 1); PG8_STAGE(PG8_SB(1, 0), b3, voffB);
            PG8_BAR; PG8_WAIT_L(0); PG8_MMA(0, 1, At, B1); PG8_BAR;
            PG8_LDA(At, 1, 1); PG8_STAGE(PG8_SA(1, 0), a3, voffA);
            PG8_BAR; PG8_WAIT_L(0); PG8_MMA(1, 0, At, B0); PG8_BAR; PG8_SCHED;
            PG8_STAGE(PG8_SB(1, 1), b3 + hstep, voffB);
            PG8_WAIT_V(6); PG8_BAR; PG8_MMA(1, 1, At, B1); PG8_BAR;
            }
        }
        if constexpr (ALIGN_EPI) { if (wr == 0) PG8_BAR; }
        if constexpr (!Epi::AFTER_DRAIN) { E(acc, cur, wr, wc, fr, fq); S.done(cur); }
        if (!has_next) break;
#pragma unroll
        for (int a = 0; a < 2; ++a)
#pragma unroll
            for (int b = 0; b < 2; ++b)
#pragma unroll
                for (int m = 0; m < 4; ++m)
#pragma unroll
                    for (int n = 0; n < 2; ++n) acc[a][b][m][n] = (f32x4){0.f, 0.f, 0.f, 0.f};
        cur = nxt; cA = nA; cB = nB; ++ui;
        if constexpr (ALIGN_EPI) { if (wr == 1) PG8_BAR; }
    }
    PG8_WAIT_V(0);
    if constexpr (!ALIGN_EPI) { if (wr == 0) PG8_BAR; }
    PG8_BAR;
    if constexpr (Epi::AFTER_DRAIN) { E.fused(acc, cur, wr, wc, fr, fq, lds, wid, lane); S.done(cur); }
#undef PG8_SA
#undef PG8_SB
#undef PG8_STAGE
#undef PG8_LDA
#undef PG8_LDB
#undef PG8_MMA
#undef PG8_WAIT_V
#undef PG8_WAIT_L
#undef PG8_BAR
#undef PG8_SCHED
}
}

#define DEV __device__ __forceinline__
#define LAS __attribute__((address_space(3)))
typedef unsigned short bf16;
typedef float f32x4 __attribute__((ext_vector_type(4)));
typedef unsigned u32x4 __attribute__((ext_vector_type(4)));
typedef unsigned u32x2 __attribute__((ext_vector_type(2)));

constexpr int D = 1024, NTOK = 10240, NCTX = 8192, DEPTH = 4, NH = 16, HP = 64, NGRP = 4, NST = 128, DIN = 8224;
constexpr int NPROJ = 8192;
constexpr int NCHUNK = 80;
constexpr float EPS = 1e-6f;
constexpr int PC_XBC = 0, PC_ZM = 2048, PC_U = 3072, PC_V = 4096, PC_ZG = 5120, PC_GLM = 6144, PC_GLG = 7168;

constexpr size_t MiB = 1u << 20;
constexpr size_t WS_CTL = 0;
constexpr size_t WS_MOD = 1 * MiB;
constexpr size_t WS_GST = WS_MOD + 256 * 1024;
constexpr size_t WS_ATOT = WS_GST + 128 * 1024;
constexpr size_t WS_DTRAW = 2 * MiB;
constexpr size_t WS_DTV = 4 * MiB;
constexpr size_t WS_WIN = 6 * MiB;
constexpr size_t WS_WM = WS_WIN + 64 * MiB;
constexpr size_t WS_WG = WS_WM + 8 * MiB;
constexpr size_t WS_WO = WS_WG + 8 * MiB;
constexpr size_t WS_HBUF = WS_WO + 8 * MiB;
constexpr size_t WS_AG = WS_HBUF + 20 * MiB;
constexpr size_t WS_PROJ = WS_AG + 20 * MiB;
constexpr size_t WS_XBUF = WS_PROJ + 160 * MiB;
constexpr size_t WS_XBCS = WS_XBUF + 40 * MiB;
constexpr size_t WS_ST = WS_XBCS + 40 * MiB;
constexpr size_t WS_YA = WS_ST + 80 * MiB;
constexpr size_t WS_END = WS_YA + 40 * MiB;

constexpr int LDS_BYTES = 155648;

DEV float bf2f(unsigned v) { return __uint_as_float(v << 16); }
DEV unsigned f2bf(float f) { unsigned u = __float_as_uint(f); return (u + 0x7fffu + ((u >> 16) & 1u)) >> 16; }
DEV unsigned pk2(float lo, float hi) { return f2bf(lo) | (f2bf(hi) << 16); }
DEV float sigmoid_f(float x) { return 1.f / (1.f + __expf(-x)); }
DEV float silu_f(float x) { return x / (1.f + __expf(-x)); }
DEV float gelu_f(float x) { return x * sigmoid_f(1.5957691216f * (x + 0.044715f * x * x * x)); }
DEV float softplus_f(float x) { return x > 20.f ? x : log1pf(__expf(x)); }
DEV float wave_sum(float v) {
#pragma unroll
    for (int o = 1; o < 64; o <<= 1) v += __shfl_xor(v, o);
    return v;
}

struct Args { const float* in[23]; float* out; unsigned char* ws; int step_lo, step_hi; };

struct Frame {
    LAS unsigned char* lds;
    int tid, lane, wave, G, bid;
    const float* const* in;
    float* out; unsigned char* ws;
};
#define IN_XP 0
#define IN_XS 1
#define IN_STATE 2
#define IN_C 3
#define IN_CCTX 4
#define IN_WADA 5
#define IN_BADA 6
#define IN_NORMW 7
#define IN_WIN 8
#define IN_CONVW 9
#define IN_CONVB 10
#define IN_DTBIAS 11
#define IN_ALOG 12
#define IN_DSKIP 13
#define IN_SSMNW 14
#define IN_WOUTM 15
#define IN_LNW 16
#define IN_LNB 17
#define IN_WSP 18
#define IN_BSP 19
#define IN_WOUTG 20
#define IN_WOUT 21
#define IN_FNW 22

DEV int scan_to_row(int sr, int layer) {
    if (sr < NCTX || !(layer & 1)) return sr;
    const int lb = (sr - NCTX) >> 10, q = (sr - NCTX) & 1023;
    return NCTX + lb * 1024 + (q & 15) * 64 + (q >> 4);
}

DEV void ph_mod(Frame& F) {
    LAS float* sc = (LAS float*)F.lds;
    for (int i = F.tid; i < 3 * 1024; i += 512) { const int v = i >> 10, k = i & 1023; const float c = v == 0 ? F.in[IN_CCTX][k] : F.in[IN_C][(v - 1) * 1024 + k]; sc[i] = silu_f(c); }
    __syncthreads();
    float* mod = (float*)(F.ws + WS_MOD);
    for (int it = F.bid * 512 + F.tid; it < DEPTH * 3072; it += F.G * 512) {
        const int l = it / 3072, j = it % 3072;
        const float* w = F.in[IN_WADA] + (size_t)l * 1024 * 3072 + j;
        float a0 = 0.f, a1 = 0.f, a2 = 0.f;
        for (int k = 0; k < 1024; ++k) { const float wv = w[(size_t)k * 3072]; a0 += sc[k] * wv; a1 += sc[1024 + k] * wv; a2 += sc[2048 + k] * wv; }
        const float b = F.in[IN_BADA][l * 3072 + j];
        mod[(l * 3 + 0) * 3072 + j] = a0 + b; mod[(l * 3 + 1) * 3072 + j] = a1 + b; mod[(l * 3 + 2) * 3072 + j] = a2 + b;
    }
}

DEV void cvt_item(const float* W, int ldw, int k0, int n0, bf16* WT, int K, int drow0, LAS float* scr, int lane) {
#pragma unroll 8
    for (int i = 0; i < 32; ++i) { const int kk = 2 * i + (lane >> 5); scr[kk * 33 + (lane & 31)] = W[(size_t)(k0 + kk) * ldw + n0 + (lane & 31)]; }
    asm volatile("s_waitcnt lgkmcnt(0)" ::: "memory");
    const int c = lane & 7;
#pragma unroll
    for (int j = 0; j < 4; ++j) { const int n = (lane >> 3) + 8 * j; const LAS float* s = scr + (8 * c) * 33 + n;
        u32x4 o; o.x = pk2(s[0 * 33], s[1 * 33]); o.y = pk2(s[2 * 33], s[3 * 33]); o.z = pk2(s[4 * 33], s[5 * 33]); o.w = pk2(s[6 * 33], s[7 * 33]);
        *(u32x4*)(WT + (size_t)(drow0 + n) * K + k0 + 8 * c) = o; }
    asm volatile("s_waitcnt lgkmcnt(0)" ::: "memory");
}
DEV void ph_cvt(Frame& F) {
    LAS float* scr = (LAS float*)(F.lds + F.wave * 16384);
    const int gw = F.bid * 8 + F.wave, NGW = F.G * 8;
    constexpr int I_IN = 16 * 256, I_O = 16 * 32, PER_L = I_IN + 3 * I_O;
    for (int it = gw; it < DEPTH * PER_L; it += NGW) {
        const int l = it / PER_L; int r = it % PER_L;
        if (r < I_IN) { const int kb = r >> 8, e = r & 255, nb = e < 96 ? e : e + 1;
            cvt_item(F.in[IN_WIN] + (size_t)l * 1024 * DIN, DIN, 64 * kb, 32 * nb, (bf16*)(F.ws + WS_WIN) + (size_t)l * NPROJ * 1024, 1024, 32 * e, scr, F.lane); continue; }
        r -= I_IN;
        const int which = r / I_O; r %= I_O; const int kb = r >> 5, nb = r & 31;
        const float* W = (which == 0 ? F.in[IN_WOUTM] : which == 1 ? F.in[IN_WOUTG] : F.in[IN_WOUT]) + (size_t)l * 1024 * 1024;
        bf16* WT = (bf16*)(F.ws + (which == 0 ? WS_WM : which == 1 ? WS_WG : WS_WO)) + (size_t)l * 1024 * 1024;
        cvt_item(W, 1024, 64 * kb, 32 * nb, WT, 1024, 32 * nb, scr, F.lane);
    }
}

DEV const float* x_row(Frame& F, int layer, int row) {
    if (layer == 0) return row < NCTX ? F.in[IN_XP] + (size_t)row * D : F.in[IN_XS] + (size_t)(row - NCTX) * D;
    return (const float*)(F.ws + WS_XBUF) + (size_t)row * D;
}
DEV void ph_prep(Frame& F, int layer) {
    const int gw = F.bid * 8 + F.wave, NGW = F.G * 8;
    const float* nw = F.in[IN_NORMW] + layer * D;
    const float* wdt = F.in[IN_WIN] + (size_t)layer * 1024 * DIN + 3072;
    for (int row = gw; row < NTOK; row += NGW) {
        const int mv = row < NCTX ? 0 : 1 + ((row - NCTX) >> 10);
        const float* md = (const float*)(F.ws + WS_MOD) + (layer * 3 + mv) * 3072;
        const f32x4* xr = (const f32x4*)x_row(F, layer, row) + F.lane;
        f32x4 v[4]; float s = 0.f;
#pragma unroll
        for (int j = 0; j < 4; ++j) { v[j] = xr[64 * j]; s += (v[j].x * v[j].x + v[j].y * v[j].y) + (v[j].z * v[j].z + v[j].w * v[j].w); }
        const float rstd = rsqrtf(wave_sum(s) * (1.f / D) + EPS);
        unsigned long long* o8 = (unsigned long long*)((bf16*)(F.ws + WS_HBUF) + (size_t)row * D) + F.lane;
#pragma unroll
        for (int j = 0; j < 4; ++j) { const int c0 = 4 * (F.lane + 64 * j);
            const f32x4 w4 = *(const f32x4*)(nw + c0), sh = *(const f32x4*)(md + c0), sc = *(const f32x4*)(md + 1024 + c0);
            v[j] = v[j] * rstd * w4 * (sc + 1.f) + sh;
            o8[64 * j] = (unsigned long long)pk2(v[j].x, v[j].y) | ((unsigned long long)pk2(v[j].z, v[j].w) << 32); }
        float* dtr = (float*)(F.ws + WS_DTRAW) + (size_t)row * 32;
        for (int jj = 0; jj < 32; ++jj) {
            float p = 0.f;
#pragma unroll
            for (int j = 0; j < 4; ++j) { const int c0 = 4 * (F.lane + 64 * j);
                p += v[j].x * wdt[(size_t)(c0 + 0) * DIN + jj] + v[j].y * wdt[(size_t)(c0 + 1) * DIN + jj] + v[j].z * wdt[(size_t)(c0 + 2) * DIN + jj] + v[j].w * wdt[(size_t)(c0 + 3) * DIN + jj]; }
            p = wave_sum(p);
            if (F.lane == 0) dtr[jj] = p;
        }
    }
}

DEV void ph_conv(Frame& F, int layer) {
    const bf16* proj = (const bf16*)(F.ws + WS_PROJ);
    bf16* xbcs = (bf16*)(F.ws + WS_XBCS);
    const float* cw = F.in[IN_CONVW] + layer * 5 * 2048;
    const float* cb = F.in[IN_CONVB] + layer * 2048;
    for (int it = F.bid * 512 + F.tid; it < NTOK * 256; it += F.G * 512) {
        const int sr = it >> 8, ch0 = (it & 255) * 8;
        int base, pos, L; bool cm = false;
        if (sr < NCTX) { base = sr & ~255; pos = sr & 255; L = 256; }
        else { const int lb = (sr - NCTX) >> 10; base = NCTX + lb * 1024; pos = (sr - NCTX) & 1023; L = 1024; cm = (layer & 1); }
        float acc[8];
#pragma unroll
        for (int i = 0; i < 8; ++i) acc[i] = cb[ch0 + i];
#pragma unroll
        for (int k = 0; k < 5; ++k) {
            const int q = pos + k - 2;
            if (q < 0 || q >= L) continue;
            const int tok = cm ? (q & 15) * 64 + (q >> 4) : q;
            const u32x4 raw = *(const u32x4*)(proj + (size_t)(base + tok) * NPROJ + PC_XBC + ch0);
            const float* w = cw + k * 2048 + ch0;
            acc[0] += w[0] * bf2f(raw.x & 0xffffu); acc[1] += w[1] * bf2f(raw.x >> 16);
            acc[2] += w[2] * bf2f(raw.y & 0xffffu); acc[3] += w[3] * bf2f(raw.y >> 16);
            acc[4] += w[4] * bf2f(raw.z & 0xffffu); acc[5] += w[5] * bf2f(raw.z >> 16);
            acc[6] += w[6] * bf2f(raw.w & 0xffffu); acc[7] += w[7] * bf2f(raw.w >> 16);
        }
        u32x4 o; o.x = pk2(silu_f(acc[0]), silu_f(acc[1])); o.y = pk2(silu_f(acc[2]), silu_f(acc[3])); o.z = pk2(silu_f(acc[4]), silu_f(acc[5])); o.w = pk2(silu_f(acc[6]), silu_f(acc[7]));
        *(u32x4*)(xbcs + (size_t)sr * 2048 + ch0) = o;
    }
    const float* dtr = (const float*)(F.ws + WS_DTRAW);
    float* dtv = (float*)(F.ws + WS_DTV);
    const float* dtb = F.in[IN_DTBIAS] + layer * 32;
    for (int it = F.bid * 512 + F.tid; it < NTOK * 32; it += F.G * 512) {
        const int sr = it >> 5, j = it & 31;
        dtv[it] = softplus_f(dtr[(size_t)scan_to_row(sr, layer) * 32 + j] + dtb[j]);
    }
}

DEV void chunk_tables(Frame& F, int layer, int ck, int h, LAS float* tb) {
    const float* dtv = (const float*)(F.ws + WS_DTV);
    if (F.tid < 128) {
        const float aF = -__expf(F.in[IN_ALOG][layer * 32 + h]), aB = -__expf(F.in[IN_ALOG][layer * 32 + 16 + h]);
        const float dF = dtv[(size_t)(ck * 128 + F.tid) * 32 + h], dB = dtv[(size_t)(ck * 128 + F.tid) * 32 + 16 + h];
        tb[256 + F.tid] = dF; tb[384 + F.tid] = dB; tb[F.tid] = dF * aF; tb[128 + F.tid] = dB * aB;
    }
    __syncthreads();
    if (F.tid == 0) { float s = 0.f; for (int i = 0; i < 128; ++i) { s += tb[i]; tb[i] = s; } }
    if (F.tid == 64) { float s = 0.f; for (int i = 127; i >= 0; --i) { s += tb[128 + i]; tb[128 + i] = s; } }
    __syncthreads();
}

DEV void ph_states(Frame& F, int layer) {
    LAS float* tb = (LAS float*)F.lds;
    LAS float* Xs = tb + 512;
    LAS float* Bs = Xs + 128 * 64;
    const bf16* xbcs = (const bf16*)(F.ws + WS_XBCS);
    float* ST = (float*)(F.ws + WS_ST);
    float* ATOT = (float*)(F.ws + WS_ATOT);
    for (int vb = F.bid; vb < NCHUNK * NH; vb += F.G) {
        const int ck = vb >> 4, h = vb & 15, g = h >> 2;
        __syncthreads();
        chunk_tables(F, layer, ck, h, tb);
        for (int i = F.tid; i < 128 * 64; i += 512) { const int s = i >> 6, p = i & 63; Xs[i] = bf2f(xbcs[(size_t)(ck * 128 + s) * 2048 + h * 64 + p]); }
        for (int i = F.tid; i < 128 * 128; i += 512) { const int s = i >> 7, n = i & 127; Bs[i] = bf2f(xbcs[(size_t)(ck * 128 + s) * 2048 + 1024 + g * 128 + n]); }
        __syncthreads();
        const float AF = tb[127], AB = tb[128];
        for (int o = F.tid; o < 2 * 8192; o += 512) {
            const int dir = o >> 13, p = (o >> 7) & 63, n = o & 127;
            float acc = 0.f;
            if (dir == 0) { for (int s = 0; s < 128; ++s) acc += Xs[s * 64 + p] * (tb[256 + s] * __expf(AF - tb[s])) * Bs[s * 128 + n]; }
            else          { for (int s = 0; s < 128; ++s) acc += Xs[s * 64 + p] * (tb[384 + s] * __expf(AB - tb[128 + s])) * Bs[s * 128 + n]; }
            ST[((size_t)(vb * 2 + dir)) * 8192 + p * 128 + n] = acc;
        }
        if (F.tid == 0) { ATOT[vb * 2] = AF; ATOT[vb * 2 + 1] = AB; }
    }
}

DEV void ph_pass(Frame& F, int layer) {
    float* ST = (float*)(F.ws + WS_ST);
    const float* ATOT = (const float*)(F.ws + WS_ATOT);
    for (int it = F.bid * 512 + F.tid; it < 34 * 16 * 2 * 8192; it += F.G * 512) {
        const int e = it & 8191, dir = (it >> 13) & 1, h = (it >> 14) & 15, sq = it >> 18;
        int nck, ck0; float S;
        if (sq < 32) { nck = 2; ck0 = 2 * sq; S = 0.f; }
        else { const int lb = sq - 32; nck = 8; ck0 = 64 + 8 * lb; S = F.in[IN_STATE][((size_t)((lb * 4 + layer) * 2 + dir) * 16 + h) * 8192 + e]; }
        for (int i = 0; i < nck; ++i) {
            const int c = dir == 0 ? i : nck - 1 - i;
            const size_t idx = (size_t)((ck0 + c) * 16 + h) * 2 + dir;
            const float st = ST[idx * 8192 + e];
            ST[idx * 8192 + e] = S;
            S = __expf(ATOT[idx]) * S + st;
        }
        if (sq < 32) F.out[(size_t)10485760 + ((size_t)((sq * 4 + layer) * 2 + dir) * 16 + h) * 8192 + e] = S;
    }
}

DEV void ph_y(Frame& F, int layer) {
    LAS float* tb = (LAS float*)F.lds;
    LAS float* Mm = tb + 512;
    LAS bf16* Cs = (LAS bf16*)(Mm + 128 * 128);
    LAS bf16* Bs = Cs + 128 * 128;
    LAS bf16* Xs = Bs + 128 * 128;
    const bf16* xbcs = (const bf16*)(F.ws + WS_XBCS);
    const bf16* proj = (const bf16*)(F.ws + WS_PROJ);
    const float* ST = (const float*)(F.ws + WS_ST);
    float* YA = (float*)(F.ws + WS_YA);
    for (int vb = F.bid; vb < NCHUNK * NH; vb += F.G) {
        const int ck = vb >> 4, h = vb & 15, g = h >> 2;
        __syncthreads();
        chunk_tables(F, layer, ck, h, tb);
        for (int i = F.tid; i < 128 * 128; i += 512) { const int s = i >> 7, n = i & 127;
            Bs[i] = xbcs[(size_t)(ck * 128 + s) * 2048 + 1024 + g * 128 + n]; Cs[i] = xbcs[(size_t)(ck * 128 + s) * 2048 + 1536 + g * 128 + n]; }
        for (int i = F.tid; i < 128 * 64; i += 512) { const int s = i >> 6, p = i & 63; Xs[i] = xbcs[(size_t)(ck * 128 + s) * 2048 + h * 64 + p]; }
        __syncthreads();
        const float dsk = F.in[IN_DSKIP][layer * 16 + h];
        for (int o = F.tid; o < 128 * 128; o += 512) {
            const int l = o >> 7, s = o & 127;
            float gsum = 0.f;
            for (int n = 0; n < 128; ++n) gsum += bf2f(Cs[l * 128 + n]) * bf2f(Bs[s * 128 + n]);
            float w;
            if (l > s) w = __expf(tb[l] - tb[s]) * tb[256 + s];
            else if (l < s) w = __expf(tb[128 + l] - tb[128 + s]) * tb[384 + s];
            else w = tb[256 + s] + tb[384 + s];
            Mm[o] = gsum * w + (l == s ? dsk : 0.f);
        }
        __syncthreads();
        const float* SF = ST + (size_t)(vb * 2 + 0) * 8192; const float* SB = ST + (size_t)(vb * 2 + 1) * 8192;
        for (int o = F.tid; o < 128 * 64; o += 512) {
            const int l = o >> 6, p = o & 63;
            float acc = 0.f, of = 0.f, ob = 0.f;
            for (int s = 0; s < 128; ++s) acc += Mm[l * 128 + s] * bf2f(Xs[s * 64 + p]);
            for (int n = 0; n < 128; ++n) { const float c = bf2f(Cs[l * 128 + n]); of += c * SF[p * 128 + n]; ob += c * SB[p * 128 + n]; }
            const float y = acc + __expf(tb[l]) * of + __expf(tb[128 + l]) * ob;
            const int row = scan_to_row(ck * 128 + l, layer);
            const float z = bf2f(proj[(size_t)row * NPROJ + PC_ZM + h * 64 + p]);
            YA[(size_t)row * D + h * 64 + p] = y * silu_f(z);
        }
    }
}

DEV void ph_ynorm(Frame& F, int layer) {
    const int gw = F.bid * 8 + F.wave, NGW = F.G * 8;
    const float* nw = F.in[IN_SSMNW] + layer * D;
    for (int row = gw; row < NTOK; row += NGW) {
        const f32x4* yr = (const f32x4*)((const float*)(F.ws + WS_YA) + (size_t)row * D) + F.lane;
        f32x4 v[4]; float s = 0.f;
#pragma unroll
        for (int j = 0; j < 4; ++j) { v[j] = yr[64 * j]; s += (v[j].x * v[j].x + v[j].y * v[j].y) + (v[j].z * v[j].z + v[j].w * v[j].w); }
        const float rstd = rsqrtf(wave_sum(s) * (1.f / D) + EPS);
        unsigned long long* o8 = (unsigned long long*)((bf16*)(F.ws + WS_HBUF) + (size_t)row * D) + F.lane;
#pragma unroll
        for (int j = 0; j < 4; ++j) { const f32x4 w4 = *(const f32x4*)(nw + 4 * (F.lane + 64 * j)); v[j] = v[j] * rstd * w4;
            o8[64 * j] = (unsigned long long)pk2(v[j].x, v[j].y) | ((unsigned long long)pk2(v[j].z, v[j].w) << 32); }
    }
}

DEV void ph_gstat(Frame& F, int layer) {
    const int gw = F.bid * 8 + F.wave, NGW = F.G * 8;
    const bf16* proj = (const bf16*)(F.ws + WS_PROJ);
    float* gst = (float*)(F.ws + WS_GST);
    for (int row = gw; row < NTOK; row += NGW) {
        float v[16]; float s = 0.f;
        const u32x4* pr = (const u32x4*)(proj + (size_t)row * NPROJ + PC_V) + F.lane;
#pragma unroll
        for (int j = 0; j < 2; ++j) { const u32x4 r = pr[64 * j];
            v[8 * j + 0] = gelu_f(bf2f(r.x & 0xffffu)); v[8 * j + 1] = gelu_f(bf2f(r.x >> 16)); v[8 * j + 2] = gelu_f(bf2f(r.y & 0xffffu)); v[8 * j + 3] = gelu_f(bf2f(r.y >> 16));
            v[8 * j + 4] = gelu_f(bf2f(r.z & 0xffffu)); v[8 * j + 5] = gelu_f(bf2f(r.z >> 16)); v[8 * j + 6] = gelu_f(bf2f(r.w & 0xffffu)); v[8 * j + 7] = gelu_f(bf2f(r.w >> 16)); }
#pragma unroll
        for (int i = 0; i < 16; ++i) s += v[i];
        const float mu = wave_sum(s) * (1.f / D); float q = 0.f;
#pragma unroll
        for (int i = 0; i < 16; ++i) { const float d = v[i] - mu; q += d * d; }
        const float rstd = rsqrtf(wave_sum(q) * (1.f / D) + EPS);
        if (F.lane == 0) { gst[row * 2] = mu; gst[row * 2 + 1] = rstd; }
    }
}

DEV void ph_gmlp(Frame& F, int layer) {
    LAS float* vn = (LAS float*)F.lds;
    const bf16* proj = (const bf16*)(F.ws + WS_PROJ);
    const float* gst = (const float*)(F.ws + WS_GST);
    bf16* ag = (bf16*)(F.ws + WS_AG);
    for (int vb = F.bid; vb < NCHUNK * 8; vb += F.G) {
        const int ck = vb >> 3, g = vb & 7;
        const float* lnw = F.in[IN_LNW] + layer * D + g * 128; const float* lnb = F.in[IN_LNB] + layer * D + g * 128;
        const float* wsp = F.in[IN_WSP] + (size_t)(layer * 8 + g) * 128 * 128; const float* bsp = F.in[IN_BSP] + (layer * 8 + g) * 128;
        __syncthreads();
        for (int i = F.tid; i < 128 * 128; i += 512) { const int s = i >> 7, ch = i & 127; const int row = ck * 128 + s;
            vn[i] = (gelu_f(bf2f(proj[(size_t)row * NPROJ + PC_V + g * 128 + ch])) - gst[row * 2]) * gst[row * 2 + 1] * lnw[ch] + lnb[ch]; }
        __syncthreads();
        for (int o = F.tid; o < 128 * 128; o += 512) {
            const int t = o >> 7, ch = o & 127; const int row = ck * 128 + t;
            float sv = bsp[t];
            for (int s = 0; s < 128; ++s) sv += wsp[t * 128 + s] * vn[s * 128 + ch];
            const float u = bf2f(proj[(size_t)row * NPROJ + PC_U + g * 128 + ch]), zg = bf2f(proj[(size_t)row * NPROJ + PC_ZG + g * 128 + ch]);
            ag[(size_t)row * D + g * 128 + ch] = (bf16)f2bf(gelu_f(u) * sv * silu_f(zg));
        }
    }
}

DEV void ph_merge(Frame& F) {
    const bf16* proj = (const bf16*)(F.ws + WS_PROJ);
    const float* tm = (const float*)(F.ws + WS_ST); const float* tg = tm + (size_t)NTOK * D;
    bf16* mg = (bf16*)(F.ws + WS_XBCS);
    for (size_t it = (size_t)F.bid * 512 + F.tid; it < (size_t)NTOK * D; it += (size_t)F.G * 512) {
        const size_t row = it >> 10; const int c = (int)(it & 1023);
        const float gm = bf2f(proj[row * NPROJ + PC_GLM + c]), gg = bf2f(proj[row * NPROJ + PC_GLG + c]);
        mg[it] = (bf16)f2bf(sigmoid_f(gm) * tm[it] + sigmoid_f(gg) * tg[it]);
    }
}

DEV void ph_res(Frame& F, int layer) {
    const float* to = (const float*)(F.ws + WS_YA);
    float* xb = (float*)(F.ws + WS_XBUF);
    for (size_t it = (size_t)F.bid * 512 + F.tid; it < (size_t)NTOK * D; it += (size_t)F.G * 512) {
        const int row = (int)(it >> 10), c = (int)(it & 1023);
        const int mv = row < NCTX ? 0 : 1 + ((row - NCTX) >> 10);
        const float gate = ((const float*)(F.ws + WS_MOD))[(layer * 3 + mv) * 3072 + 2048 + c];
        xb[it] = x_row(F, layer, row)[c] + gate * to[it];
    }
}

DEV void ph_final(Frame& F) {
    const int gw = F.bid * 8 + F.wave, NGW = F.G * 8;
    const float* nw = F.in[IN_FNW];
    for (int row = gw; row < NTOK; row += NGW) {
        const f32x4* xr = (const f32x4*)((const float*)(F.ws + WS_XBUF) + (size_t)row * D) + F.lane;
        f32x4 v[4]; float s = 0.f;
#pragma unroll
        for (int j = 0; j < 4; ++j) { v[j] = xr[64 * j]; s += (v[j].x * v[j].x + v[j].y * v[j].y) + (v[j].z * v[j].z + v[j].w * v[j].w); }
        const float rstd = rsqrtf(wave_sum(s) * (1.f / D) + EPS);
        f32x4* o = (f32x4*)(F.out + (size_t)row * D) + F.lane;
#pragma unroll
        for (int j = 0; j < 4; ++j) o[64 * j] = v[j] * rstd * *(const f32x4*)(nw + 4 * (F.lane + 64 * j));
    }
}

enum { S_PREP = 0, S_GEMM_IN, S_CONV, S_STATES, S_PASS, S_Y, S_YNORM, S_GSTAT, S_GMLP, S_GEMM_M, S_GEMM_G, S_MERGE, S_GEMM_O, S_RES, S_PER_LAYER, S_MOD, S_CVT, S_FINAL };

template <int K>
__global__ void __launch_bounds__(512, 2) k_phase(Args args) {
    extern __shared__ __attribute__((aligned(16))) unsigned char lds[];
    Frame F;
    F.lds = (LAS unsigned char*)lds; F.tid = threadIdx.x; F.lane = F.tid & 63; F.wave = __builtin_amdgcn_readfirstlane(F.tid >> 6);
    F.G = gridDim.x; F.bid = blockIdx.x; F.in = args.in; F.out = args.out; F.ws = args.ws;
    const int layer = args.step_lo;
    if constexpr (K == S_MOD) ph_mod(F);
    if constexpr (K == S_CVT) ph_cvt(F);
    if constexpr (K == S_FINAL) ph_final(F);
    if constexpr (K == S_PREP) ph_prep(F, layer);
    if constexpr (K == S_GEMM_IN) { pg8::Gemm g{(const bf16*)(F.ws + WS_HBUF), (const bf16*)(F.ws + WS_WIN) + (size_t)layer * NPROJ * 1024, NTOK, NPROJ, D};
        pg8::StaticOrder S; S.init(NTOK, NPROJ, F.G, F.bid);
        pg8::EpiBf16<0> E{(bf16*)(F.ws + WS_PROJ), NPROJ, nullptr, 0, 0, 1.f};
        pg8::gemm_phase<pg8::EpiBf16<0>, pg8::StaticOrder, true, true>(F.lds, g, S, E); }
    if constexpr (K == S_CONV) ph_conv(F, layer);
    if constexpr (K == S_STATES) ph_states(F, layer);
    if constexpr (K == S_PASS) ph_pass(F, layer);
    if constexpr (K == S_Y) ph_y(F, layer);
    if constexpr (K == S_YNORM) ph_ynorm(F, layer);
    if constexpr (K == S_GSTAT) ph_gstat(F, layer);
    if constexpr (K == S_GMLP) ph_gmlp(F, layer);
    if constexpr (K == S_GEMM_M || K == S_GEMM_G || K == S_GEMM_O) {
        const bf16* A = (const bf16*)(F.ws + (K == S_GEMM_M ? WS_HBUF : K == S_GEMM_G ? WS_AG : WS_XBCS));
        const bf16* Bt = (const bf16*)(F.ws + (K == S_GEMM_M ? WS_WM : K == S_GEMM_G ? WS_WG : WS_WO)) + (size_t)layer * D * D;
        float* C = (float*)(F.ws + (K == S_GEMM_O ? WS_YA : WS_ST)) + (K == S_GEMM_G ? (size_t)NTOK * D : 0);
        pg8::Gemm g{A, Bt, NTOK, D, D}; pg8::StaticOrder S; S.init(NTOK, D, F.G, F.bid);
        pg8::EpiF32 E{C, D, nullptr};
        pg8::gemm_phase<pg8::EpiF32, pg8::StaticOrder, true, true>(F.lds, g, S, E); }
    if constexpr (K == S_MERGE) ph_merge(F);
    if constexpr (K == S_RES) ph_res(F, layer);
}

template <int K> static bool launch_phase(const Args& a, int grid, hipStream_t stream) {
    static bool attr_done = false;
    if (!attr_done) { if (hipFuncSetAttribute((const void*)k_phase<K>, hipFuncAttributeMaxDynamicSharedMemorySize, LDS_BYTES) != hipSuccess) { fprintf(stderr, "hipFuncSetAttribute failed for phase %d\n", K); return false; } attr_done = true; }
    hipLaunchKernelGGL(k_phase<K>, dim3(grid), dim3(512), LDS_BYTES, stream, a);
    return true;
}

extern "C" void kernel_launch(void* const* d_in, const int* in_sizes, int n_in, void* d_out, int out_size, void* d_ws, size_t ws_size, hipStream_t stream) {
    static int grid = 0;
    if (grid == 0) {
        if (n_in != 23 || ws_size < WS_END) { fprintf(stderr, "kernel_launch: need 23 inputs and %zu bytes of workspace; got %d, %zu\n", (size_t)WS_END, n_in, ws_size); grid = -1; return; }
        int dev = 0, cus = 0;
        if (hipGetDevice(&dev) != hipSuccess || hipDeviceGetAttribute(&cus, hipDeviceAttributeMultiprocessorCount, dev) != hipSuccess) { grid = -1; return; }
        grid = cus;
    }
    if (grid < 0) return;
    Args a{};
    for (int i = 0; i < 23; ++i) a.in[i] = (const float*)d_in[i];
    a.out = (float*)d_out; a.ws = (unsigned char*)d_ws; a.step_hi = 0;
    a.step_lo = 0;
    launch_phase<S_MOD>(a, grid, stream);
    launch_phase<S_CVT>(a, grid, stream);
    for (int l = 0; l < DEPTH; ++l) {
        a.step_lo = l;
        launch_phase<S_PREP>(a, grid, stream); launch_phase<S_GEMM_IN>(a, grid, stream); launch_phase<S_CONV>(a, grid, stream); launch_phase<S_STATES>(a, grid, stream);
        launch_phase<S_PASS>(a, grid, stream); launch_phase<S_Y>(a, grid, stream); launch_phase<S_YNORM>(a, grid, stream); launch_phase<S_GSTAT>(a, grid, stream);
        launch_phase<S_GMLP>(a, grid, stream); launch_phase<S_GEMM_M>(a, grid, stream); launch_phase<S_GEMM_G>(a, grid, stream); launch_phase<S_MERGE>(a, grid, stream);
        launch_phase<S_GEMM_O>(a, grid, stream); launch_phase<S_RES>(a, grid, stream);
    }
    a.step_lo = 0;
    launch_phase<S_FINAL>(a, grid, stream);
}
```

```cpp
#include <hip/hip_runtime.h>
#include <cstdio>
#include <cstdint>
namespace pg8 {
#define PG8_LAS __attribute__((address_space(3)))
typedef unsigned short bf16_t;
typedef short bf16x8 __attribute__((ext_vector_type(8)));
typedef float f32x4 __attribute__((ext_vector_type(4)));
typedef unsigned u32x4 __attribute__((ext_vector_type(4)));
constexpr int BM = 256, BK = 64, HALF = 128, HTB = HALF * BK * 2  , STAGE_BYTES = 8 * HTB, NXCD = 8, WGM = 8;

__host__ __device__ __forceinline__ int lds_byte(int r, int c) { const int st = (r >> 4) * 2 + (c >> 5), rr = r & 15, cc = c & 31, ob = rr * 64 + cc * 2; return st * 1024 + (ob ^ (((ob >> 9) & 1) << 5)); }
__host__ __device__ __forceinline__ void stage_rc(int b, int& R, int& C) { const int st = b / 1024, sb = b % 1024, swz = sb ^ (((sb >> 9) & 1) << 5); R = (st >> 1) * 16 + swz / 64; C = (st & 1) * 32 + (swz % 64) / 2; }
__host__ __device__ __forceinline__ int perm32(int rho) { const int n = rho >> 4, i = rho & 15; return 8 * (i >> 2) + 4 * n + (i & 3); }

struct Unit { int pm, pn; };
struct Gemm { const bf16_t* A; const bf16_t* Bt; int M, N, K; };

struct StaticOrder {
    int nM, nN, nwg, G, c;
    __host__ __device__ void init(int M, int N, int G_, int c_) { nM = M / BM; nN = N / BM; nwg = nM * nN; G = G_; c = c_; }
    __host__ __device__ bool next(int i, Unit& u) const {
        const long L = (long)i * G + c; if (L >= nwg) return false;
        int wgid = (int)L; { const int q = nwg / NXCD, r = nwg % NXCD, xcd = wgid % NXCD, off = wgid / NXCD; wgid = (xcd < r ? xcd * (q + 1) : r * (q + 1) + (xcd - r) * q) + off; }
        const int nig = WGM * nN, gid = wgid / nig, fm = gid * WGM, gsz = (nM - fm) < WGM ? (nM - fm) : WGM;
        u.pm = fm + ((wgid % nig) % gsz); u.pn = (wgid % nig) / gsz; return true;
    }
    __device__ __forceinline__ void a_ready(const Unit&) const {}
    __device__ __forceinline__ void done(const Unit&) const {}
};

__device__ __forceinline__ unsigned cvt_pk_bf16(float lo, float hi) { unsigned r; asm volatile("v_cvt_pk_bf16_f32 %0, %1, %2" : "=v"(r) : "v"(lo), "v"(hi)); return r; }
typedef float f32x2 __attribute__((ext_vector_type(2)));
__device__ __forceinline__ f32x2 gelu_pk(f32x2 v) {
    const f32x2 av = __builtin_elementwise_abs(v), d = av * 0.2316418882f + 1.0f;
    f32x2 t; t.x = __builtin_amdgcn_rcpf(d.x); t.y = __builtin_amdgcn_rcpf(d.y);
    f32x2 q = t * 0.5307027145f + (-0.7265760135f); q = q * t + 0.7107068705f; q = q * t + (-0.142248368f); q = q * t + 0.127414796f; q = q * t;
    const f32x2 s = (v * v) * (-0.72134752044f);
    f32x2 e; e.x = __builtin_amdgcn_exp2f(s.x); e.y = __builtin_amdgcn_exp2f(s.y);
    const f32x2 m = v * (q * e), r = v - m;
    f32x2 o; o.x = v.x < 0.f ? m.x : r.x; o.y = v.y < 0.f ? m.y : r.y; return o;
}

template <int ACT  > struct EpiBf16 {
    static constexpr bool PERM = true, AFTER_DRAIN = false; static_assert(ACT == 0 || ACT == 1, "EpiBf16: ACT is 0 (none) or 1 (gelu_pk)");
    bf16_t* O; int ldc; const float* bias; int split_cols; size_t split_stride; float scale0;
    __device__ __forceinline__ void operator()(const f32x4 (&acc)[2][2][4][2], const Unit& u, int wr, int wc, int fr, int fq) const {
        const int row0 = u.pm * BM + wr * 64 + fr; int colt = u.pn * BM; bf16_t* base = O;
        float sc = 1.f; if (split_cols) { const int t = colt / split_cols; base += (size_t)t * split_stride; colt -= t * split_cols; if (t == 0) sc = scale0; }
        const int col0 = colt + wc * 32 + 8 * fq, bcol0 = u.pn * BM + wc * 32 + 8 * fq;
        f32x4 bv[2][2];
#pragma unroll
        for (int bj = 0; bj < 2; ++bj)
#pragma unroll
            for (int n = 0; n < 2; ++n) bv[bj][n] = bias ? *(const f32x4*)(bias + bcol0 + bj * HALF + 4 * n) : (f32x4){0.f, 0.f, 0.f, 0.f};
#pragma unroll
        for (int ai = 0; ai < 2; ++ai)
#pragma unroll
            for (int m = 0; m < 4; ++m) { bf16_t* rowp = base + (size_t)(row0 + ai * HALF + m * 16) * ldc + col0;
#pragma unroll
                for (int bj = 0; bj < 2; ++bj) { f32x4 v0 = acc[ai][bj][m][0] + bv[bj][0], v1 = acc[ai][bj][m][1] + bv[bj][1];
                    if (ACT == 1) { f32x2 a = gelu_pk((f32x2){v0[0], v0[1]}), b = gelu_pk((f32x2){v0[2], v0[3]}), c = gelu_pk((f32x2){v1[0], v1[1]}), d = gelu_pk((f32x2){v1[2], v1[3]});
                        v0 = (f32x4){a.x, a.y, b.x, b.y}; v1 = (f32x4){c.x, c.y, d.x, d.y}; }
                    v0 = v0 * sc; v1 = v1 * sc; u32x4 w; w.x = cvt_pk_bf16(v0[0], v0[1]); w.y = cvt_pk_bf16(v0[2], v0[3]); w.z = cvt_pk_bf16(v1[0], v1[1]); w.w = cvt_pk_bf16(v1[2], v1[3]);
                    *(u32x4*)(rowp + bj * HALF) = w; } }
    }
};
struct EpiF32 {
    static constexpr bool PERM = false, AFTER_DRAIN = false;
    float* C; int ldc; const float* bias;
    __device__ __forceinline__ void operator()(const f32x4 (&acc)[2][2][4][2], const Unit& u, int wr, int wc, int fr, int fq) const {
        const int row0 = u.pm * BM + wr * 64 + fr, col0 = u.pn * BM + wc * 32 + 4 * fq;
        f32x4 bv[2][2];
#pragma unroll
        for (int bj = 0; bj < 2; ++bj)
#pragma unroll
            for (int n = 0; n < 2; ++n) bv[bj][n] = bias ? *(const f32x4*)(bias + col0 + bj * HALF + n * 16) : (f32x4){0.f, 0.f, 0.f, 0.f};
#pragma unroll
        for (int ai = 0; ai < 2; ++ai)
#pragma unroll
            for (int m = 0; m < 4; ++m) { float* rowp = C + (size_t)(row0 + ai * HALF + m * 16) * ldc + col0;
#pragma unroll
                for (int bj = 0; bj < 2; ++bj)
#pragma unroll
                    for (int n = 0; n < 2; ++n) *(f32x4*)(rowp + bj * HALF + n * 16) = acc[ai][bj][m][n] + bv[bj][n]; }
    }
};
template <class Epi, class Sched, bool ALIGN_EPI = false, bool SP2 = false>
__device__ __forceinline__ void gemm_phase(PG8_LAS unsigned char* lds, const Gemm g, const Sched& S, const Epi& E) {
    int tid_ = threadIdx.x; asm volatile("" : "+v"(tid_));
    const int tid = tid_, wid = __builtin_amdgcn_readfirstlane(tid >> 6), lane = tid & 63, wr = wid >> 2, wc = wid & 3, fr = lane & 15, fq = lane >> 4;
    const int K = g.K, nt = K / BK;
    unsigned voffA[2], voffB[2];
#pragma unroll
    for (int i = 0; i < 2; ++i) { int R, C; stage_rc(tid * 16 + i * 8192, R, C); const int Rb = Epi::PERM ? ((R & ~31) + perm32(R & 31)) : R;
        voffA[i] = (unsigned)(R * K + C) * 2u; voffB[i] = (unsigned)(Rb * K + C) * 2u; }
    const size_t kstep = (size_t)(BK * 2);
    const size_t hstep = (size_t)HALF * K * 2;
    const size_t tstep = 2 * hstep;
    const unsigned ldsw = (unsigned)wid * 1024u;
    const int aoff = lds_byte(wr * 64 + fr, fq * 8), boff = lds_byte(wc * 32 + fr, fq * 8);
#define PG8_SA(b, h) (((b) * 2 + (h)) * HTB)
#define PG8_SB(b, h) ((4 + (b) * 2 + (h)) * HTB)
#define PG8_STAGE(bufoff, gbase, voff) do { _Pragma("unroll") for (int _i = 0; _i < 2; ++_i) \
        __builtin_amdgcn_global_load_lds((const unsigned*)((const char*)(gbase) + (voff)[_i]), (PG8_LAS unsigned*)(lds + (bufoff) + ldsw + _i * 8192), 16, 0, 0); } while (0)
#define PG8_LDA(dst, b, h) do { _Pragma("unroll") for (int m = 0; m < 4; ++m) _Pragma("unroll") for (int k = 0; k < 2; ++k) dst[m][k] = *(const PG8_LAS bf16x8*)(lds + PG8_SA(b, h) + aoff + m * 2048 + k * 1024); } while (0)
#define PG8_LDB(dst, b, h) do { _Pragma("unroll") for (int n = 0; n < 2; ++n) _Pragma("unroll") for (int k = 0; k < 2; ++k) dst[n][k] = *(const PG8_LAS bf16x8*)(lds + PG8_SB(b, h) + boff + n * 2048 + k * 1024); } while (0)
#define PG8_MMA(ai, bj, At, Bt) do { __builtin_amdgcn_s_setprio(1); _Pragma("unroll") for (int m = 0; m < 4; ++m) _Pragma("unroll") for (int n = 0; n < 2; ++n) _Pragma("unroll") for (int k = 0; k < 2; ++k) \
        acc[ai][bj][m][n] = __builtin_amdgcn_mfma_f32_16x16x32_bf16(Bt[n][k], At[m][k], acc[ai][bj][m][n], 0, 0, 0); __builtin_amdgcn_s_setprio(0); } while (0)
#define PG8_WAIT_V(n) asm volatile("s_waitcnt vmcnt(" #n ")" ::: "memory")
#define PG8_WAIT_L(n) asm volatile("s_waitcnt lgkmcnt(" #n ")" ::: "memory")
#define PG8_BAR __builtin_amdgcn_s_barrier()
#define PG8_SCHED __builtin_amdgcn_sched_barrier(0)
    Unit cur, nxt; int ui = 0;
    if (!S.next(0, cur)) return;
    f32x4 acc[2][2][4][2];
#pragma unroll
    for (int a = 0; a < 2; ++a)
#pragma unroll
        for (int b = 0; b < 2; ++b)
#pragma unroll
            for (int m = 0; m < 4; ++m)
#pragma unroll
                for (int n = 0; n < 2; ++n) acc[a][b][m][n] = (f32x4){0.f, 0.f, 0.f, 0.f};
    bf16x8 At[4][2], B0[2][2], B1[2][2];
    const char* cA = (const char*)g.A + (size_t)cur.pm * tstep; const char* cB = (const char*)g.Bt + (size_t)cur.pn * tstep;
    S.a_ready(cur);
    if constexpr (SP2) {
        PG8_STAGE(PG8_SB(0, 0), cB, voffB); PG8_STAGE(PG8_SB(0, 1), cB + hstep, voffB); PG8_STAGE(PG8_SA(0, 0), cA, voffA); PG8_STAGE(PG8_SA(0, 1), cA + hstep, voffA);
        if (wr == 1) PG8_BAR;
        PG8_WAIT_V(2); PG8_BAR;
        PG8_STAGE(PG8_SB(1, 0), cB + kstep, voffB); PG8_STAGE(PG8_SA(1, 0), cA + kstep, voffA); PG8_STAGE(PG8_SB(1, 1), cB + hstep + kstep, voffB);
        PG8_WAIT_V(6); PG8_BAR;
    } else {
        PG8_STAGE(PG8_SB(0, 0), cB, voffB); PG8_STAGE(PG8_SA(0, 0), cA, voffA); PG8_STAGE(PG8_SB(0, 1), cB + hstep, voffB); PG8_STAGE(PG8_SA(0, 1), cA + hstep, voffA);
        if (wr == 1) PG8_BAR;
        PG8_WAIT_V(4); PG8_BAR;
        PG8_STAGE(PG8_SB(1, 0), cB + kstep, voffB); PG8_STAGE(PG8_SA(1, 0), cA + kstep, voffA); PG8_STAGE(PG8_SB(1, 1), cB + hstep + kstep, voffB);
        PG8_WAIT_V(6); PG8_BAR;
    }
    for (;;) {
        const bool has_next = S.next(ui + 1, nxt);
        const char* nA = has_next ? (const char*)g.A + (size_t)nxt.pm * tstep : cA; const char* nB = has_next ? (const char*)g.Bt + (size_t)nxt.pn * tstep : cB;
        for (int t = 0; t < nt; t += 2) {
            const bool last = (t == nt - 2);
            const char* a1 = cA + (size_t)(t + 1) * kstep;
            const char* a2 = last ? nA : cA + (size_t)(t + 2) * kstep; const char* b2 = last ? nB : cB + (size_t)(t + 2) * kstep;
            const char* a3 = a2 + kstep; const char* b3 = b2 + kstep;
            if (last && has_next) S.a_ready(nxt);
            if constexpr (SP2) {
            PG8_LDB(B0, 0, 0); PG8_LDB(B1, 0, 1); PG8_SCHED; PG8_LDA(At, 0, 0); PG8_STAGE(PG8_SA(1, 1), a1 + hstep, voffA);
            PG8_WAIT_V(8); PG8_WAIT_L(0); PG8_BAR; PG8_MMA(0, 0, At, B0); PG8_MMA(0, 1, At, B1); PG8_BAR; PG8_SCHED;
            PG8_LDA(At, 0, 1); PG8_STAGE(PG8_SB(0, 0), b2, voffB); PG8_STAGE(PG8_SB(0, 1), b2 + hstep, voffB); PG8_STAGE(PG8_SA(0, 0), a2, voffA);
            PG8_WAIT_V(8); PG8_WAIT_L(0); PG8_BAR; PG8_MMA(1, 0, At, B0); PG8_MMA(1, 1, At, B1); PG8_BAR; PG8_SCHED;
            PG8_LDB(B0, 1, 0); PG8_LDB(B1, 1, 1); PG8_SCHED; PG8_LDA(At, 1, 0); PG8_STAGE(PG8_SA(0, 1), a2 + hstep, voffA);
            PG8_WAIT_V(8); PG8_WAIT_L(0); PG8_BAR; PG8_MMA(0, 0, At, B0); PG8_MMA(0, 1, At, B1); PG8_BAR; PG8_SCHED;
            PG8_LDA(At, 1, 1); PG8_STAGE(PG8_SB(1, 0), b3, voffB); PG8_STAGE(PG8_SB(1, 1), b3 + hstep, voffB); PG8_STAGE(PG8_SA(1, 0), a3, voffA);
            PG8_WAIT_V(8); PG8_WAIT_L(0); PG8_BAR; PG8_MMA(1, 0, At, B0); PG8_MMA(1, 1, At, B1); PG8_BAR; PG8_SCHED;
            } else {
            PG8_LDB(B0, 0, 0); PG8_SCHED; PG8_LDA(At, 0, 0); PG8_STAGE(PG8_SA(1, 1), a1 + hstep, voffA);
            PG8_WAIT_L(8); PG8_BAR; PG8_WAIT_L(0); PG8_MMA(0, 0, At, B0); PG8_BAR; PG8_SCHED;
            PG8_LDB(B1, 0, 1); PG8_STAGE(PG8_SB(0, 0), b2, voffB);
            PG8_BAR; PG8_WAIT_L(0); PG8_MMA(0, 1, At, B1); PG8_BAR;
            PG8_LDA(At, 0, 1); PG8_STAGE(PG8_SA(0, 0), a2, voffA);
            PG8_BAR; PG8_WAIT_L(0); PG8_MMA(1, 0, At, B0); PG8_BAR; PG8_SCHED;
            PG8_STAGE(PG8_SB(0, 1), b2 + hstep, voffB);
            PG8_WAIT_V(6); PG8_BAR; PG8_MMA(1, 1, At, B1); PG8_BAR;
            PG8_LDB(B0, 1, 0); PG8_SCHED; PG8_LDA(At, 1, 0); PG8_STAGE(PG8_SA(0, 1), a2 + hstep, voffA);
            PG8_WAIT_L(8); PG8_BAR; PG8_WAIT_L(0); PG8_MMA(0, 0, At, B0); PG8_BAR; PG8_SCHED;
            PG8_LDB(B1, 1, 1); PG8_STAGE(PG8_SB(1, 0), b3, voffB);
            PG8_BAR; PG8_WAIT_L(0); PG8_MMA(0, 1, At, B1); PG8_BAR;
            PG8_LDA(At, 1, 1); PG8_STAGE(PG8_SA(1, 0), a3, voffA);
            PG8_BAR; PG8_WAIT_L(0); PG8_MMA(1, 0, At, B0); PG8_BAR; PG8_SCHED;
            PG8_STAGE(PG8_SB(1, 1), b3 + hstep, voffB);
            PG8_WAIT_V(6); PG8_BAR; PG8_MMA(1, 1, At, B1); PG8_BAR;
            }
        }
        if constexpr (ALIGN_EPI) { if (wr == 0) PG8_BAR; }
        if constexpr (!Epi::AFTER_DRAIN) { E(acc, cur, wr, wc, fr, fq); S.done(cur); }
        if (!has_next) break;
#pragma unroll
        for (int a = 0; a < 2; ++a)
#pragma unroll
            for (int b = 0; b < 2; ++b)
#pragma unroll
                for (int m = 0; m < 4; ++m)
#pragma unroll
                    for (int n = 0; n < 2; ++n) acc[a][b][m][n] = (f32x4){0.f, 0.f, 0.f, 0.f};
        cur = nxt; cA = nA; cB = nB; ++ui;
        if constexpr (ALIGN_EPI) { if (wr == 1) PG8_BAR; }
    }
    PG8_WAIT_V(0);
    if constexpr (!ALIGN_EPI) { if (wr == 0) PG8_BAR; }
    PG8_BAR;
    if constexpr (Epi::AFTER_DRAIN) { E.fused(acc, cur, wr, wc, fr, fq, lds, wid, lane); S.done(cur); }
#undef PG8_SA
#undef PG8_SB
#undef PG8_STAGE
#undef PG8_LDA
#undef PG8_LDB
#undef PG8_MMA
#undef PG8_WAIT_V
#undef PG8_WAIT_L
#undef PG8_BAR
#undef PG8_SCHED
}
}

#define DEV __device__ __forceinline__
#define LAS __attribute__((address_space(3)))
typedef unsigned short bf16;
typedef float f32x4 __attribute__((ext_vector_type(4)));
typedef unsigned u32x4 __attribute__((ext_vector_type(4)));
typedef unsigned u32x2 __attribute__((ext_vector_type(2)));

constexpr int D = 1024, NTOK = 10240, NCTX = 8192, DEPTH = 4, NH = 16, HP = 64, NGRP = 4, NST = 128, DIN = 8224;
constexpr int NPROJ = 8192;
constexpr int NCHUNK = 80;
constexpr float EPS = 1e-6f;
constexpr int PC_XBC = 0, PC_ZM = 2048, PC_U = 3072, PC_V = 4096, PC_ZG = 5120, PC_GLM = 6144, PC_GLG = 7168;

constexpr size_t MiB = 1u << 20;
constexpr size_t WS_CTL = 0;
constexpr size_t WS_MOD = 1 * MiB;
constexpr size_t WS_GST = WS_MOD + 256 * 1024;
constexpr size_t WS_ATOT = WS_GST + 128 * 1024;
constexpr size_t WS_WDT = WS_ATOT + 64 * 1024;
constexpr size_t WS_DTRAW = 2 * MiB;
constexpr size_t WS_DTV = 4 * MiB;
constexpr size_t WS_WIN = 6 * MiB;
constexpr size_t WS_WM = WS_WIN + 64 * MiB;
constexpr size_t WS_WG = WS_WM + 8 * MiB;
constexpr size_t WS_WO = WS_WG + 8 * MiB;
constexpr size_t WS_HBUF = WS_WO + 8 * MiB;
constexpr size_t WS_AG = WS_HBUF + 20 * MiB;
constexpr size_t WS_PROJ = WS_AG + 20 * MiB;
constexpr size_t WS_XBUF = WS_PROJ + 160 * MiB;
constexpr size_t WS_XBCS = WS_XBUF + 40 * MiB;
constexpr size_t WS_ST = WS_XBCS + 40 * MiB;
constexpr size_t WS_YA = WS_ST + 80 * MiB;
constexpr size_t WS_END = WS_YA + 40 * MiB;

constexpr size_t CTL_SSQ = 65536;
constexpr int LDS_BYTES = 155648;

DEV float bf2f(unsigned v) { return __uint_as_float(v << 16); }
DEV unsigned f2bf(float f) { unsigned u = __float_as_uint(f); return (u + 0x7fffu + ((u >> 16) & 1u)) >> 16; }
DEV unsigned pk2(float lo, float hi) { return f2bf(lo) | (f2bf(hi) << 16); }
DEV float sigmoid_f(float x) { return 1.f / (1.f + __expf(-x)); }
DEV float silu_f(float x) { return x / (1.f + __expf(-x)); }
DEV float gelu_f(float x) { return x * sigmoid_f(1.5957691216f * (x + 0.044715f * x * x * x)); }
DEV float softplus_f(float x) { return x > 20.f ? x : log1pf(__expf(x)); }
DEV float wave_sum(float v) {
#pragma unroll
    for (int o = 1; o < 64; o <<= 1) v += __shfl_xor(v, o);
    return v;
}

struct Args { const float* in[23]; float* out; unsigned char* ws; int step_lo, step_hi; };

struct Frame {
    LAS unsigned char* lds;
    int tid, lane, wave, G, bid, z;
    const float* const* in;
    float* out; unsigned char* ws;
};
DEV Frame launder(const Frame& F0) {
    Frame F = F0;
    F.z = 0; asm volatile("" : "+s"(F.z), "+s"(F.out), "+s"(F.ws), "+s"(F.G), "+s"(F.bid), "+s"(F.wave));
    asm volatile("" : "+v"(F.tid));
    F.lane = F.tid & 63;
    return F;
}
#define IN_XP 0
#define IN_XS 1
#define IN_STATE 2
#define IN_C 3
#define IN_CCTX 4
#define IN_WADA 5
#define IN_BADA 6
#define IN_NORMW 7
#define IN_WIN 8
#define IN_CONVW 9
#define IN_CONVB 10
#define IN_DTBIAS 11
#define IN_ALOG 12
#define IN_DSKIP 13
#define IN_SSMNW 14
#define IN_WOUTM 15
#define IN_LNW 16
#define IN_LNB 17
#define IN_WSP 18
#define IN_BSP 19
#define IN_WOUTG 20
#define IN_WOUT 21
#define IN_FNW 22

DEV int scan_to_row(int sr, int layer) {
    if (sr < NCTX || !(layer & 1)) return sr;
    const int lb = (sr - NCTX) >> 10, q = (sr - NCTX) & 1023;
    return NCTX + lb * 1024 + (q & 15) * 64 + (q >> 4);
}

DEV void ph_mod(const Frame& F0) {
    Frame F = launder(F0);
    LAS float* sc = (LAS float*)F.lds;
    LAS float* part = sc + 3 * 1024;
    for (int i = F.tid; i < 3 * 1024; i += 512) { const int v = i >> 10, k = i & 1023; const float c = v == 0 ? F.in[IN_CCTX + F.z][k] : F.in[IN_C + F.z][(v - 1) * 1024 + k]; sc[i] = silu_f(c); }
    __syncthreads();
    float* mod = (float*)(F.ws + WS_MOD);
    for (int it = F.bid; it < DEPTH * 24; it += F.G) {
        const int l = it / 24, j = (it % 24) * 128 + (F.tid & 127), kq = F.tid >> 7;
        const float* w = F.in[IN_WADA + F.z] + (size_t)l * 1024 * 3072 + (size_t)(kq * 256) * 3072 + j;
        float a0 = 0.f, a1 = 0.f, a2 = 0.f;
#pragma unroll 8
        for (int k = 0; k < 256; ++k) { const float wv = w[(size_t)k * 3072]; a0 += sc[kq * 256 + k] * wv; a1 += sc[1024 + kq * 256 + k] * wv; a2 += sc[2048 + kq * 256 + k] * wv; }
        __syncthreads();
        part[(kq * 3 + 0) * 128 + (F.tid & 127)] = a0; part[(kq * 3 + 1) * 128 + (F.tid & 127)] = a1; part[(kq * 3 + 2) * 128 + (F.tid & 127)] = a2;
        __syncthreads();
        if (F.tid < 384) { const int v = F.tid >> 7, jj = F.tid & 127, col = (it % 24) * 128 + jj;
            mod[(l * 3 + v) * 3072 + col] = part[(0 * 3 + v) * 128 + jj] + part[(1 * 3 + v) * 128 + jj] + part[(2 * 3 + v) * 128 + jj] + part[(3 * 3 + v) * 128 + jj] + F.in[IN_BADA + F.z][l * 3072 + col]; }
    }
}

DEV void cvt_item(const float* W, int ldw, int k0, int n0, bf16* WT, int K, int drow0, LAS float* scr, int lane) {
#pragma unroll 8
    for (int i = 0; i < 32; ++i) { const int kk = 2 * i + (lane >> 5); scr[kk * 33 + (lane & 31)] = W[(size_t)(k0 + kk) * ldw + n0 + (lane & 31)]; }
    asm volatile("s_waitcnt lgkmcnt(0)" ::: "memory");
    const int c = lane & 7;
#pragma unroll
    for (int j = 0; j < 4; ++j) { const int n = (lane >> 3) + 8 * j; const LAS float* s = scr + (8 * c) * 33 + n;
        u32x4 o; o.x = pk2(s[0 * 33], s[1 * 33]); o.y = pk2(s[2 * 33], s[3 * 33]); o.z = pk2(s[4 * 33], s[5 * 33]); o.w = pk2(s[6 * 33], s[7 * 33]);
        *(u32x4*)(WT + (size_t)(drow0 + n) * K + k0 + 8 * c) = o; }
    asm volatile("s_waitcnt lgkmcnt(0)" ::: "memory");
}
DEV void ph_cvt(const Frame& F0) {
    Frame F = launder(F0);
    LAS float* scr = (LAS float*)(F.lds + F.wave * 16384);
    const int gw = F.bid * 8 + F.wave, NGW = F.G * 8;
    constexpr int I_IN = 16 * 257, I_O = 16 * 32, PER_L = I_IN + 3 * I_O;
    for (int it = gw; it < DEPTH * PER_L; it += NGW) {
        const int l = it / PER_L; int r = it % PER_L;
        if (r < I_IN) { const int kb = r / 257, nb = r % 257;
            if (nb == 96) cvt_item(F.in[IN_WIN + F.z] + (size_t)l * 1024 * DIN, DIN, 64 * kb, 3072, (bf16*)(F.ws + WS_WDT) + (size_t)l * 32 * 1024, 1024, 0, scr, F.lane);
            else cvt_item(F.in[IN_WIN + F.z] + (size_t)l * 1024 * DIN, DIN, 64 * kb, 32 * nb, (bf16*)(F.ws + WS_WIN) + (size_t)l * NPROJ * 1024, 1024, 32 * (nb < 96 ? nb : nb - 1), scr, F.lane);
            continue; }
        r -= I_IN;
        const int which = r / I_O; r %= I_O; const int kb = r >> 5, nb = r & 31;
        const float* W = (which == 0 ? F.in[IN_WOUTM + F.z] : which == 1 ? F.in[IN_WOUTG + F.z] : F.in[IN_WOUT + F.z]) + (size_t)l * 1024 * 1024;
        bf16* WT = (bf16*)(F.ws + (which == 0 ? WS_WM : which == 1 ? WS_WG : WS_WO)) + (size_t)l * 1024 * 1024;
        cvt_item(W, 1024, 64 * kb, 32 * nb, WT, 1024, 32 * nb, scr, F.lane);
    }
}

DEV const float* x_row(Frame& F, int layer, int row) {
    if (layer == 0) return row < NCTX ? F.in[IN_XP + F.z] + (size_t)row * D : F.in[IN_XS + F.z] + (size_t)(row - NCTX) * D;
    return (const float*)(F.ws + WS_XBUF) + (size_t)row * D;
}
DEV void ph_prep(const Frame& F0, int layer) {
    Frame F = launder(F0);
    asm volatile("" : "+s"(layer));
    const int gw = F.bid * 8 + F.wave, NGW = F.G * 8;
    const float* nw = F.in[IN_NORMW + F.z] + layer * D;
    for (int row = gw; row < NTOK; row += NGW) {
        const int mv = row < NCTX ? 0 : 1 + ((row - NCTX) >> 10);
        const float* md = (const float*)(F.ws + WS_MOD) + (layer * 3 + mv) * 3072;
        const f32x4* xr = (const f32x4*)x_row(F, layer, row) + F.lane;
        f32x4 v[4]; float s = 0.f;
#pragma unroll
        for (int j = 0; j < 4; ++j) { v[j] = xr[64 * j]; s += (v[j].x * v[j].x + v[j].y * v[j].y) + (v[j].z * v[j].z + v[j].w * v[j].w); }
        const float rstd = rsqrtf(wave_sum(s) * (1.f / D) + EPS);
        unsigned long long* o8 = (unsigned long long*)((bf16*)(F.ws + WS_HBUF) + (size_t)row * D) + F.lane;
#pragma unroll
        for (int j = 0; j < 4; ++j) { const int c0 = 4 * (F.lane + 64 * j);
            const f32x4 w4 = *(const f32x4*)(nw + c0), sh = *(const f32x4*)(md + c0), sc = *(const f32x4*)(md + 1024 + c0);
            v[j] = v[j] * rstd * w4 * (sc + 1.f) + sh;
            o8[64 * j] = (unsigned long long)pk2(v[j].x, v[j].y) | ((unsigned long long)pk2(v[j].z, v[j].w) << 32); }
    }
}

DEV void ph_conv(const Frame& F0, int layer) {
    Frame F = launder(F0);
    asm volatile("" : "+s"(layer));
    const bf16* proj = (const bf16*)(F.ws + WS_PROJ);
    bf16* xbcs = (bf16*)(F.ws + WS_XBCS);
    const float* cw = F.in[IN_CONVW + F.z] + layer * 5 * 2048;
    const float* cb = F.in[IN_CONVB + F.z] + layer * 2048;
    for (int it = F.bid * 512 + F.tid; it < NTOK * 256; it += F.G * 512) {
        const int sr = it >> 8, ch0 = (it & 255) * 8;
        int base, pos, L; bool cm = false;
        if (sr < NCTX) { base = sr & ~255; pos = sr & 255; L = 256; }
        else { const int lb = (sr - NCTX) >> 10; base = NCTX + lb * 1024; pos = (sr - NCTX) & 1023; L = 1024; cm = (layer & 1); }
        float acc[8];
#pragma unroll
        for (int i = 0; i < 8; ++i) acc[i] = cb[ch0 + i];
#pragma unroll
        for (int k = 0; k < 5; ++k) {
            const int q = pos + k - 2;
            if (q < 0 || q >= L) continue;
            const int tok = cm ? (q & 15) * 64 + (q >> 4) : q;
            const u32x4 raw = *(const u32x4*)(proj + (size_t)(base + tok) * NPROJ + PC_XBC + ch0);
            const float* w = cw + k * 2048 + ch0;
            acc[0] += w[0] * bf2f(raw.x & 0xffffu); acc[1] += w[1] * bf2f(raw.x >> 16);
            acc[2] += w[2] * bf2f(raw.y & 0xffffu); acc[3] += w[3] * bf2f(raw.y >> 16);
            acc[4] += w[4] * bf2f(raw.z & 0xffffu); acc[5] += w[5] * bf2f(raw.z >> 16);
            acc[6] += w[6] * bf2f(raw.w & 0xffffu); acc[7] += w[7] * bf2f(raw.w >> 16);
        }
        u32x4 o; o.x = pk2(silu_f(acc[0]), silu_f(acc[1])); o.y = pk2(silu_f(acc[2]), silu_f(acc[3])); o.z = pk2(silu_f(acc[4]), silu_f(acc[5])); o.w = pk2(silu_f(acc[6]), silu_f(acc[7]));
        *(u32x4*)(xbcs + (size_t)sr * 2048 + ch0) = o;
    }
    const float* dtr = (const float*)(F.ws + WS_DTRAW);
    float* dtv = (float*)(F.ws + WS_DTV);
    const float* dtb = F.in[IN_DTBIAS + F.z] + layer * 32;
    for (int it = F.bid * 512 + F.tid; it < NTOK * 32; it += F.G * 512) {
        const int sr = it >> 5, j = it & 31;
        dtv[it] = softplus_f(dtr[(size_t)scan_to_row(sr, layer) * 32 + j] + dtb[j]);
    }
}

DEV void chunk_tables(Frame& F, int layer, int ck, int h, LAS float* tb) {
    const float* dtv = (const float*)(F.ws + WS_DTV);
    if (F.tid < 128) {
        const float aF = -__expf(F.in[IN_ALOG + F.z][layer * 32 + h]), aB = -__expf(F.in[IN_ALOG + F.z][layer * 32 + 16 + h]);
        const float dF = dtv[(size_t)(ck * 128 + F.tid) * 32 + h], dB = dtv[(size_t)(ck * 128 + F.tid) * 32 + 16 + h];
        tb[256 + F.tid] = dF; tb[384 + F.tid] = dB; tb[F.tid] = dF * aF; tb[128 + F.tid] = dB * aB;
    }
    __syncthreads();
    if (F.tid == 0) { float s = 0.f; for (int i = 0; i < 128; ++i) { s += tb[i]; tb[i] = s; } }
    if (F.tid == 64) { float s = 0.f; for (int i = 127; i >= 0; --i) { s += tb[128 + i]; tb[128 + i] = s; } }
    __syncthreads();
}

DEV void ph_states(const Frame& F0, int layer) {
    Frame F = launder(F0);
    asm volatile("" : "+s"(layer));
    LAS float* tb = (LAS float*)F.lds;
    LAS float* Xs = tb + 512;
    LAS float* Bs = Xs + 128 * 64;
    const bf16* xbcs = (const bf16*)(F.ws + WS_XBCS);
    float* ST = (float*)(F.ws + WS_ST);
    float* ATOT = (float*)(F.ws + WS_ATOT);
    for (int vb = F.bid; vb < NCHUNK * NH; vb += F.G) {
        const int ck = vb >> 4, h = vb & 15, g = h >> 2;
        __syncthreads();
        chunk_tables(F, layer, ck, h, tb);
        for (int i = F.tid; i < 128 * 64; i += 512) { const int s = i >> 6, p = i & 63; Xs[i] = bf2f(xbcs[(size_t)(ck * 128 + s) * 2048 + h * 64 + p]); }
        for (int i = F.tid; i < 128 * 128; i += 512) { const int s = i >> 7, n = i & 127; Bs[i] = bf2f(xbcs[(size_t)(ck * 128 + s) * 2048 + 1024 + g * 128 + n]); }
        __syncthreads();
        const float AF = tb[127], AB = tb[128];
        for (int o = F.tid; o < 2 * 8192; o += 512) {
            const int dir = o >> 13, p = (o >> 7) & 63, n = o & 127;
            float acc = 0.f;
            if (dir == 0) { for (int s = 0; s < 128; ++s) acc += Xs[s * 64 + p] * (tb[256 + s] * __expf(AF - tb[s])) * Bs[s * 128 + n]; }
            else          { for (int s = 0; s < 128; ++s) acc += Xs[s * 64 + p] * (tb[384 + s] * __expf(AB - tb[128 + s])) * Bs[s * 128 + n]; }
            ST[((size_t)(vb * 2 + dir)) * 8192 + p * 128 + n] = acc;
        }
        if (F.tid == 0) { ATOT[vb * 2] = AF; ATOT[vb * 2 + 1] = AB; }
    }
}

DEV void ph_pass(const Frame& F0, int layer) {
    Frame F = launder(F0);
    asm volatile("" : "+s"(layer));
    float* ST = (float*)(F.ws + WS_ST);
    const float* ATOT = (const float*)(F.ws + WS_ATOT);
    for (int it = F.bid * 512 + F.tid; it < 34 * 16 * 2 * 8192; it += F.G * 512) {
        const int e = it & 8191, dir = (it >> 13) & 1, h = (it >> 14) & 15, sq = it >> 18;
        int nck, ck0; float S;
        if (sq < 32) { nck = 2; ck0 = 2 * sq; S = 0.f; }
        else { const int lb = sq - 32; nck = 8; ck0 = 64 + 8 * lb; S = F.in[IN_STATE + F.z][((size_t)((lb * 4 + layer) * 2 + dir) * 16 + h) * 8192 + e]; }
        for (int i = 0; i < nck; ++i) {
            const int c = dir == 0 ? i : nck - 1 - i;
            const size_t idx = (size_t)((ck0 + c) * 16 + h) * 2 + dir;
            const float st = ST[idx * 8192 + e];
            ST[idx * 8192 + e] = S;
            S = __expf(ATOT[idx]) * S + st;
        }
        if (sq < 32) F.out[(size_t)10485760 + ((size_t)((sq * 4 + layer) * 2 + dir) * 16 + h) * 8192 + e] = S;
    }
}

DEV void ph_y(const Frame& F0, int layer) {
    Frame F = launder(F0);
    asm volatile("" : "+s"(layer));
    LAS float* tb = (LAS float*)F.lds;
    LAS float* Mm = tb + 512;
    LAS bf16* Cs = (LAS bf16*)(Mm + 128 * 128);
    LAS bf16* Bs = Cs + 128 * 128;
    LAS bf16* Xs = Bs + 128 * 128;
    const bf16* xbcs = (const bf16*)(F.ws + WS_XBCS);
    const bf16* proj = (const bf16*)(F.ws + WS_PROJ);
    const float* ST = (const float*)(F.ws + WS_ST);
    float* YA = (float*)(F.ws + WS_YA);
    for (int vb = F.bid; vb < NCHUNK * NH; vb += F.G) {
        const int ck = vb >> 4, h = vb & 15, g = h >> 2;
        __syncthreads();
        chunk_tables(F, layer, ck, h, tb);
        for (int i = F.tid; i < 128 * 128; i += 512) { const int s = i >> 7, n = i & 127;
            Bs[i] = xbcs[(size_t)(ck * 128 + s) * 2048 + 1024 + g * 128 + n]; Cs[i] = xbcs[(size_t)(ck * 128 + s) * 2048 + 1536 + g * 128 + n]; }
        for (int i = F.tid; i < 128 * 64; i += 512) { const int s = i >> 6, p = i & 63; Xs[i] = xbcs[(size_t)(ck * 128 + s) * 2048 + h * 64 + p]; }
        __syncthreads();
        const float dsk = F.in[IN_DSKIP + F.z][layer * 16 + h];
        for (int o = F.tid; o < 128 * 128; o += 512) {
            const int l = o >> 7, s = o & 127;
            float gsum = 0.f;
            for (int n = 0; n < 128; ++n) gsum += bf2f(Cs[l * 128 + n]) * bf2f(Bs[s * 128 + n]);
            float w;
            if (l > s) w = __expf(tb[l] - tb[s]) * tb[256 + s];
            else if (l < s) w = __expf(tb[128 + l] - tb[128 + s]) * tb[384 + s];
            else w = tb[256 + s] + tb[384 + s];
            Mm[o] = gsum * w + (l == s ? dsk : 0.f);
        }
        __syncthreads();
        const float* SF = ST + (size_t)(vb * 2 + 0) * 8192; const float* SB = ST + (size_t)(vb * 2 + 1) * 8192;
        for (int o = F.tid; o < 128 * 64; o += 512) {
            const int l = o >> 6, p = o & 63;
            float acc = 0.f, of = 0.f, ob = 0.f;
            for (int s = 0; s < 128; ++s) acc += Mm[l * 128 + s] * bf2f(Xs[s * 64 + p]);
            for (int n = 0; n < 128; ++n) { const float c = bf2f(Cs[l * 128 + n]); of += c * SF[p * 128 + n]; ob += c * SB[p * 128 + n]; }
            const float y = acc + __expf(tb[l]) * of + __expf(tb[128 + l]) * ob;
            const int row = scan_to_row(ck * 128 + l, layer);
            const float z = bf2f(proj[(size_t)row * NPROJ + PC_ZM + h * 64 + p]);
            YA[(size_t)row * D + h * 64 + p] = y * silu_f(z);
        }
    }
}

DEV void ph_ynorm(const Frame& F0, int layer) {
    Frame F = launder(F0);
    asm volatile("" : "+s"(layer));
    const int gw = F.bid * 8 + F.wave, NGW = F.G * 8;
    const float* nw = F.in[IN_SSMNW + F.z] + layer * D;
    for (int row = gw; row < NTOK; row += NGW) {
        const f32x4* yr = (const f32x4*)((const float*)(F.ws + WS_YA) + (size_t)row * D) + F.lane;
        f32x4 v[4]; float s = 0.f;
#pragma unroll
        for (int j = 0; j < 4; ++j) { v[j] = yr[64 * j]; s += (v[j].x * v[j].x + v[j].y * v[j].y) + (v[j].z * v[j].z + v[j].w * v[j].w); }
        const float rstd = rsqrtf(wave_sum(s) * (1.f / D) + EPS);
        unsigned long long* o8 = (unsigned long long*)((bf16*)(F.ws + WS_HBUF) + (size_t)row * D) + F.lane;
#pragma unroll
        for (int j = 0; j < 4; ++j) { const f32x4 w4 = *(const f32x4*)(nw + 4 * (F.lane + 64 * j)); v[j] = v[j] * rstd * w4;
            o8[64 * j] = (unsigned long long)pk2(v[j].x, v[j].y) | ((unsigned long long)pk2(v[j].z, v[j].w) << 32); }
    }
}

DEV void ph_gstat(const Frame& F0, int layer) {
    Frame F = launder(F0);
    asm volatile("" : "+s"(layer));
    const int gw = F.bid * 8 + F.wave, NGW = F.G * 8;
    const bf16* proj = (const bf16*)(F.ws + WS_PROJ);
    float* gst = (float*)(F.ws + WS_GST);
    for (int row = gw; row < NTOK; row += NGW) {
        float v[16]; float s = 0.f;
        const u32x4* pr = (const u32x4*)(proj + (size_t)row * NPROJ + PC_V) + F.lane;
#pragma unroll
        for (int j = 0; j < 2; ++j) { const u32x4 r = pr[64 * j];
            v[8 * j + 0] = gelu_f(bf2f(r.x & 0xffffu)); v[8 * j + 1] = gelu_f(bf2f(r.x >> 16)); v[8 * j + 2] = gelu_f(bf2f(r.y & 0xffffu)); v[8 * j + 3] = gelu_f(bf2f(r.y >> 16));
            v[8 * j + 4] = gelu_f(bf2f(r.z & 0xffffu)); v[8 * j + 5] = gelu_f(bf2f(r.z >> 16)); v[8 * j + 6] = gelu_f(bf2f(r.w & 0xffffu)); v[8 * j + 7] = gelu_f(bf2f(r.w >> 16)); }
#pragma unroll
        for (int i = 0; i < 16; ++i) s += v[i];
        const float mu = wave_sum(s) * (1.f / D); float q = 0.f;
#pragma unroll
        for (int i = 0; i < 16; ++i) { const float d = v[i] - mu; q += d * d; }
        const float rstd = rsqrtf(wave_sum(q) * (1.f / D) + EPS);
        if (F.lane == 0) { gst[row * 2] = mu; gst[row * 2 + 1] = rstd; }
    }
}

DEV void ph_gmlp(const Frame& F0, int layer) {
    Frame F = launder(F0);
    asm volatile("" : "+s"(layer));
    LAS float* vn = (LAS float*)F.lds;
    const bf16* proj = (const bf16*)(F.ws + WS_PROJ);
    const float* gst = (const float*)(F.ws + WS_GST);
    bf16* ag = (bf16*)(F.ws + WS_AG);
    for (int vb = F.bid; vb < NCHUNK * 8; vb += F.G) {
        const int ck = vb >> 3, g = vb & 7;
        const float* lnw = F.in[IN_LNW + F.z] + layer * D + g * 128; const float* lnb = F.in[IN_LNB + F.z] + layer * D + g * 128;
        const float* wsp = F.in[IN_WSP + F.z] + (size_t)(layer * 8 + g) * 128 * 128; const float* bsp = F.in[IN_BSP + F.z] + (layer * 8 + g) * 128;
        __syncthreads();
        for (int i = F.tid; i < 128 * 128; i += 512) { const int s = i >> 7, ch = i & 127; const int row = ck * 128 + s;
            vn[i] = (gelu_f(bf2f(proj[(size_t)row * NPROJ + PC_V + g * 128 + ch])) - gst[row * 2]) * gst[row * 2 + 1] * lnw[ch] + lnb[ch]; }
        __syncthreads();
        for (int o = F.tid; o < 128 * 128; o += 512) {
            const int t = o >> 7, ch = o & 127; const int row = ck * 128 + t;
            float sv = bsp[t];
            for (int s = 0; s < 128; ++s) sv += wsp[t * 128 + s] * vn[s * 128 + ch];
            const float u = bf2f(proj[(size_t)row * NPROJ + PC_U + g * 128 + ch]), zg = bf2f(proj[(size_t)row * NPROJ + PC_ZG + g * 128 + ch]);
            ag[(size_t)row * D + g * 128 + ch] = (bf16)f2bf(gelu_f(u) * sv * silu_f(zg));
        }
    }
}

DEV void ph_merge(const Frame& F0, int layer) {
    Frame F = launder(F0);
    asm volatile("" : "+s"(layer));
    const float* SSQ = (const float*)(F.ws + WS_CTL + CTL_SSQ) + layer * NTOK;
    const bf16* proj = (const bf16*)(F.ws + WS_PROJ);
    const float* tm = (const float*)(F.ws + WS_ST); const float* tg = tm + (size_t)NTOK * D;
    bf16* mg = (bf16*)(F.ws + WS_XBCS);
    for (size_t it = (size_t)F.bid * 512 + F.tid; it < (size_t)NTOK * D; it += (size_t)F.G * 512) {
        const size_t row = it >> 10; const int c = (int)(it & 1023);
        const float gm = bf2f(proj[row * NPROJ + PC_GLM + c]), gg = bf2f(proj[row * NPROJ + PC_GLG + c]);
        mg[it] = (bf16)f2bf(sigmoid_f(gm) * rsqrtf(SSQ[row] * (1.f / D) + EPS) * tm[it] + sigmoid_f(gg) * tg[it]);
    }
}

DEV void ph_res(const Frame& F0, int layer) {
    Frame F = launder(F0);
    asm volatile("" : "+s"(layer));
    const float* to = (const float*)(F.ws + WS_YA);
    float* xb = (float*)(F.ws + WS_XBUF);
    for (size_t it = (size_t)F.bid * 512 + F.tid; it < (size_t)NTOK * D; it += (size_t)F.G * 512) {
        const int row = (int)(it >> 10), c = (int)(it & 1023);
        const int mv = row < NCTX ? 0 : 1 + ((row - NCTX) >> 10);
        const float gate = ((const float*)(F.ws + WS_MOD))[(layer * 3 + mv) * 3072 + 2048 + c];
        xb[it] = x_row(F, layer, row)[c] + gate * to[it];
    }
}

DEV void ph_final(const Frame& F0) {
    Frame F = launder(F0);
    const int gw = F.bid * 8 + F.wave, NGW = F.G * 8;
    const float* nw = F.in[IN_FNW + F.z];
    for (int row = gw; row < NTOK; row += NGW) {
        const f32x4* xr = (const f32x4*)((const float*)(F.ws + WS_XBUF) + (size_t)row * D) + F.lane;
        f32x4 v[4]; float s = 0.f;
#pragma unroll
        for (int j = 0; j < 4; ++j) { v[j] = xr[64 * j]; s += (v[j].x * v[j].x + v[j].y * v[j].y) + (v[j].z * v[j].z + v[j].w * v[j].w); }
        const float rstd = rsqrtf(wave_sum(s) * (1.f / D) + EPS);
        f32x4* o = (f32x4*)(F.out + (size_t)row * D) + F.lane;
#pragma unroll
        for (int j = 0; j < 4; ++j) o[64 * j] = v[j] * rstd * *(const f32x4*)(nw + 4 * (F.lane + 64 * j));
    }
}


typedef short bf16x8 __attribute__((ext_vector_type(8)));
typedef short s16x4 __attribute__((ext_vector_type(4)));
typedef float f32x16 __attribute__((ext_vector_type(16)));
typedef float f32x2 __attribute__((ext_vector_type(2)));
typedef __bf16 bf16x2_t __attribute__((ext_vector_type(2)));
#define MFMA32(a, b, c) __builtin_amdgcn_mfma_f32_32x32x16_bf16((a), (b), (c), 0, 0, 0)
DEV unsigned pkbf(float a, float b) { const f32x2 v = {a, b}; return __builtin_bit_cast(unsigned, __builtin_convertvector(v, bf16x2_t)); }
DEV bf16x8 pack8(float a0, float a1, float a2, float a3, float a4, float a5, float a6, float a7) {
    u32x4 p; p.x = pkbf(a0, a1); p.y = pkbf(a2, a3); p.z = pkbf(a4, a5); p.w = pkbf(a6, a7); return __builtin_bit_cast(bf16x8, p); }
DEV int crow(int r, int hh) { return (r & 3) + 8 * (r >> 2) + 4 * hh; }

struct ChunkGeo { int seq_row0, pos0, L; bool cm; };
DEV ChunkGeo chunk_geo(int ck, int layer) {
    ChunkGeo g;
    if (ck < 64) { g.seq_row0 = (ck >> 1) * 256; g.pos0 = (ck & 1) * 128; g.L = 256; g.cm = false; }
    else { const int lb = (ck - 64) >> 3; g.seq_row0 = NCTX + lb * 1024; g.pos0 = ((ck - 64) & 7) * 128; g.L = 1024; g.cm = (layer & 1) != 0; }
    return g;
}
DEV int geo_row(const ChunkGeo& g, int Q) { return g.seq_row0 + (g.cm ? (Q & 15) * 64 + (Q >> 4) : Q); }

DEV void chunk_tables2(Frame& F, int layer, const ChunkGeo& geo, int h, LAS float* tb) {
    if (F.wave < 2) {
        const int dir = F.wave;
        const float a = -__expf(F.in[IN_ALOG + F.z][layer * 32 + dir * 16 + h]);
        const float bias = F.in[IN_DTBIAS + F.z][layer * 32 + dir * 16 + h];
        const float* dtr = (const float*)(F.ws + WS_DTRAW);
        const int q0 = 2 * F.lane;
        const float d0 = softplus_f(dtr[(size_t)geo_row(geo, geo.pos0 + q0) * 32 + dir * 16 + h] + bias);
        const float d1 = softplus_f(dtr[(size_t)geo_row(geo, geo.pos0 + q0 + 1) * 32 + dir * 16 + h] + bias);
        const float a0 = d0 * a, a1 = d1 * a;
        float sc = a0 + a1, c0, c1, tot;
        if (dir == 0) {
#pragma unroll
            for (int o = 1; o < 64; o <<= 1) { const float t = __shfl_up(sc, o); if (F.lane >= o) sc += t; }
            c1 = sc; c0 = sc - a1; tot = __shfl(c1, 63);
        } else {
#pragma unroll
            for (int o = 1; o < 64; o <<= 1) { const float t = __shfl_down(sc, o); if (F.lane + o < 64) sc += t; }
            c0 = sc; c1 = sc - a0; tot = __shfl(c0, 0);
        }
        LAS float* t = tb + dir * 128 + q0;
        t[0] = c0; t[1] = c1; t[256] = d0; t[257] = d1; t[512] = __expf(c0); t[513] = __expf(c1);
        t[768] = d0 * __expf(tot - c0); t[769] = d1 * __expf(tot - c1);
    }
    __syncthreads();
}

template <int NC, int MODE>
DEV void stage_conv(Frame& F, int layer, const ChunkGeo& geo, int col0, LAS unsigned char* img0, LAS unsigned char* img1, int pitch, const LAS float* tb) {
    constexpr int CG = NC / 8, NT = CG * 32;
    if (F.tid < NT) {
        const int cg = F.tid % CG, tg = F.tid / CG, ch0 = col0 + cg * 8, q0 = tg * 4;
        const bf16* proj = (const bf16*)(F.ws + WS_PROJ);
        float x[8][8];
#pragma unroll
        for (int i = 0; i < 8; ++i) {
            const int Q = geo.pos0 + q0 - 2 + i;
            u32x4 raw = {0u, 0u, 0u, 0u};
            if (Q >= 0 && Q < geo.L) raw = *(const u32x4*)(proj + (size_t)geo_row(geo, Q) * NPROJ + PC_XBC + ch0);
            x[i][0] = bf2f(raw.x & 0xffffu); x[i][1] = bf2f(raw.x >> 16); x[i][2] = bf2f(raw.y & 0xffffu); x[i][3] = bf2f(raw.y >> 16);
            x[i][4] = bf2f(raw.z & 0xffffu); x[i][5] = bf2f(raw.z >> 16); x[i][6] = bf2f(raw.w & 0xffffu); x[i][7] = bf2f(raw.w >> 16);
        }
        const float* cw = F.in[IN_CONVW + F.z] + layer * 5 * 2048 + ch0; const float* cb = F.in[IN_CONVB + F.z] + layer * 2048 + ch0;
        float acc[4][8];
        { const f32x4 b0 = *(const f32x4*)cb, b1 = *(const f32x4*)(cb + 4);
#pragma unroll
          for (int t = 0; t < 4; ++t) { acc[t][0] = b0.x; acc[t][1] = b0.y; acc[t][2] = b0.z; acc[t][3] = b0.w; acc[t][4] = b1.x; acc[t][5] = b1.y; acc[t][6] = b1.z; acc[t][7] = b1.w; } }
#pragma unroll
        for (int k = 0; k < 5; ++k) {
            const f32x4 w0 = *(const f32x4*)(cw + k * 2048), w1 = *(const f32x4*)(cw + k * 2048 + 4);
            const float w[8] = {w0.x, w0.y, w0.z, w0.w, w1.x, w1.y, w1.z, w1.w};
#pragma unroll
            for (int t = 0; t < 4; ++t)
#pragma unroll
                for (int c = 0; c < 8; ++c) acc[t][c] += w[c] * x[t + k][c];
        }
#pragma unroll
        for (int t = 0; t < 4; ++t) {
            float v[8];
#pragma unroll
            for (int c = 0; c < 8; ++c) v[c] = silu_f(acc[t][c]);
            const int s = q0 + t;
            if (MODE == 0) {
                u32x4 o; o.x = pkbf(v[0], v[1]); o.y = pkbf(v[2], v[3]); o.z = pkbf(v[4], v[5]); o.w = pkbf(v[6], v[7]);
                *(LAS u32x4*)(img0 + s * pitch + cg * 16) = o;
            } else {
                const float sf = tb[768 + s], sb = tb[896 + s];
                u32x4 o; o.x = pkbf(v[0] * sf, v[1] * sf); o.y = pkbf(v[2] * sf, v[3] * sf); o.z = pkbf(v[4] * sf, v[5] * sf); o.w = pkbf(v[6] * sf, v[7] * sf);
                *(LAS u32x4*)(img0 + s * pitch + cg * 16) = o;
                o.x = pkbf(v[0] * sb, v[1] * sb); o.y = pkbf(v[2] * sb, v[3] * sb); o.z = pkbf(v[4] * sb, v[5] * sb); o.w = pkbf(v[6] * sb, v[7] * sb);
                *(LAS u32x4*)(img1 + s * pitch + cg * 16) = o;
            }
        }
    }
}

DEV bf16x8 tr2(const LAS unsigned char* img, int pitch, int row0, int row1, int col0, int lane) {
    const int i = lane & 15, blk = (lane >> 4) & 1;
    const int off = (i >> 2) * pitch + (col0 + 16 * blk + 4 * (i & 3)) * 2;
    const s16x4 lo = __builtin_amdgcn_ds_read_tr16_b64_v4i16((LAS s16x4*)(img + row0 * pitch + off));
    const s16x4 hi = __builtin_amdgcn_ds_read_tr16_b64_v4i16((LAS s16x4*)(img + row1 * pitch + off));
    return __builtin_shufflevector(lo, hi, 0, 1, 2, 3, 4, 5, 6, 7);
}

DEV void ph_s1(const Frame& F0, int layer) {
    Frame F = launder(F0);
    asm volatile("" : "+s"(layer));
    LAS float* tb = (LAS float*)F.lds;
    LAS unsigned char* Bi = F.lds + 4096;
    LAS unsigned char* XF = Bi + 128 * 320;
    LAS unsigned char* XB = XF + 128 * 192;
    float* ST = (float*)(F.ws + WS_ST);
    float* ATOT = (float*)(F.ws + WS_ATOT);
    const int hh = F.lane >> 5, wpi = F.wave >> 2, wni = F.wave & 3;
    for (int vb = F.bid; vb < NCHUNK * NH; vb += F.G) {
        const int ck = vb >> 4, h = vb & 15, g = h >> 2;
        const ChunkGeo geo = chunk_geo(ck, layer);
        __syncthreads();
        chunk_tables2(F, layer, geo, h, tb);
        stage_conv<128, 0>(F, layer, geo, 1024 + g * 128, Bi, Bi, 320, tb);
        stage_conv<64, 1>(F, layer, geo, h * 64, XF, XB, 192, tb);
        __syncthreads();
        f32x16 af, ab;
#pragma unroll
        for (int r = 0; r < 16; ++r) { af[r] = 0.f; ab[r] = 0.f; }
#pragma unroll
        for (int ks = 0; ks < 8; ++ks) {
            const int k0 = 16 * ks + 8 * hh;
            const bf16x8 b = tr2(Bi, 320, k0, k0 + 4, 32 * wni, F.lane);
            const bf16x8 xf = tr2(XF, 192, k0, k0 + 4, 32 * wpi, F.lane);
            const bf16x8 xb = tr2(XB, 192, k0, k0 + 4, 32 * wpi, F.lane);
            af = MFMA32(xf, b, af); ab = MFMA32(xb, b, ab);
        }
        float* o0 = ST + (size_t)(vb * 2) * 8192 + (32 * wpi) * 128 + 32 * wni + (F.lane & 31);
#pragma unroll
        for (int r = 0; r < 16; ++r) { const int p = crow(r, hh); o0[p * 128] = af[r]; o0[8192 + p * 128] = ab[r]; }
        if (F.tid == 0) { ATOT[vb * 2] = tb[127]; ATOT[vb * 2 + 1] = tb[128]; }
    }
}

DEV void ph_s2(const Frame& F0, int layer) {
    Frame F = launder(F0);
    asm volatile("" : "+s"(layer));
    LAS float* tb = (LAS float*)F.lds;
    LAS unsigned char* Ci = F.lds + 4096;
    LAS unsigned char* Bi = Ci + 128 * 272;
    LAS unsigned char* Xi = Bi + 128 * 272;
    LAS unsigned char* stg = Ci;
    const float* ST = (const float*)(F.ws + WS_ST);
    const bf16* proj = (const bf16*)(F.ws + WS_PROJ);
    bf16* AM = (bf16*)(F.ws + WS_HBUF);
    float* SSQ = (float*)(F.ws + WS_CTL + CTL_SSQ) + layer * NTOK;
    const int hh = F.lane >> 5, li = F.wave & 3, sh = F.wave >> 2, l31 = F.lane & 31;
    for (int vb = F.bid; vb < NCHUNK * NH; vb += F.G) {
        const int ck = vb >> 4, h = vb & 15, g = h >> 2;
        const ChunkGeo geo = chunk_geo(ck, layer);
        __syncthreads();
        chunk_tables2(F, layer, geo, h, tb);
        stage_conv<128, 0>(F, layer, geo, 1536 + g * 128, Ci, Ci, 272, tb);
        stage_conv<128, 0>(F, layer, geo, 1024 + g * 128, Bi, Bi, 272, tb);
        stage_conv<64, 0>(F, layer, geo, h * 64, Xi, Xi, 192, tb);
        __syncthreads();
        const float dsk = F.in[IN_DSKIP + F.z][layer * 16 + h];
        const int l = 32 * li + l31;
        bf16x8 cf[8];
#pragma unroll
        for (int ks = 0; ks < 8; ++ks) cf[ks] = *(const LAS bf16x8*)(Ci + l * 272 + (16 * ks + 8 * hh) * 2);
        const float acFl = tb[l], acBl = tb[128 + l];
        f32x16 accd[2];
#pragma unroll
        for (int r = 0; r < 16; ++r) { accd[0][r] = 0.f; accd[1][r] = 0.f; }
#pragma unroll
        for (int sj = 0; sj < 2; ++sj) {
            const int si = 2 * sh + sj;
            f32x16 gt;
#pragma unroll
            for (int r = 0; r < 16; ++r) gt[r] = 0.f;
#pragma unroll
            for (int ks = 0; ks < 8; ++ks) { const bf16x8 a = *(const LAS bf16x8*)(Bi + (32 * si + l31) * 272 + (16 * ks + 8 * hh) * 2); gt = MFMA32(a, cf[ks], gt); }
            float m[16];
#pragma unroll
            for (int r = 0; r < 16; ++r) {
                const int s = 32 * si + crow(r, hh);
                const float wf = __expf(fminf(acFl - tb[s], 0.f)) * tb[256 + s], wb = __expf(fminf(acBl - tb[128 + s], 0.f)) * tb[384 + s];
                const float w = l > s ? wf : (l < s ? wb : tb[256 + s] + tb[384 + s]);
                m[r] = gt[r] * w + (l == s ? dsk : 0.f);
            }
#pragma unroll
            for (int t = 0; t < 2; ++t) {
                const bf16x8 ma = pack8(m[8 * t], m[8 * t + 1], m[8 * t + 2], m[8 * t + 3], m[8 * t + 4], m[8 * t + 5], m[8 * t + 6], m[8 * t + 7]);
                const int r0 = 32 * si + 16 * t + 4 * hh;
#pragma unroll
                for (int pi = 0; pi < 2; ++pi) { const bf16x8 xb = tr2(Xi, 192, r0, r0 + 8, 32 * pi, F.lane); accd[pi] = MFMA32(ma, xb, accd[pi]); }
            }
        }
        const float* S = ST + (size_t)(vb * 2 + sh) * 8192;
#pragma unroll
        for (int pi = 0; pi < 2; ++pi) {
            f32x16 acco;
#pragma unroll
            for (int r = 0; r < 16; ++r) acco[r] = 0.f;
#pragma unroll
            for (int ks = 0; ks < 8; ++ks) {
                const float* sp = S + (32 * pi + l31) * 128 + 16 * ks + 8 * hh;
                const f32x4 s0 = *(const f32x4*)sp, s1 = *(const f32x4*)(sp + 4);
                const bf16x8 sb = pack8(s0.x, s0.y, s0.z, s0.w, s1.x, s1.y, s1.z, s1.w);
                acco = MFMA32(cf[ks], sb, acco);
            }
#pragma unroll
            for (int r = 0; r < 16; ++r) accd[pi][r] += tb[512 + sh * 128 + 32 * li + crow(r, hh)] * acco[r];
        }
        __syncthreads();
#pragma unroll
        for (int pi = 0; pi < 2; ++pi)
#pragma unroll
            for (int r = 0; r < 16; ++r) *(LAS float*)(stg + sh * (128 * 272) + (32 * li + crow(r, hh)) * 272 + (32 * pi + l31) * 4) = accd[pi][r];
        __syncthreads();
        const int c4 = F.lane & 15;
        const f32x4 nw = *(const f32x4*)(F.in[IN_SSMNW + F.z] + layer * D + h * 64 + 4 * c4);
#pragma unroll
        for (int v = 0; v < 4; ++v) {
            const int lr = F.wave * 16 + 4 * v + (F.lane >> 4);
            const f32x4 y0 = *(const LAS f32x4*)(stg + lr * 272 + c4 * 16), y1 = *(const LAS f32x4*)(stg + 128 * 272 + lr * 272 + c4 * 16);
            const int row = geo_row(geo, geo.pos0 + lr);
            const u32x2 zr = *(const u32x2*)(proj + (size_t)row * NPROJ + PC_ZM + h * 64 + 4 * c4);
            f32x4 y = y0 + y1;
            y.x *= silu_f(bf2f(zr.x & 0xffffu)); y.y *= silu_f(bf2f(zr.x >> 16)); y.z *= silu_f(bf2f(zr.y & 0xffffu)); y.w *= silu_f(bf2f(zr.y >> 16));
            float q = (y.x * y.x + y.y * y.y) + (y.z * y.z + y.w * y.w);
            q += __shfl_xor(q, 1); q += __shfl_xor(q, 2); q += __shfl_xor(q, 4); q += __shfl_xor(q, 8);
            if (c4 == 0) atomicAdd(SSQ + row, q);
            y = y * nw;
            u32x2 o; o.x = pkbf(y.x, y.y); o.y = pkbf(y.z, y.w);
            *(u32x2*)(AM + (size_t)row * D + h * 64 + 4 * c4) = o;
        }
    }
}

DEV void ph_gmlp2(const Frame& F0, int layer) {
    Frame F = launder(F0);
    asm volatile("" : "+s"(layer));
    LAS unsigned char* Vi = F.lds;
    LAS unsigned char* stg = F.lds + 128 * 320;
    const bf16* proj = (const bf16*)(F.ws + WS_PROJ);
    const float* gst = (const float*)(F.ws + WS_GST);
    bf16* ag = (bf16*)(F.ws + WS_AG);
    const int hh = F.lane >> 5, ti = F.wave >> 1, cj = F.wave & 1, l31 = F.lane & 31;
    for (int vb = F.bid; vb < NCHUNK * 8; vb += F.G) {
        const int ck = vb >> 3, g = vb & 7;
        __syncthreads();
        {
            const int s = F.tid >> 2, c0 = (F.tid & 3) * 32, row = ck * 128 + s;
            const float mu = gst[row * 2], rstd = gst[row * 2 + 1];
            const float* lnw = F.in[IN_LNW + F.z] + layer * D + g * 128 + c0; const float* lnb = F.in[IN_LNB + F.z] + layer * D + g * 128 + c0;
#pragma unroll
            for (int j = 0; j < 4; ++j) {
                const u32x4 r = *(const u32x4*)(proj + (size_t)row * NPROJ + PC_V + g * 128 + c0 + 8 * j);
                const f32x4 w0 = *(const f32x4*)(lnw + 8 * j), w1 = *(const f32x4*)(lnw + 8 * j + 4), b0 = *(const f32x4*)(lnb + 8 * j), b1 = *(const f32x4*)(lnb + 8 * j + 4);
                float v[8] = {bf2f(r.x & 0xffffu), bf2f(r.x >> 16), bf2f(r.y & 0xffffu), bf2f(r.y >> 16), bf2f(r.z & 0xffffu), bf2f(r.z >> 16), bf2f(r.w & 0xffffu), bf2f(r.w >> 16)};
                const float ww[8] = {w0.x, w0.y, w0.z, w0.w, w1.x, w1.y, w1.z, w1.w}, bb[8] = {b0.x, b0.y, b0.z, b0.w, b1.x, b1.y, b1.z, b1.w};
#pragma unroll
                for (int c = 0; c < 8; ++c) v[c] = (gelu_f(v[c]) - mu) * rstd * ww[c] + bb[c];
                u32x4 o; o.x = pkbf(v[0], v[1]); o.y = pkbf(v[2], v[3]); o.z = pkbf(v[4], v[5]); o.w = pkbf(v[6], v[7]);
                *(LAS u32x4*)(Vi + s * 320 + (c0 + 8 * j) * 2) = o;
            }
        }
        __syncthreads();
        const float* wsp = F.in[IN_WSP + F.z] + (size_t)(layer * 8 + g) * 128 * 128 + (32 * ti + l31) * 128;
        f32x16 acc[2];
#pragma unroll
        for (int r = 0; r < 16; ++r) { acc[0][r] = 0.f; acc[1][r] = 0.f; }
#pragma unroll
        for (int ks = 0; ks < 8; ++ks) {
            const int k0 = 16 * ks + 8 * hh;
            const f32x4 a0 = *(const f32x4*)(wsp + k0), a1 = *(const f32x4*)(wsp + k0 + 4);
            const bf16x8 a = pack8(a0.x, a0.y, a0.z, a0.w, a1.x, a1.y, a1.z, a1.w);
#pragma unroll
            for (int c = 0; c < 2; ++c) { const bf16x8 b = tr2(Vi, 320, k0, k0 + 4, 64 * cj + 32 * c, F.lane); acc[c] = MFMA32(a, b, acc[c]); }
        }
#pragma unroll
        for (int c = 0; c < 2; ++c)
#pragma unroll
            for (int r = 0; r < 16; ++r) *(LAS float*)(stg + (32 * ti + crow(r, hh)) * 528 + (64 * cj + 32 * c + l31) * 4) = acc[c][r];
        __syncthreads();
        const float* bsp = F.in[IN_BSP + F.z] + (layer * 8 + g) * 128;
#pragma unroll
        for (int v = 0; v < 8; ++v) {
            const int t = F.wave * 16 + 2 * v + hh, row = ck * 128 + t;
            const f32x4 sv = *(const LAS f32x4*)(stg + t * 528 + l31 * 16) + bsp[t];
            const u32x2 ur = *(const u32x2*)(proj + (size_t)row * NPROJ + PC_U + g * 128 + 4 * l31), zr = *(const u32x2*)(proj + (size_t)row * NPROJ + PC_ZG + g * 128 + 4 * l31);
            u32x2 o;
            o.x = pkbf(gelu_f(bf2f(ur.x & 0xffffu)) * sv.x * silu_f(bf2f(zr.x & 0xffffu)), gelu_f(bf2f(ur.x >> 16)) * sv.y * silu_f(bf2f(zr.x >> 16)));
            o.y = pkbf(gelu_f(bf2f(ur.y & 0xffffu)) * sv.z * silu_f(bf2f(zr.y & 0xffffu)), gelu_f(bf2f(ur.y >> 16)) * sv.w * silu_f(bf2f(zr.y >> 16)));
            *(u32x2*)(ag + (size_t)row * D + g * 128 + 4 * l31) = o;
        }
    }
}

DEV void ph_dt(const Frame& F0, int layer) {
    Frame F = launder(F0);
    asm volatile("" : "+s"(layer));
    const int hh = F.lane >> 5, l31 = F.lane & 31;
    for (int pm = F.bid; pm < NTOK / 256; pm += F.G) {
        const bf16* A = (const bf16*)(F.ws + WS_HBUF) + (size_t)(pm * 256 + F.wave * 32 + l31) * D + 8 * hh;
        const bf16* B = (const bf16*)(F.ws + WS_WDT) + (size_t)layer * 32 * 1024 + (size_t)l31 * 1024 + 8 * hh;
        f32x16 acc;
#pragma unroll
        for (int r = 0; r < 16; ++r) acc[r] = 0.f;
#pragma unroll 8
        for (int ks = 0; ks < 64; ++ks) { const bf16x8 a = *(const bf16x8*)(A + 16 * ks), b = *(const bf16x8*)(B + 16 * ks); acc = MFMA32(a, b, acc); }
        float* o = (float*)(F.ws + WS_DTRAW) + (size_t)(pm * 256 + F.wave * 32) * 32 + l31;
#pragma unroll
        for (int r = 0; r < 16; ++r) o[crow(r, hh) * 32] = acc[r];
    }
}

#define XB_TMO      128
#define XB_XCNT(j)  (256  + 64 * (j))
#define XB_XSUB(j)  (1280 + 64 * (j))
#define XB_XGEN(j)  (2304 + 64 * (j))
#define XB_TOP      3328
#define XB_TOPGEN   3392
#define XCD_BAR_WORDS 3456
#define XB_SPIN_CAP (1u << 18)

__device__ __forceinline__ unsigned xb_ld(unsigned* p)              { return __hip_atomic_load(p, __ATOMIC_RELAXED, __HIP_MEMORY_SCOPE_AGENT); }
__device__ __forceinline__ unsigned xb_add(unsigned* p, unsigned v) { return __hip_atomic_fetch_add(p, v, __ATOMIC_RELAXED, __HIP_MEMORY_SCOPE_AGENT); }
__device__ __forceinline__ unsigned xb_xcc_id() { return (unsigned)__builtin_amdgcn_s_getreg((3 << 11) | 20) & 0xFu; }
#define XB_SPIN(cond, bar) do { unsigned _sp = 0; while (cond) { __builtin_amdgcn_s_sleep(1); \
    if ((++_sp & 255u) == 0u) { if (xb_ld(&(bar)[XB_TMO])) break; if (_sp > XB_SPIN_CAP) { atomicAdd(&(bar)[XB_TMO], 1u); break; } } } } while (0)

struct XcdBarrier {
    unsigned* bar; unsigned x;
    volatile LAS unsigned* st;
};

__device__ __forceinline__ XcdBarrier xcd_barrier_post(unsigned* bar, volatile LAS unsigned* st) {
    XcdBarrier b; b.bar = bar; b.x = xb_xcc_id(); b.st = st;
    if (threadIdx.x == 0) (void)xb_add(&bar[XB_XCNT(b.x)], 1u);
    return b;
}
__device__ __forceinline__ void xcd_barrier_complete(unsigned* bar, unsigned x, unsigned& nloc, unsigned& nx) {
    const unsigned G = gridDim.x * gridDim.y * gridDim.z;
    unsigned sum, cnt, mine, sp = 0u;
    for (;;) {
        sum = 0u; cnt = 0u; mine = 0u;
#pragma unroll
        for (unsigned j = 0; j < 16; ++j) { const unsigned c = xb_ld(&bar[XB_XCNT(j)]); sum += c; cnt += (c > 0u) ? 1u : 0u; mine = (j == x) ? c : mine; }
        if (sum == G) break;
        __builtin_amdgcn_s_sleep(1);
        if ((++sp & 255u) == 0u) { if (xb_ld(&bar[XB_TMO])) break; if (sp > XB_SPIN_CAP) { atomicAdd(&bar[XB_TMO], 1u); break; } }
    }
    nloc = mine > 0u ? mine : 1u; nx = cnt > 0u ? cnt : 1u;
}

__device__ __forceinline__ void xcd_barrier(const XcdBarrier& b) {
    asm volatile("s_waitcnt vmcnt(0)" ::: "memory");
    __syncthreads();
    if (threadIdx.x == 0) {
        unsigned* bar = b.bar;
        __builtin_amdgcn_s_waitcnt(0);
        unsigned nloc = b.st[0], nx = b.st[1];
        if (nloc == 0u) { xcd_barrier_complete(bar, b.x, nloc, nx); b.st[0] = nloc; b.st[1] = nx; }
        const unsigned old = xb_add(&bar[XB_XSUB(b.x)], 1u);
        const unsigned gen = old / nloc;
        if (old + 1u == (gen + 1u) * nloc) {
            __builtin_amdgcn_fence(__ATOMIC_RELEASE, "agent");
            asm volatile("s_waitcnt vmcnt(0)" ::: "memory");
            const unsigned og = xb_add(&bar[XB_TOP], 1u);
            const unsigned tg = og / nx;
            if (og + 1u == (tg + 1u) * nx) xb_add(&bar[XB_TOPGEN], 1u);
            else XB_SPIN(xb_ld(&bar[XB_TOPGEN]) == tg, bar);
            __builtin_amdgcn_fence(__ATOMIC_ACQUIRE, "agent");
            xb_add(&bar[XB_XGEN(b.x)], 1u);
            asm volatile("s_waitcnt vmcnt(0)" ::: "memory");
        } else {
            XB_SPIN(xb_ld(&bar[XB_XGEN(b.x)]) == gen, bar);
            __builtin_amdgcn_fence(__ATOMIC_ACQUIRE, "agent");
            asm volatile("s_waitcnt vmcnt(0)" ::: "memory");
        }
    }
    __syncthreads();
}

constexpr int CW_BAR = 4096;
constexpr int MISC_OFF = LDS_BYTES - 256;

__global__ void __launch_bounds__(512, 2) mega(Args args) {
    extern __shared__ __attribute__((aligned(16))) unsigned char lds[];
    Frame F;
    F.lds = (LAS unsigned char*)lds; F.tid = threadIdx.x; F.lane = F.tid & 63; F.wave = __builtin_amdgcn_readfirstlane(F.tid >> 6);
    F.G = gridDim.x; F.bid = blockIdx.x; F.in = args.in; F.out = args.out; F.ws = args.ws;
    volatile LAS unsigned* MISC = (volatile LAS unsigned*)(F.lds + MISC_OFF);
    if (F.tid < 64) MISC[F.tid] = 0u;
    __syncthreads();
    XcdBarrier bar = xcd_barrier_post((unsigned*)(F.ws + WS_CTL) + CW_BAR, MISC + 8);
#define GRID_BAR() xcd_barrier(bar)
    ph_mod(F); GRID_BAR();
    ph_cvt(F); GRID_BAR();
    for (int layer = 0; layer < DEPTH; ++layer) {
        ph_prep(F, layer); GRID_BAR();
        { Frame Fg = launder(F); pg8::Gemm g{(const bf16*)(Fg.ws + WS_HBUF), (const bf16*)(Fg.ws + WS_WIN) + (size_t)layer * NPROJ * 1024, NTOK, NPROJ, D};
          pg8::StaticOrder S; S.init(NTOK, NPROJ, Fg.G, Fg.bid);
          pg8::EpiBf16<0> E{(bf16*)(Fg.ws + WS_PROJ), NPROJ, nullptr, 0, 0, 1.f};
          pg8::gemm_phase<pg8::EpiBf16<0>, pg8::StaticOrder, true, true>(Fg.lds, g, S, E); }
        ph_dt(F, layer);
        GRID_BAR();
        ph_s1(F, layer); ph_gstat(F, layer); GRID_BAR();
        ph_pass(F, layer); GRID_BAR();
        ph_s2(F, layer); ph_gmlp2(F, layer); GRID_BAR();
#pragma unroll 1
        for (int k = 0; k < 3; ++k) {
            Frame Fg = launder(F);
            const bf16* A = (const bf16*)(Fg.ws + (k == 0 ? WS_HBUF : k == 1 ? WS_AG : WS_XBCS));
            const bf16* Bt = (const bf16*)(Fg.ws + (k == 0 ? WS_WM : k == 1 ? WS_WG : WS_WO)) + (size_t)layer * D * D;
            float* C = (float*)(Fg.ws + (k == 2 ? WS_YA : WS_ST)) + (k == 1 ? (size_t)NTOK * D : 0);
            pg8::Gemm g{A, Bt, NTOK, D, D}; pg8::StaticOrder S; S.init(NTOK, D, Fg.G, Fg.bid);
            pg8::EpiF32 E{C, D, nullptr};
            pg8::gemm_phase<pg8::EpiF32, pg8::StaticOrder, true, true>(Fg.lds, g, S, E);
            if (k == 1) { GRID_BAR(); ph_merge(F, layer); }
            if (k >= 1) GRID_BAR();
        }
        ph_res(F, layer); GRID_BAR();
    }
    ph_final(F);
}

extern "C" void kernel_launch(void* const* d_in, const int* in_sizes, int n_in, void* d_out, int out_size, void* d_ws, size_t ws_size, hipStream_t stream) {
    static int grid = 0;
    if (grid == 0) {
        if (n_in != 23 || ws_size < WS_END) { fprintf(stderr, "kernel_launch: need 23 inputs and %zu bytes of workspace; got %d, %zu\n", (size_t)WS_END, n_in, ws_size); grid = -1; return; }
        int dev = 0, cus = 0;
        if (hipGetDevice(&dev) != hipSuccess || hipDeviceGetAttribute(&cus, hipDeviceAttributeMultiprocessorCount, dev) != hipSuccess) { grid = -1; return; }
        if (hipFuncSetAttribute((const void*)mega, hipFuncAttributeMaxDynamicSharedMemorySize, LDS_BYTES) != hipSuccess) { fprintf(stderr, "kernel_launch: hipFuncSetAttribute failed\n"); grid = -1; return; }
        grid = cus;
    }
    if (grid < 0) return;
    if (hipMemsetAsync((char*)d_ws + WS_CTL, 0, 1 * MiB, stream) != hipSuccess) return;
    Args a{};
    for (int i = 0; i < 23; ++i) a.in[i] = (const float*)d_in[i];
    a.out = (float*)d_out; a.ws = (unsigned char*)d_ws;
    hipLaunchKernelGGL(mega, dim3(grid), dim3(512), LDS_BYTES, stream, a);
}
```

```cpp
#include <hip/hip_runtime.h>
#include <cstdio>
#include <cstdint>
namespace pg8 {
#define PG8_LAS __attribute__((address_space(3)))
typedef unsigned short bf16_t;
typedef short bf16x8 __attribute__((ext_vector_type(8)));
typedef float f32x4 __attribute__((ext_vector_type(4)));
typedef unsigned u32x4 __attribute__((ext_vector_type(4)));
constexpr int BM = 256, BK = 64, HALF = 128, HTB = HALF * BK * 2  , STAGE_BYTES = 8 * HTB, NXCD = 8, WGM = 8;

__host__ __device__ __forceinline__ int lds_byte(int r, int c) { const int st = (r >> 4) * 2 + (c >> 5), rr = r & 15, cc = c & 31, ob = rr * 64 + cc * 2; return st * 1024 + (ob ^ (((ob >> 9) & 1) << 5)); }
__host__ __device__ __forceinline__ void stage_rc(int b, int& R, int& C) { const int st = b / 1024, sb = b % 1024, swz = sb ^ (((sb >> 9) & 1) << 5); R = (st >> 1) * 16 + swz / 64; C = (st & 1) * 32 + (swz % 64) / 2; }
__host__ __device__ __forceinline__ int perm32(int rho) { const int n = rho >> 4, i = rho & 15; return 8 * (i >> 2) + 4 * n + (i & 3); }

struct Unit { int pm, pn; };
struct Gemm { const bf16_t* A; const bf16_t* Bt; int M, N, K; };

struct StaticOrder {
    int nM, nN, nwg, G, c;
    __host__ __device__ void init(int M, int N, int G_, int c_) { nM = M / BM; nN = N / BM; nwg = nM * nN; G = G_; c = c_; }
    __host__ __device__ bool next(int i, Unit& u) const {
        const long L = (long)i * G + c; if (L >= nwg) return false;
        int wgid = (int)L; { const int q = nwg / NXCD, r = nwg % NXCD, xcd = wgid % NXCD, off = wgid / NXCD; wgid = (xcd < r ? xcd * (q + 1) : r * (q + 1) + (xcd - r) * q) + off; }
        const int nig = WGM * nN, gid = wgid / nig, fm = gid * WGM, gsz = (nM - fm) < WGM ? (nM - fm) : WGM;
        u.pm = fm + ((wgid % nig) % gsz); u.pn = (wgid % nig) / gsz; return true;
    }
    __device__ __forceinline__ void a_ready(const Unit&) const {}
    __device__ __forceinline__ void done(const Unit&) const {}
};

__device__ __forceinline__ unsigned cvt_pk_bf16(float lo, float hi) { unsigned r; asm volatile("v_cvt_pk_bf16_f32 %0, %1, %2" : "=v"(r) : "v"(lo), "v"(hi)); return r; }
typedef float f32x2 __attribute__((ext_vector_type(2)));
__device__ __forceinline__ f32x2 gelu_pk(f32x2 v) {
    const f32x2 av = __builtin_elementwise_abs(v), d = av * 0.2316418882f + 1.0f;
    f32x2 t; t.x = __builtin_amdgcn_rcpf(d.x); t.y = __builtin_amdgcn_rcpf(d.y);
    f32x2 q = t * 0.5307027145f + (-0.7265760135f); q = q * t + 0.7107068705f; q = q * t + (-0.142248368f); q = q * t + 0.127414796f; q = q * t;
    const f32x2 s = (v * v) * (-0.72134752044f);
    f32x2 e; e.x = __builtin_amdgcn_exp2f(s.x); e.y = __builtin_amdgcn_exp2f(s.y);
    const f32x2 m = v * (q * e), r = v - m;
    f32x2 o; o.x = v.x < 0.f ? m.x : r.x; o.y = v.y < 0.f ? m.y : r.y; return o;
}

template <int ACT  > struct EpiBf16 {
    static constexpr bool PERM = true, AFTER_DRAIN = false, HAS_MID = false; static_assert(ACT == 0 || ACT == 1, "EpiBf16: ACT is 0 (none) or 1 (gelu_pk)");
    bf16_t* O; int ldc; const float* bias; int split_cols; size_t split_stride; float scale0;
    __device__ __forceinline__ void operator()(const f32x4 (&acc)[2][2][4][2], const Unit& u, int wr, int wc, int fr, int fq) const {
        const int row0 = u.pm * BM + wr * 64 + fr; int colt = u.pn * BM; bf16_t* base = O;
        float sc = 1.f; if (split_cols) { const int t = colt / split_cols; base += (size_t)t * split_stride; colt -= t * split_cols; if (t == 0) sc = scale0; }
        const int col0 = colt + wc * 32 + 8 * fq, bcol0 = u.pn * BM + wc * 32 + 8 * fq;
        f32x4 bv[2][2];
#pragma unroll
        for (int bj = 0; bj < 2; ++bj)
#pragma unroll
            for (int n = 0; n < 2; ++n) bv[bj][n] = bias ? *(const f32x4*)(bias + bcol0 + bj * HALF + 4 * n) : (f32x4){0.f, 0.f, 0.f, 0.f};
#pragma unroll
        for (int ai = 0; ai < 2; ++ai)
#pragma unroll
            for (int m = 0; m < 4; ++m) { bf16_t* rowp = base + (size_t)(row0 + ai * HALF + m * 16) * ldc + col0;
#pragma unroll
                for (int bj = 0; bj < 2; ++bj) { f32x4 v0 = acc[ai][bj][m][0] + bv[bj][0], v1 = acc[ai][bj][m][1] + bv[bj][1];
                    if (ACT == 1) { f32x2 a = gelu_pk((f32x2){v0[0], v0[1]}), b = gelu_pk((f32x2){v0[2], v0[3]}), c = gelu_pk((f32x2){v1[0], v1[1]}), d = gelu_pk((f32x2){v1[2], v1[3]});
                        v0 = (f32x4){a.x, a.y, b.x, b.y}; v1 = (f32x4){c.x, c.y, d.x, d.y}; }
                    v0 = v0 * sc; v1 = v1 * sc; u32x4 w; w.x = cvt_pk_bf16(v0[0], v0[1]); w.y = cvt_pk_bf16(v0[2], v0[3]); w.z = cvt_pk_bf16(v1[0], v1[1]); w.w = cvt_pk_bf16(v1[2], v1[3]);
                    *(u32x4*)(rowp + bj * HALF) = w; } }
    }
};
struct EpiF32 {
    static constexpr bool PERM = false, AFTER_DRAIN = false, HAS_MID = false;
    float* C; int ldc; const float* bias;
    __device__ __forceinline__ void operator()(const f32x4 (&acc)[2][2][4][2], const Unit& u, int wr, int wc, int fr, int fq) const {
        const int row0 = u.pm * BM + wr * 64 + fr, col0 = u.pn * BM + wc * 32 + 4 * fq;
        f32x4 bv[2][2];
#pragma unroll
        for (int bj = 0; bj < 2; ++bj)
#pragma unroll
            for (int n = 0; n < 2; ++n) bv[bj][n] = bias ? *(const f32x4*)(bias + col0 + bj * HALF + n * 16) : (f32x4){0.f, 0.f, 0.f, 0.f};
#pragma unroll
        for (int ai = 0; ai < 2; ++ai)
#pragma unroll
            for (int m = 0; m < 4; ++m) { float* rowp = C + (size_t)(row0 + ai * HALF + m * 16) * ldc + col0;
#pragma unroll
                for (int bj = 0; bj < 2; ++bj)
#pragma unroll
                    for (int n = 0; n < 2; ++n) *(f32x4*)(rowp + bj * HALF + n * 16) = acc[ai][bj][m][n] + bv[bj][n]; }
    }
};
template <class Epi, class Sched, bool ALIGN_EPI = false, bool SP2 = false>
__device__ __forceinline__ void gemm_phase(PG8_LAS unsigned char* lds, const Gemm g, const Sched& S, const Epi& E) {
    int tid_ = threadIdx.x; asm volatile("" : "+v"(tid_));
    const int tid = tid_, wid = __builtin_amdgcn_readfirstlane(tid >> 6), lane = tid & 63, wr = wid >> 2, wc = wid & 3, fr = lane & 15, fq = lane >> 4;
    const int K = g.K, nt = K / BK;
    unsigned voffA[2], voffB[2];
#pragma unroll
    for (int i = 0; i < 2; ++i) { int R, C; stage_rc(tid * 16 + i * 8192, R, C); const int Rb = Epi::PERM ? ((R & ~31) + perm32(R & 31)) : R;
        voffA[i] = (unsigned)(R * K + C) * 2u; voffB[i] = (unsigned)(Rb * K + C) * 2u; }
    const size_t kstep = (size_t)(BK * 2);
    const size_t hstep = (size_t)HALF * K * 2;
    const size_t tstep = 2 * hstep;
    const unsigned ldsw = (unsigned)wid * 1024u;
    const int aoff = lds_byte(wr * 64 + fr, fq * 8), boff = lds_byte(wc * 32 + fr, fq * 8);
#define PG8_SA(b, h) (((b) * 2 + (h)) * HTB)
#define PG8_SB(b, h) ((4 + (b) * 2 + (h)) * HTB)
#define PG8_STAGE(bufoff, gbase, voff) do { _Pragma("unroll") for (int _i = 0; _i < 2; ++_i) \
        __builtin_amdgcn_global_load_lds((const unsigned*)((const char*)(gbase) + (voff)[_i]), (PG8_LAS unsigned*)(lds + (bufoff) + ldsw + _i * 8192), 16, 0, 0); } while (0)
#define PG8_LDA(dst, b, h) do { _Pragma("unroll") for (int m = 0; m < 4; ++m) _Pragma("unroll") for (int k = 0; k < 2; ++k) dst[m][k] = *(const PG8_LAS bf16x8*)(lds + PG8_SA(b, h) + aoff + m * 2048 + k * 1024); } while (0)
#define PG8_LDB(dst, b, h) do { _Pragma("unroll") for (int n = 0; n < 2; ++n) _Pragma("unroll") for (int k = 0; k < 2; ++k) dst[n][k] = *(const PG8_LAS bf16x8*)(lds + PG8_SB(b, h) + boff + n * 2048 + k * 1024); } while (0)
#define PG8_MMA(ai, bj, At, Bt) do { __builtin_amdgcn_s_setprio(1); _Pragma("unroll") for (int m = 0; m < 4; ++m) _Pragma("unroll") for (int n = 0; n < 2; ++n) _Pragma("unroll") for (int k = 0; k < 2; ++k) \
        acc[ai][bj][m][n] = __builtin_amdgcn_mfma_f32_16x16x32_bf16(Bt[n][k], At[m][k], acc[ai][bj][m][n], 0, 0, 0); __builtin_amdgcn_s_setprio(0); } while (0)
#define PG8_WAIT_V(n) asm volatile("s_waitcnt vmcnt(" #n ")" ::: "memory")
#define PG8_WAIT_L(n) asm volatile("s_waitcnt lgkmcnt(" #n ")" ::: "memory")
#define PG8_BAR __builtin_amdgcn_s_barrier()
#define PG8_SCHED __builtin_amdgcn_sched_barrier(0)
    Unit cur, nxt; int ui = 0;
    if (!S.next(0, cur)) return;
    f32x4 acc[2][2][4][2];
#pragma unroll
    for (int a = 0; a < 2; ++a)
#pragma unroll
        for (int b = 0; b < 2; ++b)
#pragma unroll
            for (int m = 0; m < 4; ++m)
#pragma unroll
                for (int n = 0; n < 2; ++n) acc[a][b][m][n] = (f32x4){0.f, 0.f, 0.f, 0.f};
    bf16x8 At[4][2], B0[2][2], B1[2][2];
    const char* cA = (const char*)g.A + (size_t)cur.pm * tstep; const char* cB = (const char*)g.Bt + (size_t)cur.pn * tstep;
    S.a_ready(cur);
    if constexpr (SP2) {
        PG8_STAGE(PG8_SB(0, 0), cB, voffB); PG8_STAGE(PG8_SB(0, 1), cB + hstep, voffB); PG8_STAGE(PG8_SA(0, 0), cA, voffA); PG8_STAGE(PG8_SA(0, 1), cA + hstep, voffA);
        if (wr == 1) PG8_BAR;
        PG8_WAIT_V(2); PG8_BAR;
        PG8_STAGE(PG8_SB(1, 0), cB + kstep, voffB); PG8_STAGE(PG8_SA(1, 0), cA + kstep, voffA); PG8_STAGE(PG8_SB(1, 1), cB + hstep + kstep, voffB);
        PG8_WAIT_V(6); PG8_BAR;
    } else {
        PG8_STAGE(PG8_SB(0, 0), cB, voffB); PG8_STAGE(PG8_SA(0, 0), cA, voffA); PG8_STAGE(PG8_SB(0, 1), cB + hstep, voffB); PG8_STAGE(PG8_SA(0, 1), cA + hstep, voffA);
        if (wr == 1) PG8_BAR;
        PG8_WAIT_V(4); PG8_BAR;
        PG8_STAGE(PG8_SB(1, 0), cB + kstep, voffB); PG8_STAGE(PG8_SA(1, 0), cA + kstep, voffA); PG8_STAGE(PG8_SB(1, 1), cB + hstep + kstep, voffB);
        PG8_WAIT_V(6); PG8_BAR;
    }
    for (;;) {
        const bool has_next = S.next(ui + 1, nxt);
        const char* nA = has_next ? (const char*)g.A + (size_t)nxt.pm * tstep : cA; const char* nB = has_next ? (const char*)g.Bt + (size_t)nxt.pn * tstep : cB;
        for (int t = 0; t < nt; t += 2) {
            const bool last = (t == nt - 2);
            const char* a1 = cA + (size_t)(t + 1) * kstep;
            const char* a2 = last ? nA : cA + (size_t)(t + 2) * kstep; const char* b2 = last ? nB : cB + (size_t)(t + 2) * kstep;
            const char* a3 = a2 + kstep; const char* b3 = b2 + kstep;
            if (last && has_next) S.a_ready(nxt);
            if constexpr (Epi::HAS_MID) { if (t == nt / 2) E.mid(acc, cur, wr, wc, fr, fq); }
            if constexpr (SP2) {
            PG8_LDB(B0, 0, 0); PG8_LDB(B1, 0, 1); PG8_SCHED; PG8_LDA(At, 0, 0); PG8_STAGE(PG8_SA(1, 1), a1 + hstep, voffA);
            PG8_WAIT_V(8); PG8_WAIT_L(0); PG8_BAR; PG8_MMA(0, 0, At, B0); PG8_MMA(0, 1, At, B1); PG8_BAR; PG8_SCHED;
            PG8_LDA(At, 0, 1); PG8_STAGE(PG8_SB(0, 0), b2, voffB); PG8_STAGE(PG8_SB(0, 1), b2 + hstep, voffB); PG8_STAGE(PG8_SA(0, 0), a2, voffA);
            PG8_WAIT_V(8); PG8_WAIT_L(0); PG8_BAR; PG8_MMA(1, 0, At, B0); PG8_MMA(1, 1, At, B1); PG8_BAR; PG8_SCHED;
            PG8_LDB(B0, 1, 0); PG8_LDB(B1, 1, 1); PG8_SCHED; PG8_LDA(At, 1, 0); PG8_STAGE(PG8_SA(0, 1), a2 + hstep, voffA);
            PG8_WAIT_V(8); PG8_WAIT_L(0); PG8_BAR; PG8_MMA(0, 0, At, B0); PG8_MMA(0, 1, At, B1); PG8_BAR; PG8_SCHED;
            PG8_LDA(At, 1, 1); PG8_STAGE(PG8_SB(1, 0), b3, voffB); PG8_STAGE(PG8_SB(1, 1), b3 + hstep, voffB); PG8_STAGE(PG8_SA(1, 0), a3, voffA);
            PG8_WAIT_V(8); PG8_WAIT_L(0); PG8_BAR; PG8_MMA(1, 0, At, B0); PG8_MMA(1, 1, At, B1); PG8_BAR; PG8_SCHED;
            } else {
            PG8_LDB(B0, 0, 0); PG8_SCHED; PG8_LDA(At, 0, 0); PG8_STAGE(PG8_SA(1, 1), a1 + hstep, voffA);
            PG8_WAIT_L(8); PG8_BAR; PG8_WAIT_L(0); PG8_MMA(0, 0, At, B0); PG8_BAR; PG8_SCHED;
            PG8_LDB(B1, 0, 1); PG8_STAGE(PG8_SB(0, 0), b2, voffB);
            PG8_BAR; PG8_WAIT_L(0); PG8_MMA(0, 1, At, B1); PG8_BAR;
            PG8_LDA(At, 0, 1); PG8_STAGE(PG8_SA(0, 0), a2, voffA);
            PG8_BAR; PG8_WAIT_L(0); PG8_MMA(1, 0, At, B0); PG8_BAR; PG8_SCHED;
            PG8_STAGE(PG8_SB(0, 1), b2 + hstep, voffB);
            PG8_WAIT_V(6); PG8_BAR; PG8_MMA(1, 1, At, B1); PG8_BAR;
            PG8_LDB(B0, 1, 0); PG8_SCHED; PG8_LDA(At, 1, 0); PG8_STAGE(PG8_SA(0, 1), a2 + hstep, voffA);
            PG8_WAIT_L(8); PG8_BAR; PG8_WAIT_L(0); PG8_MMA(0, 0, At, B0); PG8_BAR; PG8_SCHED;
            PG8_LDB(B1, 1, 1); PG8_STAGE(PG8_SB(1, 0), b3, voffB);
            PG8_BAR; PG8_WAIT_L(0); PG8_MMA(0, 1, At, B1); PG8_BAR;
            PG8_LDA(At, 1, 1); PG8_STAGE(PG8_SA(1, 0), a3, voffA);
            PG8_BAR; PG8_WAIT_L(0); PG8_MMA(1, 0, At, B0); PG8_BAR; PG8_SCHED;
            PG8_STAGE(PG8_SB(1, 1), b3 + hstep, voffB);
            PG8_WAIT_V(6); PG8_BAR; PG8_MMA(1, 1, At, B1); PG8_BAR;
            }
        }
        if constexpr (ALIGN_EPI) { if (wr == 0) PG8_BAR; }
        if constexpr (!Epi::AFTER_DRAIN) { E(acc, cur, wr, wc, fr, fq); S.done(cur); }
        if (!has_next) break;
#pragma unroll
        for (int a = 0; a < 2; ++a)
#pragma unroll
            for (int b = 0; b < 2; ++b)
#pragma unroll
                for (int m = 0; m < 4; ++m)
#pragma unroll
                    for (int n = 0; n < 2; ++n) acc[a][b][m][n] = (f32x4){0.f, 0.f, 0.f, 0.f};
        cur = nxt; cA = nA; cB = nB; ++ui;
        if constexpr (ALIGN_EPI) { if (wr == 1) PG8_BAR; }
    }
    PG8_WAIT_V(0);
    if constexpr (!ALIGN_EPI) { if (wr == 0) PG8_BAR; }
    PG8_BAR;
    if constexpr (Epi::AFTER_DRAIN) { E.fused(acc, cur, wr, wc, fr, fq, lds, wid, lane); S.done(cur); }
#undef PG8_SA
#undef PG8_SB
#undef PG8_STAGE
#undef PG8_LDA
#undef PG8_LDB
#undef PG8_MMA
#undef PG8_WAIT_V
#undef PG8_WAIT_L
#undef PG8_BAR
#undef PG8_SCHED
}
}

#define DEV __device__ __forceinline__
#define LAS __attribute__((address_space(3)))
typedef unsigned short bf16;
typedef float f32x4 __attribute__((ext_vector_type(4)));
typedef unsigned u32x4 __attribute__((ext_vector_type(4)));
typedef unsigned u32x2 __attribute__((ext_vector_type(2)));

constexpr int D = 1024, NTOK = 10240, NCTX = 8192, DEPTH = 4, NH = 16, HP = 64, NGRP = 4, NST = 128, DIN = 8224;
constexpr int NPROJ = 8192;
constexpr int NCHUNK = 80;
constexpr float EPS = 1e-6f;
constexpr int PC_XBC = 0, PC_ZM = 2048, PC_U = 3072, PC_V = 4096, PC_ZG = 5120, PC_GLM = 6144, PC_GLG = 7168;

constexpr size_t MiB = 1u << 20;
constexpr size_t WS_CTL = 0, CTL_BYTES = 2 * MiB;
constexpr size_t CTL_SSQ = 64 * 1024;
constexpr size_t CTL_SSQX = 256 * 1024;
constexpr size_t CTL_GSUM = 512 * 1024;
constexpr size_t CTL_SW = 1 * MiB;
constexpr size_t WS_MOD = 2 * MiB;
constexpr size_t WS_GN = WS_MOD + 256 * 1024;
constexpr size_t WS_ATOT = WS_GN + 128 * 1024;
constexpr size_t WS_WDT = WS_ATOT + 64 * 1024;
constexpr size_t WS_DTRAW = 4 * MiB;
constexpr size_t WS_WIN = 6 * MiB;
constexpr size_t WS_WMG = WS_WIN + 64 * MiB;
constexpr size_t WS_WO = WS_WMG + 16 * MiB;
constexpr size_t WS_HBUF = WS_WO + 8 * MiB;
constexpr size_t WS_AMG = WS_HBUF + 20 * MiB;
constexpr size_t WS_PROJ = WS_AMG + 40 * MiB;
constexpr size_t WS_XBUF = WS_PROJ + 160 * MiB;
constexpr size_t WS_MRG = WS_XBUF + 40 * MiB;
constexpr size_t WS_ST = WS_MRG + 20 * MiB;
constexpr size_t WS_END = WS_ST + 80 * MiB;

constexpr int LDS_BYTES = 155648;

DEV float bf2f(unsigned v) { return __uint_as_float(v << 16); }
DEV unsigned f2bf(float f) { unsigned u = __float_as_uint(f); return (u + 0x7fffu + ((u >> 16) & 1u)) >> 16; }
DEV unsigned pk2(float lo, float hi) { return f2bf(lo) | (f2bf(hi) << 16); }
DEV float sigmoid_f(float x) { return 1.f / (1.f + __expf(-x)); }
DEV float silu_f(float x) { return x / (1.f + __expf(-x)); }
DEV float gelu_f(float x) { return x * sigmoid_f(1.5957691216f * (x + 0.044715f * x * x * x)); }
DEV float softplus_f(float x) { return x > 20.f ? x : log1pf(__expf(x)); }
DEV float wave_sum(float v) {
#pragma unroll
    for (int o = 1; o < 64; o <<= 1) v += __shfl_xor(v, o);
    return v;
}

struct Args { const float* in[23]; float* out; unsigned char* ws; int step_lo, step_hi; };

struct Frame {
    LAS unsigned char* lds;
    int tid, lane, wave, G, bid, z;
    const float* const* in;
    float* out; unsigned char* ws;
};
DEV Frame launder(const Frame& F0) {
    Frame F = F0;
    F.z = 0; asm volatile("" : "+s"(F.z), "+s"(F.out), "+s"(F.ws), "+s"(F.G), "+s"(F.bid), "+s"(F.wave));
    asm volatile("" : "+v"(F.tid));
    F.lane = F.tid & 63;
    return F;
}
#define IN_XP 0
#define IN_XS 1
#define IN_STATE 2
#define IN_C 3
#define IN_CCTX 4
#define IN_WADA 5
#define IN_BADA 6
#define IN_NORMW 7
#define IN_WIN 8
#define IN_CONVW 9
#define IN_CONVB 10
#define IN_DTBIAS 11
#define IN_ALOG 12
#define IN_DSKIP 13
#define IN_SSMNW 14
#define IN_WOUTM 15
#define IN_LNW 16
#define IN_LNB 17
#define IN_WSP 18
#define IN_BSP 19
#define IN_WOUTG 20
#define IN_WOUT 21
#define IN_FNW 22

DEV int scan_to_row(int sr, int layer) {
    if (sr < NCTX || !(layer & 1)) return sr;
    const int lb = (sr - NCTX) >> 10, q = (sr - NCTX) & 1023;
    return NCTX + lb * 1024 + (q & 15) * 64 + (q >> 4);
}

DEV void ph_mod(const Frame& F0) {
    Frame F = launder(F0);
    LAS float* sc = (LAS float*)F.lds;
    LAS float* part = sc + 3 * 1024;
    for (int i = F.tid; i < 3 * 1024; i += 512) { const int v = i >> 10, k = i & 1023; const float c = v == 0 ? F.in[IN_CCTX + F.z][k] : F.in[IN_C + F.z][(v - 1) * 1024 + k]; sc[i] = silu_f(c); }
    __syncthreads();
    float* mod = (float*)(F.ws + WS_MOD);
    for (int it = F.bid; it < DEPTH * 24; it += F.G) {
        const int l = it / 24, j = (it % 24) * 128 + (F.tid & 127), kq = F.tid >> 7;
        const float* w = F.in[IN_WADA + F.z] + (size_t)l * 1024 * 3072 + (size_t)(kq * 256) * 3072 + j;
        float a0 = 0.f, a1 = 0.f, a2 = 0.f;
#pragma unroll 8
        for (int k = 0; k < 256; ++k) { const float wv = w[(size_t)k * 3072]; a0 += sc[kq * 256 + k] * wv; a1 += sc[1024 + kq * 256 + k] * wv; a2 += sc[2048 + kq * 256 + k] * wv; }
        __syncthreads();
        part[(kq * 3 + 0) * 128 + (F.tid & 127)] = a0; part[(kq * 3 + 1) * 128 + (F.tid & 127)] = a1; part[(kq * 3 + 2) * 128 + (F.tid & 127)] = a2;
        __syncthreads();
        if (F.tid < 384) { const int v = F.tid >> 7, jj = F.tid & 127, col = (it % 24) * 128 + jj;
            mod[(l * 3 + v) * 3072 + col] = part[(0 * 3 + v) * 128 + jj] + part[(1 * 3 + v) * 128 + jj] + part[(2 * 3 + v) * 128 + jj] + part[(3 * 3 + v) * 128 + jj] + F.in[IN_BADA + F.z][l * 3072 + col]; }
    }
}

DEV void cvt_item(const float* W, int ldw, int k0, int n0, bf16* WT, int ldt, int k0d, int drow0, LAS float* scr, int lane, const float* shift3, float* sw3) {
#pragma unroll 8
    for (int i = 0; i < 32; ++i) { const int kk = 2 * i + (lane >> 5); scr[kk * 33 + (lane & 31)] = W[(size_t)(k0 + kk) * ldw + n0 + (lane & 31)]; }
    asm volatile("s_waitcnt lgkmcnt(0)" ::: "memory");
    const int c = lane & 7;
#pragma unroll
    for (int j = 0; j < 4; ++j) { const int n = (lane >> 3) + 8 * j; const LAS float* s = scr + (8 * c) * 33 + n;
        u32x4 o; o.x = pk2(s[0 * 33], s[1 * 33]); o.y = pk2(s[2 * 33], s[3 * 33]); o.z = pk2(s[4 * 33], s[5 * 33]); o.w = pk2(s[6 * 33], s[7 * 33]);
        *(u32x4*)(WT + (size_t)(drow0 + n) * ldt + k0d + 8 * c) = o; }
    if (shift3) {
        const int n = lane & 31, kh = (lane >> 5) * 32;
        float a0 = 0.f, a1 = 0.f, a2 = 0.f;
#pragma unroll 8
        for (int kk = 0; kk < 32; ++kk) { const float wv = scr[(kh + kk) * 33 + n]; a0 += shift3[k0 + kh + kk] * wv; a1 += shift3[3072 + k0 + kh + kk] * wv; a2 += shift3[6144 + k0 + kh + kk] * wv; }
        a0 += __shfl_xor(a0, 32); a1 += __shfl_xor(a1, 32); a2 += __shfl_xor(a2, 32);
        if (lane < 32) { atomicAdd(sw3 + n0 + n, a0); atomicAdd(sw3 + DIN + n0 + n, a1); atomicAdd(sw3 + 2 * DIN + n0 + n, a2); }
    }
    asm volatile("s_waitcnt lgkmcnt(0)" ::: "memory");
}
DEV void ph_cvt(const Frame& F0) {
    Frame F = launder(F0);
    LAS float* scr = (LAS float*)(F.lds + F.wave * 16384);
    const int gw = F.bid * 8 + F.wave, NGW = F.G * 8;
    constexpr int I_IN = 16 * 257, I_O = 16 * 32, PER_L = I_IN + 3 * I_O;
    for (int it = gw; it < DEPTH * PER_L; it += NGW) {
        const int l = it / PER_L; int r = it % PER_L;
        if (r < I_IN) { const int kb = r / 257, nb = r % 257;
            const float* shift3 = (const float*)(F.ws + WS_MOD) + (size_t)l * 3 * 3072;
            float* sw3 = (float*)(F.ws + WS_CTL + CTL_SW) + (size_t)l * 3 * DIN;
            if (nb == 96) cvt_item(F.in[IN_WIN + F.z] + (size_t)l * 1024 * DIN, DIN, 64 * kb, 3072, (bf16*)(F.ws + WS_WDT) + (size_t)l * 32 * 1024, 1024, 64 * kb, 0, scr, F.lane, shift3, sw3);
            else cvt_item(F.in[IN_WIN + F.z] + (size_t)l * 1024 * DIN, DIN, 64 * kb, 32 * nb, (bf16*)(F.ws + WS_WIN) + (size_t)l * NPROJ * 1024, 1024, 64 * kb, 32 * (nb < 96 ? nb : nb - 1), scr, F.lane, shift3, sw3);
            continue; }
        r -= I_IN;
        const int which = r / I_O; r %= I_O; const int kb = r >> 5, nb = r & 31;
        const float* W = (which == 0 ? F.in[IN_WOUTM + F.z] : which == 1 ? F.in[IN_WOUTG + F.z] : F.in[IN_WOUT + F.z]) + (size_t)l * 1024 * 1024;
        if (which < 2) cvt_item(W, 1024, 64 * kb, 32 * nb, (bf16*)(F.ws + WS_WMG) + (size_t)l * 1024 * 2048, 2048, which * 1024 + 64 * kb, 32 * nb, scr, F.lane, nullptr, nullptr);
        else cvt_item(W, 1024, 64 * kb, 32 * nb, (bf16*)(F.ws + WS_WO) + (size_t)l * 1024 * 1024, 1024, 64 * kb, 32 * nb, scr, F.lane, nullptr, nullptr);
    }
    float* gn = (float*)(F.ws + WS_GN);
    for (int i = F.bid * 512 + F.tid; i < DEPTH * 3 * 1024; i += F.G * 512) { const int c = i & 1023, lv = i >> 10, l = lv / 3;
        gn[i] = F.in[IN_NORMW + F.z][l * 1024 + c] * (1.f + ((const float*)(F.ws + WS_MOD))[lv * 3072 + 1024 + c]); }
}

DEV void ph_prep0(const Frame& F0) {
    Frame F = launder(F0);
    const int gw = F.bid * 8 + F.wave, NGW = F.G * 8;
    const float* nw = F.in[IN_NORMW + F.z];
    float* ssqx = (float*)(F.ws + WS_CTL + CTL_SSQX);
    for (int row = gw; row < NTOK; row += NGW) {
        const int mv = row < NCTX ? 0 : 1 + ((row - NCTX) >> 10);
        const float* md = (const float*)(F.ws + WS_MOD) + mv * 3072;
        const f32x4* xr = (const f32x4*)(row < NCTX ? F.in[IN_XP + F.z] + (size_t)row * D : F.in[IN_XS + F.z] + (size_t)(row - NCTX) * D) + F.lane;
        f32x4 v[4]; float s = 0.f;
#pragma unroll
        for (int j = 0; j < 4; ++j) { v[j] = xr[64 * j]; s += (v[j].x * v[j].x + v[j].y * v[j].y) + (v[j].z * v[j].z + v[j].w * v[j].w); }
        s = wave_sum(s);
        if (F.lane == 0) ssqx[row] = s;
        unsigned long long* o8 = (unsigned long long*)((bf16*)(F.ws + WS_HBUF) + (size_t)row * D) + F.lane;
#pragma unroll
        for (int j = 0; j < 4; ++j) { const int c0 = 4 * (F.lane + 64 * j);
            const f32x4 w4 = *(const f32x4*)(nw + c0), sc = *(const f32x4*)(md + 1024 + c0);
            v[j] = v[j] * w4 * (sc + 1.f);
            o8[64 * j] = (unsigned long long)pk2(v[j].x, v[j].y) | ((unsigned long long)pk2(v[j].z, v[j].w) << 32); }
    }
}

DEV void ph_pass(const Frame& F0, int layer) {
    Frame F = launder(F0);
    asm volatile("" : "+s"(layer));
    float* ST = (float*)(F.ws + WS_ST);
    const float* ATOT = (const float*)(F.ws + WS_ATOT);
    for (int it = F.bid * 512 + F.tid; it < 34 * 16 * 2 * 8192; it += F.G * 512) {
        const int e = it & 8191, dir = (it >> 13) & 1, h = (it >> 14) & 15, sq = it >> 18;
        int nck, ck0; float S;
        if (sq < 32) { nck = 2; ck0 = 2 * sq; S = 0.f; }
        else { const int lb = sq - 32; nck = 8; ck0 = 64 + 8 * lb; S = F.in[IN_STATE + F.z][((size_t)((lb * 4 + layer) * 2 + dir) * 16 + h) * 8192 + e]; }
        for (int i = 0; i < nck; ++i) {
            const int c = dir == 0 ? i : nck - 1 - i;
            const size_t idx = (size_t)((ck0 + c) * 16 + h) * 2 + dir;
            const float st = ST[idx * 8192 + e];
            ST[idx * 8192 + e] = S;
            S = __expf(ATOT[idx]) * S + st;
        }
        if (sq < 32) F.out[(size_t)10485760 + ((size_t)((sq * 4 + layer) * 2 + dir) * 16 + h) * 8192 + e] = S;
    }
}

DEV void ph_final(const Frame& F0) {
    Frame F = launder(F0);
    const int gw = F.bid * 8 + F.wave, NGW = F.G * 8;
    const float* nw = F.in[IN_FNW + F.z];
    const float* ssqx = (const float*)(F.ws + WS_CTL + CTL_SSQX) + 4 * NTOK;
    for (int row = gw; row < NTOK; row += NGW) {
        const f32x4* xr = (const f32x4*)((const float*)(F.ws + WS_XBUF) + (size_t)row * D) + F.lane;
        const float rstd = rsqrtf(ssqx[row] * (1.f / D) + EPS);
        f32x4* o = (f32x4*)(F.out + (size_t)row * D) + F.lane;
#pragma unroll
        for (int j = 0; j < 4; ++j) o[64 * j] = xr[64 * j] * rstd * *(const f32x4*)(nw + 4 * (F.lane + 64 * j));
    }
}

typedef short bf16x8 __attribute__((ext_vector_type(8)));
typedef short s16x4 __attribute__((ext_vector_type(4)));
typedef float f32x16 __attribute__((ext_vector_type(16)));
typedef float f32x2 __attribute__((ext_vector_type(2)));
typedef __bf16 bf16x2_t __attribute__((ext_vector_type(2)));
#define MFMA32(a, b, c) __builtin_amdgcn_mfma_f32_32x32x16_bf16((a), (b), (c), 0, 0, 0)
DEV unsigned pkbf(float a, float b) { const f32x2 v = {a, b}; return __builtin_bit_cast(unsigned, __builtin_convertvector(v, bf16x2_t)); }
DEV bf16x8 pack8(float a0, float a1, float a2, float a3, float a4, float a5, float a6, float a7) {
    u32x4 p; p.x = pkbf(a0, a1); p.y = pkbf(a2, a3); p.z = pkbf(a4, a5); p.w = pkbf(a6, a7); return __builtin_bit_cast(bf16x8, p); }
DEV int crow(int r, int hh) { return (r & 3) + 8 * (r >> 2) + 4 * hh; }

struct ChunkGeo { int seq_row0, pos0, L; bool cm; };
DEV ChunkGeo chunk_geo(int ck, int layer) {
    ChunkGeo g;
    if (ck < 64) { g.seq_row0 = (ck >> 1) * 256; g.pos0 = (ck & 1) * 128; g.L = 256; g.cm = false; }
    else { const int lb = (ck - 64) >> 3; g.seq_row0 = NCTX + lb * 1024; g.pos0 = ((ck - 64) & 7) * 128; g.L = 1024; g.cm = (layer & 1) != 0; }
    return g;
}
DEV int geo_row(const ChunkGeo& g, int Q) { return g.seq_row0 + (g.cm ? (Q & 15) * 64 + (Q >> 4) : Q); }

DEV void chunk_tables2(Frame& F, int layer, const ChunkGeo& geo, int h, LAS float* tb) {
    if (F.wave < 2) {
        const int dir = F.wave;
        const float a = -__expf(F.in[IN_ALOG + F.z][layer * 32 + dir * 16 + h]);
        const float bias = F.in[IN_DTBIAS + F.z][layer * 32 + dir * 16 + h];
        const float* dtr = (const float*)(F.ws + WS_DTRAW);
        const int q0 = 2 * F.lane;
        const float d0 = softplus_f(dtr[(size_t)geo_row(geo, geo.pos0 + q0) * 32 + dir * 16 + h] + bias);
        const float d1 = softplus_f(dtr[(size_t)geo_row(geo, geo.pos0 + q0 + 1) * 32 + dir * 16 + h] + bias);
        const float a0 = d0 * a, a1 = d1 * a;
        float sc = a0 + a1, c0, c1, tot;
        if (dir == 0) {
#pragma unroll
            for (int o = 1; o < 64; o <<= 1) { const float t = __shfl_up(sc, o); if (F.lane >= o) sc += t; }
            c1 = sc; c0 = sc - a1; tot = __shfl(c1, 63);
        } else {
#pragma unroll
            for (int o = 1; o < 64; o <<= 1) { const float t = __shfl_down(sc, o); if (F.lane + o < 64) sc += t; }
            c0 = sc; c1 = sc - a0; tot = __shfl(c0, 0);
        }
        LAS float* t = tb + dir * 128 + q0;
        t[0] = c0; t[1] = c1; t[256] = d0; t[257] = d1; t[512] = __expf(c0); t[513] = __expf(c1);
        t[768] = d0 * __expf(tot - c0); t[769] = d1 * __expf(tot - c1);
    }
    __syncthreads();
}

template <int NC, int MODE>
DEV void stage_conv(Frame& F, int layer, const ChunkGeo& geo, int col0, LAS unsigned char* img0, LAS unsigned char* img1, int pitch, const LAS float* tb) {
    constexpr int CG = NC / 8, NT = CG * 32;
    if (F.tid < NT) {
        const int cg = F.tid % CG, tg = F.tid / CG, ch0 = col0 + cg * 8, q0 = tg * 4;
        const bf16* proj = (const bf16*)(F.ws + WS_PROJ);
        float x[8][8];
#pragma unroll
        for (int i = 0; i < 8; ++i) {
            const int Q = geo.pos0 + q0 - 2 + i;
            u32x4 raw = {0u, 0u, 0u, 0u};
            if (Q >= 0 && Q < geo.L) raw = *(const u32x4*)(proj + (size_t)geo_row(geo, Q) * NPROJ + PC_XBC + ch0);
            x[i][0] = bf2f(raw.x & 0xffffu); x[i][1] = bf2f(raw.x >> 16); x[i][2] = bf2f(raw.y & 0xffffu); x[i][3] = bf2f(raw.y >> 16);
            x[i][4] = bf2f(raw.z & 0xffffu); x[i][5] = bf2f(raw.z >> 16); x[i][6] = bf2f(raw.w & 0xffffu); x[i][7] = bf2f(raw.w >> 16);
        }
        const float* cw = F.in[IN_CONVW + F.z] + layer * 5 * 2048 + ch0; const float* cb = F.in[IN_CONVB + F.z] + layer * 2048 + ch0;
        float acc[4][8];
        { const f32x4 b0 = *(const f32x4*)cb, b1 = *(const f32x4*)(cb + 4);
#pragma unroll
          for (int t = 0; t < 4; ++t) { acc[t][0] = b0.x; acc[t][1] = b0.y; acc[t][2] = b0.z; acc[t][3] = b0.w; acc[t][4] = b1.x; acc[t][5] = b1.y; acc[t][6] = b1.z; acc[t][7] = b1.w; } }
#pragma unroll
        for (int k = 0; k < 5; ++k) {
            const f32x4 w0 = *(const f32x4*)(cw + k * 2048), w1 = *(const f32x4*)(cw + k * 2048 + 4);
            const float w[8] = {w0.x, w0.y, w0.z, w0.w, w1.x, w1.y, w1.z, w1.w};
#pragma unroll
            for (int t = 0; t < 4; ++t)
#pragma unroll
                for (int c = 0; c < 8; ++c) acc[t][c] += w[c] * x[t + k][c];
        }
#pragma unroll
        for (int t = 0; t < 4; ++t) {
            float v[8];
#pragma unroll
            for (int c = 0; c < 8; ++c) v[c] = silu_f(acc[t][c]);
            const int s = q0 + t;
            if (MODE == 0) {
                u32x4 o; o.x = pkbf(v[0], v[1]); o.y = pkbf(v[2], v[3]); o.z = pkbf(v[4], v[5]); o.w = pkbf(v[6], v[7]);
                *(LAS u32x4*)(img0 + s * pitch + cg * 16) = o;
            } else {
                const float sf = tb[768 + s], sb = tb[896 + s];
                u32x4 o; o.x = pkbf(v[0] * sf, v[1] * sf); o.y = pkbf(v[2] * sf, v[3] * sf); o.z = pkbf(v[4] * sf, v[5] * sf); o.w = pkbf(v[6] * sf, v[7] * sf);
                *(LAS u32x4*)(img0 + s * pitch + cg * 16) = o;
                o.x = pkbf(v[0] * sb, v[1] * sb); o.y = pkbf(v[2] * sb, v[3] * sb); o.z = pkbf(v[4] * sb, v[5] * sb); o.w = pkbf(v[6] * sb, v[7] * sb);
                *(LAS u32x4*)(img1 + s * pitch + cg * 16) = o;
            }
        }
    }
}

DEV bf16x8 tr2(const LAS unsigned char* img, int pitch, int row0, int row1, int col0, int lane) {
    const int i = lane & 15, blk = (lane >> 4) & 1;
    const int off = (i >> 2) * pitch + (col0 + 16 * blk + 4 * (i & 3)) * 2;
    const s16x4 lo = __builtin_amdgcn_ds_read_tr16_b64_v4i16((LAS s16x4*)(img + row0 * pitch + off));
    const s16x4 hi = __builtin_amdgcn_ds_read_tr16_b64_v4i16((LAS s16x4*)(img + row1 * pitch + off));
    return __builtin_shufflevector(lo, hi, 0, 1, 2, 3, 4, 5, 6, 7);
}

DEV void ph_s1(const Frame& F0, int layer) {
    Frame F = launder(F0);
    asm volatile("" : "+s"(layer));
    LAS float* tb = (LAS float*)F.lds;
    LAS unsigned char* Bi = F.lds + 4096;
    LAS unsigned char* XF = Bi + 128 * 320;
    LAS unsigned char* XB = XF + 128 * 192;
    float* ST = (float*)(F.ws + WS_ST);
    float* ATOT = (float*)(F.ws + WS_ATOT);
    const int hh = F.lane >> 5, wpi = F.wave >> 2, wni = F.wave & 3;
    for (int vb = F.bid; vb < NCHUNK * NH; vb += F.G) {
        const int ck = vb >> 4, h = vb & 15, g = h >> 2;
        const ChunkGeo geo = chunk_geo(ck, layer);
        __syncthreads();
        chunk_tables2(F, layer, geo, h, tb);
        stage_conv<128, 0>(F, layer, geo, 1024 + g * 128, Bi, Bi, 320, tb);
        stage_conv<64, 1>(F, layer, geo, h * 64, XF, XB, 192, tb);
        __syncthreads();
        f32x16 af, ab;
#pragma unroll
        for (int r = 0; r < 16; ++r) { af[r] = 0.f; ab[r] = 0.f; }
#pragma unroll
        for (int ks = 0; ks < 8; ++ks) {
            const int k0 = 16 * ks + 8 * hh;
            const bf16x8 b = tr2(Bi, 320, k0, k0 + 4, 32 * wni, F.lane);
            const bf16x8 xf = tr2(XF, 192, k0, k0 + 4, 32 * wpi, F.lane);
            const bf16x8 xb = tr2(XB, 192, k0, k0 + 4, 32 * wpi, F.lane);
            af = MFMA32(xf, b, af); ab = MFMA32(xb, b, ab);
        }
        float* o0 = ST + (size_t)(vb * 2) * 8192 + (32 * wpi) * 128 + 32 * wni + (F.lane & 31);
#pragma unroll
        for (int r = 0; r < 16; ++r) { const int p = crow(r, hh); o0[p * 128] = af[r]; o0[8192 + p * 128] = ab[r]; }
        if (F.tid == 0) { ATOT[vb * 2] = tb[127]; ATOT[vb * 2 + 1] = tb[128]; }
    }
}

DEV void ph_s2(const Frame& F0, int layer) {
    Frame F = launder(F0);
    asm volatile("" : "+s"(layer));
    LAS float* tb = (LAS float*)F.lds;
    LAS unsigned char* Ci = F.lds + 4096;
    LAS unsigned char* Bi = Ci + 128 * 272;
    LAS unsigned char* Xi = Bi + 128 * 272;
    LAS unsigned char* stg = Ci;
    const float* ST = (const float*)(F.ws + WS_ST);
    const bf16* proj = (const bf16*)(F.ws + WS_PROJ);
    bf16* AM = (bf16*)(F.ws + WS_AMG);
    float* SSQ = (float*)(F.ws + WS_CTL + CTL_SSQ) + layer * NTOK;
    const int hh = F.lane >> 5, li = F.wave & 3, sh = F.wave >> 2, l31 = F.lane & 31;
    for (int vb = F.bid; vb < NCHUNK * NH; vb += F.G) {
        const int ck = vb >> 4, h = vb & 15, g = h >> 2;
        const ChunkGeo geo = chunk_geo(ck, layer);
        __syncthreads();
        chunk_tables2(F, layer, geo, h, tb);
        stage_conv<128, 0>(F, layer, geo, 1536 + g * 128, Ci, Ci, 272, tb);
        stage_conv<128, 0>(F, layer, geo, 1024 + g * 128, Bi, Bi, 272, tb);
        stage_conv<64, 0>(F, layer, geo, h * 64, Xi, Xi, 192, tb);
        __syncthreads();
        const float dsk = F.in[IN_DSKIP + F.z][layer * 16 + h];
        const int l = 32 * li + l31;
        bf16x8 cf[8];
#pragma unroll
        for (int ks = 0; ks < 8; ++ks) cf[ks] = *(const LAS bf16x8*)(Ci + l * 272 + (16 * ks + 8 * hh) * 2);
        const float acFl = tb[l], acBl = tb[128 + l];
        f32x16 accd[2];
#pragma unroll
        for (int r = 0; r < 16; ++r) { accd[0][r] = 0.f; accd[1][r] = 0.f; }
#pragma unroll
        for (int sj = 0; sj < 2; ++sj) {
            const int si = 2 * sh + sj;
            f32x16 gt;
#pragma unroll
            for (int r = 0; r < 16; ++r) gt[r] = 0.f;
#pragma unroll
            for (int ks = 0; ks < 8; ++ks) { const bf16x8 a = *(const LAS bf16x8*)(Bi + (32 * si + l31) * 272 + (16 * ks + 8 * hh) * 2); gt = MFMA32(a, cf[ks], gt); }
            float m[16];
#pragma unroll
            for (int r = 0; r < 16; ++r) {
                const int s = 32 * si + crow(r, hh);
                const float wf = __expf(fminf(acFl - tb[s], 0.f)) * tb[256 + s], wb = __expf(fminf(acBl - tb[128 + s], 0.f)) * tb[384 + s];
                const float w = l > s ? wf : (l < s ? wb : tb[256 + s] + tb[384 + s]);
                m[r] = gt[r] * w + (l == s ? dsk : 0.f);
            }
#pragma unroll
            for (int t = 0; t < 2; ++t) {
                const bf16x8 ma = pack8(m[8 * t], m[8 * t + 1], m[8 * t + 2], m[8 * t + 3], m[8 * t + 4], m[8 * t + 5], m[8 * t + 6], m[8 * t + 7]);
                const int r0 = 32 * si + 16 * t + 4 * hh;
#pragma unroll
                for (int pi = 0; pi < 2; ++pi) { const bf16x8 xb = tr2(Xi, 192, r0, r0 + 8, 32 * pi, F.lane); accd[pi] = MFMA32(ma, xb, accd[pi]); }
            }
        }
        const float* S = ST + (size_t)(vb * 2 + sh) * 8192;
#pragma unroll
        for (int pi = 0; pi < 2; ++pi) {
            f32x16 acco;
#pragma unroll
            for (int r = 0; r < 16; ++r) acco[r] = 0.f;
#pragma unroll
            for (int ks = 0; ks < 8; ++ks) {
                const float* sp = S + (32 * pi + l31) * 128 + 16 * ks + 8 * hh;
                const f32x4 s0 = *(const f32x4*)sp, s1 = *(const f32x4*)(sp + 4);
                const bf16x8 sb = pack8(s0.x, s0.y, s0.z, s0.w, s1.x, s1.y, s1.z, s1.w);
                acco = MFMA32(cf[ks], sb, acco);
            }
#pragma unroll
            for (int r = 0; r < 16; ++r) accd[pi][r] += tb[512 + sh * 128 + 32 * li + crow(r, hh)] * acco[r];
        }
        __syncthreads();
#pragma unroll
        for (int pi = 0; pi < 2; ++pi)
#pragma unroll
            for (int r = 0; r < 16; ++r) *(LAS float*)(stg + sh * (128 * 272) + (32 * li + crow(r, hh)) * 272 + (32 * pi + l31) * 4) = accd[pi][r];
        __syncthreads();
        const int c4 = F.lane & 15;
        const f32x4 nw = *(const f32x4*)(F.in[IN_SSMNW + F.z] + layer * D + h * 64 + 4 * c4);
#pragma unroll
        for (int v = 0; v < 4; ++v) {
            const int lr = F.wave * 16 + 4 * v + (F.lane >> 4);
            const f32x4 y0 = *(const LAS f32x4*)(stg + lr * 272 + c4 * 16), y1 = *(const LAS f32x4*)(stg + 128 * 272 + lr * 272 + c4 * 16);
            const int row = geo_row(geo, geo.pos0 + lr);
            const u32x2 zr = *(const u32x2*)(proj + (size_t)row * NPROJ + PC_ZM + h * 64 + 4 * c4);
            f32x4 y = y0 + y1;
            y.x *= bf2f(zr.x & 0xffffu); y.y *= bf2f(zr.x >> 16); y.z *= bf2f(zr.y & 0xffffu); y.w *= bf2f(zr.y >> 16);
            float q = (y.x * y.x + y.y * y.y) + (y.z * y.z + y.w * y.w);
            q += __shfl_xor(q, 1); q += __shfl_xor(q, 2); q += __shfl_xor(q, 4); q += __shfl_xor(q, 8);
            if (c4 == 0) atomicAdd(SSQ + row, q);
            y = y * nw;
            u32x2 o; o.x = pkbf(y.x, y.y); o.y = pkbf(y.z, y.w);
            *(u32x2*)(AM + (size_t)row * 2048 + h * 64 + 4 * c4) = o;
        }
    }
}

DEV void ph_gmlp2(const Frame& F0, int layer) {
    Frame F = launder(F0);
    asm volatile("" : "+s"(layer));
    LAS unsigned char* Vi = F.lds;
    LAS unsigned char* stg = F.lds + 128 * 320;
    const bf16* proj = (const bf16*)(F.ws + WS_PROJ);
    const float* gsum = (const float*)(F.ws + WS_CTL + CTL_GSUM) + (size_t)layer * NTOK * 2;
    bf16* ag = (bf16*)(F.ws + WS_AMG) + 1024;
    const int hh = F.lane >> 5, ti = F.wave >> 1, cj = F.wave & 1, l31 = F.lane & 31;
    for (int vb = F.bid; vb < NCHUNK * 8; vb += F.G) {
        const int ck = vb >> 3, g = vb & 7;
        __syncthreads();
        {
            const int s = F.tid >> 2, c0 = (F.tid & 3) * 32, row = ck * 128 + s;
            const float mu = gsum[row * 2] * (1.f / D), rstd = rsqrtf(fmaxf(gsum[row * 2 + 1] * (1.f / D) - mu * mu, 0.f) + EPS);
            const float* lnw = F.in[IN_LNW + F.z] + layer * D + g * 128 + c0; const float* lnb = F.in[IN_LNB + F.z] + layer * D + g * 128 + c0;
#pragma unroll
            for (int j = 0; j < 4; ++j) {
                const u32x4 r = *(const u32x4*)(proj + (size_t)row * NPROJ + PC_V + g * 128 + c0 + 8 * j);
                const f32x4 w0 = *(const f32x4*)(lnw + 8 * j), w1 = *(const f32x4*)(lnw + 8 * j + 4), b0 = *(const f32x4*)(lnb + 8 * j), b1 = *(const f32x4*)(lnb + 8 * j + 4);
                float v[8] = {bf2f(r.x & 0xffffu), bf2f(r.x >> 16), bf2f(r.y & 0xffffu), bf2f(r.y >> 16), bf2f(r.z & 0xffffu), bf2f(r.z >> 16), bf2f(r.w & 0xffffu), bf2f(r.w >> 16)};
                const float ww[8] = {w0.x, w0.y, w0.z, w0.w, w1.x, w1.y, w1.z, w1.w}, bb[8] = {b0.x, b0.y, b0.z, b0.w, b1.x, b1.y, b1.z, b1.w};
#pragma unroll
                for (int c = 0; c < 8; ++c) v[c] = (v[c] - mu) * rstd * ww[c] + bb[c];
                u32x4 o; o.x = pkbf(v[0], v[1]); o.y = pkbf(v[2], v[3]); o.z = pkbf(v[4], v[5]); o.w = pkbf(v[6], v[7]);
                *(LAS u32x4*)(Vi + s * 320 + (c0 + 8 * j) * 2) = o;
            }
        }
        __syncthreads();
        const float* wsp = F.in[IN_WSP + F.z] + (size_t)(layer * 8 + g) * 128 * 128 + (32 * ti + l31) * 128;
        f32x16 acc[2];
#pragma unroll
        for (int r = 0; r < 16; ++r) { acc[0][r] = 0.f; acc[1][r] = 0.f; }
#pragma unroll
        for (int ks = 0; ks < 8; ++ks) {
            const int k0 = 16 * ks + 8 * hh;
            const f32x4 a0 = *(const f32x4*)(wsp + k0), a1 = *(const f32x4*)(wsp + k0 + 4);
            const bf16x8 a = pack8(a0.x, a0.y, a0.z, a0.w, a1.x, a1.y, a1.z, a1.w);
#pragma unroll
            for (int c = 0; c < 2; ++c) { const bf16x8 b = tr2(Vi, 320, k0, k0 + 4, 64 * cj + 32 * c, F.lane); acc[c] = MFMA32(a, b, acc[c]); }
        }
#pragma unroll
        for (int c = 0; c < 2; ++c)
#pragma unroll
            for (int r = 0; r < 16; ++r) *(LAS float*)(stg + (32 * ti + crow(r, hh)) * 528 + (64 * cj + 32 * c + l31) * 4) = acc[c][r];
        __syncthreads();
        const float* bsp = F.in[IN_BSP + F.z] + (layer * 8 + g) * 128;
#pragma unroll
        for (int v = 0; v < 8; ++v) {
            const int t = F.wave * 16 + 2 * v + hh, row = ck * 128 + t;
            const f32x4 sv = *(const LAS f32x4*)(stg + t * 528 + l31 * 16) + bsp[t];
            const u32x2 ur = *(const u32x2*)(proj + (size_t)row * NPROJ + PC_U + g * 128 + 4 * l31), zr = *(const u32x2*)(proj + (size_t)row * NPROJ + PC_ZG + g * 128 + 4 * l31);
            u32x2 o;
            o.x = pkbf(bf2f(ur.x & 0xffffu) * sv.x * bf2f(zr.x & 0xffffu), bf2f(ur.x >> 16) * sv.y * bf2f(zr.x >> 16));
            o.y = pkbf(bf2f(ur.y & 0xffffu) * sv.z * bf2f(zr.y & 0xffffu), bf2f(ur.y >> 16) * sv.w * bf2f(zr.y >> 16));
            *(u32x2*)(ag + (size_t)row * 2048 + g * 128 + 4 * l31) = o;
        }
    }
}

DEV void ph_dt(const Frame& F0, int layer) {
    Frame F = launder(F0);
    asm volatile("" : "+s"(layer));
    const int hh = F.lane >> 5, l31 = F.lane & 31;
    for (int pm = F.bid; pm < NTOK / 256; pm += F.G) {
        const bf16* A = (const bf16*)(F.ws + WS_HBUF) + (size_t)(pm * 256 + F.wave * 32 + l31) * D + 8 * hh;
        const bf16* B = (const bf16*)(F.ws + WS_WDT) + (size_t)layer * 32 * 1024 + (size_t)l31 * 1024 + 8 * hh;
        f32x16 acc;
#pragma unroll
        for (int r = 0; r < 16; ++r) acc[r] = 0.f;
#pragma unroll 8
        for (int ks = 0; ks < 64; ++ks) { const bf16x8 a = *(const bf16x8*)(A + 16 * ks), b = *(const bf16x8*)(B + 16 * ks); acc = MFMA32(a, b, acc); }
        float* o = (float*)(F.ws + WS_DTRAW) + (size_t)(pm * 256 + F.wave * 32) * 32 + l31;
        const float* ssqx = (const float*)(F.ws + WS_CTL + CTL_SSQX) + (size_t)layer * NTOK + pm * 256 + F.wave * 32;
        const float swv = ((const float*)(F.ws + WS_CTL + CTL_SW))[(size_t)(layer * 3 + (pm < 32 ? 0 : 1 + ((pm - 32) >> 2))) * DIN + 3072 + l31];
#pragma unroll
        for (int r = 0; r < 16; ++r) o[crow(r, hh) * 32] = acc[r] * rsqrtf(ssqx[crow(r, hh)] * (1.f / D) + EPS) + swv;
    }
}

#define XB_TMO      128
#define XB_XCNT(j)  (256  + 64 * (j))
#define XB_XSUB(j)  (1280 + 64 * (j))
#define XB_XGEN(j)  (2304 + 64 * (j))
#define XB_TOP      3328
#define XB_TOPGEN   3392
#define XCD_BAR_WORDS 3456
#define XB_SPIN_CAP (1u << 18)

__device__ __forceinline__ unsigned xb_ld(unsigned* p)              { return __hip_atomic_load(p, __ATOMIC_RELAXED, __HIP_MEMORY_SCOPE_AGENT); }
__device__ __forceinline__ unsigned xb_add(unsigned* p, unsigned v) { return __hip_atomic_fetch_add(p, v, __ATOMIC_RELAXED, __HIP_MEMORY_SCOPE_AGENT); }
__device__ __forceinline__ unsigned xb_xcc_id() { return (unsigned)__builtin_amdgcn_s_getreg((3 << 11) | 20) & 0xFu; }
#define XB_SPIN(cond, bar) do { unsigned _sp = 0; while (cond) { __builtin_amdgcn_s_sleep(1); \
    if ((++_sp & 255u) == 0u) { if (xb_ld(&(bar)[XB_TMO])) break; if (_sp > XB_SPIN_CAP) { atomicAdd(&(bar)[XB_TMO], 1u); break; } } } } while (0)

struct XcdBarrier {
    unsigned* bar; unsigned x;
    volatile LAS unsigned* st;
};

__device__ __forceinline__ XcdBarrier xcd_barrier_post(unsigned* bar, volatile LAS unsigned* st) {
    XcdBarrier b; b.bar = bar; b.x = xb_xcc_id(); b.st = st;
    if (threadIdx.x == 0) (void)xb_add(&bar[XB_XCNT(b.x)], 1u);
    return b;
}
__device__ __forceinline__ void xcd_barrier_complete(unsigned* bar, unsigned x, unsigned& nloc, unsigned& nx) {
    const unsigned G = gridDim.x * gridDim.y * gridDim.z;
    unsigned sum, cnt, mine, sp = 0u;
    for (;;) {
        sum = 0u; cnt = 0u; mine = 0u;
#pragma unroll
        for (unsigned j = 0; j < 16; ++j) { const unsigned c = xb_ld(&bar[XB_XCNT(j)]); sum += c; cnt += (c > 0u) ? 1u : 0u; mine = (j == x) ? c : mine; }
        if (sum == G) break;
        __builtin_amdgcn_s_sleep(1);
        if ((++sp & 255u) == 0u) { if (xb_ld(&bar[XB_TMO])) break; if (sp > XB_SPIN_CAP) { atomicAdd(&bar[XB_TMO], 1u); break; } }
    }
    nloc = mine > 0u ? mine : 1u; nx = cnt > 0u ? cnt : 1u;
}

__device__ __forceinline__ void xcd_barrier(const XcdBarrier& b) {
    asm volatile("s_waitcnt vmcnt(0)" ::: "memory");
    __syncthreads();
    if (threadIdx.x == 0) {
        unsigned* bar = b.bar;
        __builtin_amdgcn_s_waitcnt(0);
        unsigned nloc = b.st[0], nx = b.st[1];
        if (nloc == 0u) { xcd_barrier_complete(bar, b.x, nloc, nx); b.st[0] = nloc; b.st[1] = nx; }
        const unsigned old = xb_add(&bar[XB_XSUB(b.x)], 1u);
        const unsigned gen = old / nloc;
        if (old + 1u == (gen + 1u) * nloc) {
            __builtin_amdgcn_fence(__ATOMIC_RELEASE, "agent");
            asm volatile("s_waitcnt vmcnt(0)" ::: "memory");
            const unsigned og = xb_add(&bar[XB_TOP], 1u);
            const unsigned tg = og / nx;
            if (og + 1u == (tg + 1u) * nx) xb_add(&bar[XB_TOPGEN], 1u);
            else XB_SPIN(xb_ld(&bar[XB_TOPGEN]) == tg, bar);
            __builtin_amdgcn_fence(__ATOMIC_ACQUIRE, "agent");
            xb_add(&bar[XB_XGEN(b.x)], 1u);
            asm volatile("s_waitcnt vmcnt(0)" ::: "memory");
        } else {
            XB_SPIN(xb_ld(&bar[XB_XGEN(b.x)]) == gen, bar);
            __builtin_amdgcn_fence(__ATOMIC_ACQUIRE, "agent");
            asm volatile("s_waitcnt vmcnt(0)" ::: "memory");
        }
    }
    __syncthreads();
}

struct EpiIn {
    static constexpr bool PERM = true, AFTER_DRAIN = false, HAS_MID = false;
    bf16* O; const float* ssqx; const float* sw; float* gsum;
    __device__ __forceinline__ void operator()(const f32x4 (&acc)[2][2][4][2], const pg8::Unit& u, int wr, int wc, int fr, int fq) const {
        int row0 = u.pm * 256 + wr * 64 + fr, col0 = u.pn * 256 + wc * 32 + 8 * fq;
        asm volatile("" : "+v"(row0), "+v"(col0));
        const int mv = u.pm < 32 ? 0 : 1 + ((u.pm - 32) >> 2);
        const int kind = u.pn < 8 ? 0 : u.pn < 12 ? 1 : u.pn < 20 ? 2 : u.pn < 24 ? 1 : 3;
        const bool stats = (u.pn >= 16 && u.pn < 20);
        const float* swp = sw + mv * DIN + col0 + (u.pn >= 12 ? 32 : 0);
        f32x4 bv[2][2];
#pragma unroll
        for (int bj = 0; bj < 2; ++bj)
#pragma unroll
            for (int n = 0; n < 2; ++n) bv[bj][n] = *(const f32x4*)(swp + bj * 128 + 4 * n);
#pragma unroll
        for (int ai = 0; ai < 2; ++ai)
#pragma unroll
            for (int m = 0; m < 4; ++m) {
                const int r = row0 + ai * 128 + m * 16;
                const float rs = rsqrtf(ssqx[r] * (1.f / D) + EPS);
                float s1 = 0.f, s2 = 0.f;
#pragma unroll
                for (int bj = 0; bj < 2; ++bj) {
                    float v[8];
#pragma unroll
                    for (int j = 0; j < 4; ++j) { v[j] = acc[ai][bj][m][0][j] * rs + bv[bj][0][j]; v[4 + j] = acc[ai][bj][m][1][j] * rs + bv[bj][1][j]; }
                    if (kind == 1) {
#pragma unroll
                        for (int j = 0; j < 8; ++j) v[j] = silu_f(v[j]);
                    } else if (kind == 2) {
#pragma unroll
                        for (int j = 0; j < 8; ++j) v[j] = gelu_f(v[j]);
                    } else if (kind == 3) {
#pragma unroll
                        for (int j = 0; j < 8; ++j) v[j] = sigmoid_f(v[j]);
                    }
                    if (stats) {
#pragma unroll
                        for (int j = 0; j < 8; ++j) { s1 += v[j]; s2 += v[j] * v[j]; }
                    }
                    u32x4 w; w.x = pkbf(v[0], v[1]); w.y = pkbf(v[2], v[3]); w.z = pkbf(v[4], v[5]); w.w = pkbf(v[6], v[7]);
                    *(u32x4*)(O + (size_t)r * NPROJ + col0 + bj * 128) = w;
                }
                if (stats) {
                    s1 += __shfl_xor(s1, 16); s1 += __shfl_xor(s1, 32); s2 += __shfl_xor(s2, 16); s2 += __shfl_xor(s2, 32);
                    if (fq == 0) { atomicAdd(gsum + 2 * r, s1); atomicAdd(gsum + 2 * r + 1, s2); }
                }
                asm volatile("" ::: "memory");
            }
    }
};
struct EpiMerge {
    static constexpr bool PERM = true, AFTER_DRAIN = false, HAS_MID = true;
    bf16* O; const bf16* proj; const float* ssq;
    __device__ __forceinline__ void mid(f32x4 (&acc)[2][2][4][2], const pg8::Unit& u, int wr, int wc, int fr, int fq) const {
        int row0 = u.pm * 256 + wr * 64 + fr, col0 = u.pn * 256 + wc * 32 + 8 * fq;
        asm volatile("" : "+v"(row0), "+v"(col0));
#pragma unroll
        for (int ai = 0; ai < 2; ++ai)
#pragma unroll
            for (int m = 0; m < 4; ++m) {
                const int r = row0 + ai * 128 + m * 16;
                const float rs = rsqrtf(ssq[r] * (1.f / D) + EPS);
#pragma unroll
                for (int bj = 0; bj < 2; ++bj) {
                    const u32x4 gm = *(const u32x4*)(proj + (size_t)r * NPROJ + PC_GLM + col0 + bj * 128), gg = *(const u32x4*)(proj + (size_t)r * NPROJ + PC_GLG + col0 + bj * 128);
                    acc[ai][bj][m][0][0] *= bf2f(gm.x & 0xffffu) * rs / bf2f(gg.x & 0xffffu); acc[ai][bj][m][0][1] *= bf2f(gm.x >> 16) * rs / bf2f(gg.x >> 16);
                    acc[ai][bj][m][0][2] *= bf2f(gm.y & 0xffffu) * rs / bf2f(gg.y & 0xffffu); acc[ai][bj][m][0][3] *= bf2f(gm.y >> 16) * rs / bf2f(gg.y >> 16);
                    acc[ai][bj][m][1][0] *= bf2f(gm.z & 0xffffu) * rs / bf2f(gg.z & 0xffffu); acc[ai][bj][m][1][1] *= bf2f(gm.z >> 16) * rs / bf2f(gg.z >> 16);
                    acc[ai][bj][m][1][2] *= bf2f(gm.w & 0xffffu) * rs / bf2f(gg.w & 0xffffu); acc[ai][bj][m][1][3] *= bf2f(gm.w >> 16) * rs / bf2f(gg.w >> 16);
                }
                asm volatile("" ::: "memory");
            }
    }
    __device__ __forceinline__ void operator()(const f32x4 (&acc)[2][2][4][2], const pg8::Unit& u, int wr, int wc, int fr, int fq) const {
        int row0 = u.pm * 256 + wr * 64 + fr, col0 = u.pn * 256 + wc * 32 + 8 * fq;
        asm volatile("" : "+v"(row0), "+v"(col0));
#pragma unroll
        for (int ai = 0; ai < 2; ++ai)
#pragma unroll
            for (int m = 0; m < 4; ++m) {
                const int r = row0 + ai * 128 + m * 16;
#pragma unroll
                for (int bj = 0; bj < 2; ++bj) {
                    const u32x4 gg = *(const u32x4*)(proj + (size_t)r * NPROJ + PC_GLG + col0 + bj * 128);
                    u32x4 w;
                    w.x = pkbf(acc[ai][bj][m][0][0] * bf2f(gg.x & 0xffffu), acc[ai][bj][m][0][1] * bf2f(gg.x >> 16));
                    w.y = pkbf(acc[ai][bj][m][0][2] * bf2f(gg.y & 0xffffu), acc[ai][bj][m][0][3] * bf2f(gg.y >> 16));
                    w.z = pkbf(acc[ai][bj][m][1][0] * bf2f(gg.z & 0xffffu), acc[ai][bj][m][1][1] * bf2f(gg.z >> 16));
                    w.w = pkbf(acc[ai][bj][m][1][2] * bf2f(gg.w & 0xffffu), acc[ai][bj][m][1][3] * bf2f(gg.w >> 16));
                    *(u32x4*)(O + (size_t)r * D + col0 + bj * 128) = w;
                }
                asm volatile("" ::: "memory");
            }
    }
};
struct EpiOut {
    static constexpr bool PERM = true, AFTER_DRAIN = false, HAS_MID = false;
    const float* xp; const float* xs; const float* xold; float* xnew; bf16* hx; const float* mod; const float* gn; float* ssqn;
    __device__ __forceinline__ void operator()(const f32x4 (&acc)[2][2][4][2], const pg8::Unit& u, int wr, int wc, int fr, int fq) const {
        int row0 = u.pm * 256 + wr * 64 + fr, col0 = u.pn * 256 + wc * 32 + 8 * fq;
        asm volatile("" : "+v"(row0), "+v"(col0));
        const int mv = u.pm < 32 ? 0 : 1 + ((u.pm - 32) >> 2);
        const float* xo = xold ? xold : (u.pm < 32 ? xp : xs - (size_t)NCTX * D);
        const float* gate = mod + mv * 3072 + 2048 + col0;
        const float* g2 = gn ? gn + mv * 1024 + col0 : nullptr;
#pragma unroll
        for (int ai = 0; ai < 2; ++ai)
#pragma unroll
            for (int m = 0; m < 4; ++m) {
                const int r = row0 + ai * 128 + m * 16;
                float q = 0.f;
#pragma unroll
                for (int bj = 0; bj < 2; ++bj) {
                    const size_t off = (size_t)r * D + col0 + bj * 128;
                    const f32x4 x0 = *(const f32x4*)(xo + off), x1 = *(const f32x4*)(xo + off + 4);
                    const f32x4 ga0 = *(const f32x4*)(gate + bj * 128), ga1 = *(const f32x4*)(gate + bj * 128 + 4);
                    const f32x4 n0 = x0 + ga0 * acc[ai][bj][m][0], n1 = x1 + ga1 * acc[ai][bj][m][1];
                    *(f32x4*)(xnew + off) = n0; *(f32x4*)(xnew + off + 4) = n1;
                    q += (n0.x * n0.x + n0.y * n0.y) + (n0.z * n0.z + n0.w * n0.w) + (n1.x * n1.x + n1.y * n1.y) + (n1.z * n1.z + n1.w * n1.w);
                    if (g2) { const f32x4 h0 = n0 * *(const f32x4*)(g2 + bj * 128), h1 = n1 * *(const f32x4*)(g2 + bj * 128 + 4);
                        u32x4 w; w.x = pkbf(h0.x, h0.y); w.y = pkbf(h0.z, h0.w); w.z = pkbf(h1.x, h1.y); w.w = pkbf(h1.z, h1.w);
                        *(u32x4*)(hx + off) = w; }
                }
                q += __shfl_xor(q, 16); q += __shfl_xor(q, 32);
                if (fq == 0) atomicAdd(ssqn + r, q);
                asm volatile("" ::: "memory");
            }
    }
};

constexpr int CW_BAR = 4096;
constexpr int MISC_OFF = LDS_BYTES - 256;

__global__ void __launch_bounds__(512, 2) mega(Args args) {
    extern __shared__ __attribute__((aligned(16))) unsigned char lds[];
    Frame F;
    F.lds = (LAS unsigned char*)lds; F.tid = threadIdx.x; F.lane = F.tid & 63; F.wave = __builtin_amdgcn_readfirstlane(F.tid >> 6);
    F.G = gridDim.x; F.bid = blockIdx.x; F.in = args.in; F.out = args.out; F.ws = args.ws; F.z = 0;
    volatile LAS unsigned* MISC = (volatile LAS unsigned*)(F.lds + MISC_OFF);
    if (F.tid < 64) MISC[F.tid] = 0u;
    __syncthreads();
    (void)xcd_barrier_post((unsigned*)(F.ws + WS_CTL) + CW_BAR, MISC + 8);
#define GRID_BAR() do { Frame Fb = launder(F); XcdBarrier b_; b_.bar = (unsigned*)(Fb.ws + WS_CTL) + CW_BAR; b_.x = xb_xcc_id(); b_.st = (volatile LAS unsigned*)(Fb.lds + MISC_OFF) + 8; xcd_barrier(b_); } while (0)
    ph_mod(F); GRID_BAR();
    ph_cvt(F); ph_prep0(F); GRID_BAR();
    for (int layer = 0; layer < DEPTH; ++layer) {
        { Frame Fg = launder(F);
          pg8::Gemm g{(const bf16*)(Fg.ws + WS_HBUF), (const bf16*)(Fg.ws + WS_WIN) + (size_t)layer * NPROJ * 1024, NTOK, NPROJ, D};
          pg8::StaticOrder S; S.init(NTOK, NPROJ, Fg.G, Fg.bid);
          EpiIn E{(bf16*)(Fg.ws + WS_PROJ), (const float*)(Fg.ws + WS_CTL + CTL_SSQX) + (size_t)layer * NTOK, (const float*)(Fg.ws + WS_CTL + CTL_SW) + (size_t)layer * 3 * DIN,
                  (float*)(Fg.ws + WS_CTL + CTL_GSUM) + (size_t)layer * NTOK * 2};
          pg8::gemm_phase<EpiIn, pg8::StaticOrder, true, true>(Fg.lds, g, S, E); }
        ph_dt(F, layer);
        GRID_BAR();
        ph_s1(F, layer); GRID_BAR();
        ph_pass(F, layer); GRID_BAR();
        ph_s2(F, layer); ph_gmlp2(F, layer); GRID_BAR();
        { Frame Fg = launder(F);
          pg8::Gemm g{(const bf16*)(Fg.ws + WS_AMG), (const bf16*)(Fg.ws + WS_WMG) + (size_t)layer * 1024 * 2048, NTOK, D, 2048};
          pg8::StaticOrder S; S.init(NTOK, D, Fg.G, Fg.bid);
          EpiMerge E{(bf16*)(Fg.ws + WS_MRG), (const bf16*)(Fg.ws + WS_PROJ), (const float*)(Fg.ws + WS_CTL + CTL_SSQ) + (size_t)layer * NTOK};
          pg8::gemm_phase<EpiMerge, pg8::StaticOrder, true, true>(Fg.lds, g, S, E); }
        GRID_BAR();
        { Frame Fg = launder(F);
          pg8::Gemm g{(const bf16*)(Fg.ws + WS_MRG), (const bf16*)(Fg.ws + WS_WO) + (size_t)layer * 1024 * 1024, NTOK, D, D};
          pg8::StaticOrder S; S.init(NTOK, D, Fg.G, Fg.bid);
          EpiOut E{Fg.in[IN_XP + Fg.z], Fg.in[IN_XS + Fg.z], layer == 0 ? nullptr : (const float*)(Fg.ws + WS_XBUF), (float*)(Fg.ws + WS_XBUF), (bf16*)(Fg.ws + WS_HBUF),
                   (const float*)(Fg.ws + WS_MOD) + (size_t)layer * 3 * 3072, layer + 1 < DEPTH ? (const float*)(Fg.ws + WS_GN) + (size_t)(layer + 1) * 3 * 1024 : nullptr,
                   (float*)(Fg.ws + WS_CTL + CTL_SSQX) + (size_t)(layer + 1) * NTOK};
          pg8::gemm_phase<EpiOut, pg8::StaticOrder, true, true>(Fg.lds, g, S, E); }
        GRID_BAR();
    }
    ph_final(F);
}

extern "C" void kernel_launch(void* const* d_in, const int* in_sizes, int n_in, void* d_out, int out_size, void* d_ws, size_t ws_size, hipStream_t stream) {
    static int grid = 0;
    if (grid == 0) {
        if (n_in != 23 || ws_size < WS_END) { fprintf(stderr, "kernel_launch: need 23 inputs and %zu bytes of workspace; got %d, %zu\n", (size_t)WS_END, n_in, ws_size); grid = -1; return; }
        int dev = 0, cus = 0;
        if (hipGetDevice(&dev) != hipSuccess || hipDeviceGetAttribute(&cus, hipDeviceAttributeMultiprocessorCount, dev) != hipSuccess) { grid = -1; return; }
        if (hipFuncSetAttribute((const void*)mega, hipFuncAttributeMaxDynamicSharedMemorySize, LDS_BYTES) != hipSuccess) { fprintf(stderr, "kernel_launch: hipFuncSetAttribute failed\n"); grid = -1; return; }
        grid = cus;
    }
    if (grid < 0) return;
    if (hipMemsetAsync((char*)d_ws + WS_CTL, 0, CTL_BYTES, stream) != hipSuccess) return;
    Args a{};
    for (int i = 0; i < 23; ++i) a.in[i] = (const float*)d_in[i];
    a.out = (float*)d_out; a.ws = (unsigned char*)d_ws;
    hipLaunchKernelGGL(mega, dim3(grid), dim3(512), LDS_BYTES, stream, a);
}
```

```cpp
#define DUP_MASK 0
#include <hip/hip_runtime.h>
#include <cstdio>
#include <cstdint>
namespace pg8 {
#define PG8_LAS __attribute__((address_space(3)))
typedef unsigned short bf16_t;
typedef short bf16x8 __attribute__((ext_vector_type(8)));
typedef float f32x4 __attribute__((ext_vector_type(4)));
typedef unsigned u32x4 __attribute__((ext_vector_type(4)));
constexpr int BM = 256, BK = 64, HALF = 128, HTB = HALF * BK * 2  , STAGE_BYTES = 8 * HTB, NXCD = 8, WGM = 8;

__host__ __device__ __forceinline__ int lds_byte(int r, int c) { const int st = (r >> 4) * 2 + (c >> 5), rr = r & 15, cc = c & 31, ob = rr * 64 + cc * 2; return st * 1024 + (ob ^ (((ob >> 9) & 1) << 5)); }
__host__ __device__ __forceinline__ void stage_rc(int b, int& R, int& C) { const int st = b / 1024, sb = b % 1024, swz = sb ^ (((sb >> 9) & 1) << 5); R = (st >> 1) * 16 + swz / 64; C = (st & 1) * 32 + (swz % 64) / 2; }
__host__ __device__ __forceinline__ int perm32(int rho) { const int n = rho >> 4, i = rho & 15; return 8 * (i >> 2) + 4 * n + (i & 3); }

struct Unit { int pm, pn; };
struct Gemm { const bf16_t* A; const bf16_t* Bt; int M, N, K; };

struct StaticOrder {
    int nM, nN, nwg, G, c;
    __host__ __device__ void init(int M, int N, int G_, int c_) { nM = M / BM; nN = N / BM; nwg = nM * nN; G = G_; c = c_; }
    __host__ __device__ bool next(int i, Unit& u) const {
        const long L = (long)i * G + c; if (L >= nwg) return false;
        int wgid = (int)L; { const int q = nwg / NXCD, r = nwg % NXCD, xcd = wgid % NXCD, off = wgid / NXCD; wgid = (xcd < r ? xcd * (q + 1) : r * (q + 1) + (xcd - r) * q) + off; }
        const int nig = WGM * nN, gid = wgid / nig, fm = gid * WGM, gsz = (nM - fm) < WGM ? (nM - fm) : WGM;
        u.pm = fm + ((wgid % nig) % gsz); u.pn = (wgid % nig) / gsz; return true;
    }
    __device__ __forceinline__ void a_ready(const Unit&) const {}
    __device__ __forceinline__ void done(const Unit&) const {}
};

__device__ __forceinline__ unsigned cvt_pk_bf16(float lo, float hi) { unsigned r; asm volatile("v_cvt_pk_bf16_f32 %0, %1, %2" : "=v"(r) : "v"(lo), "v"(hi)); return r; }
typedef float f32x2 __attribute__((ext_vector_type(2)));
__device__ __forceinline__ f32x2 gelu_pk(f32x2 v) {
    const f32x2 av = __builtin_elementwise_abs(v), d = av * 0.2316418882f + 1.0f;
    f32x2 t; t.x = __builtin_amdgcn_rcpf(d.x); t.y = __builtin_amdgcn_rcpf(d.y);
    f32x2 q = t * 0.5307027145f + (-0.7265760135f); q = q * t + 0.7107068705f; q = q * t + (-0.142248368f); q = q * t + 0.127414796f; q = q * t;
    const f32x2 s = (v * v) * (-0.72134752044f);
    f32x2 e; e.x = __builtin_amdgcn_exp2f(s.x); e.y = __builtin_amdgcn_exp2f(s.y);
    const f32x2 m = v * (q * e), r = v - m;
    f32x2 o; o.x = v.x < 0.f ? m.x : r.x; o.y = v.y < 0.f ? m.y : r.y; return o;
}

template <int ACT  > struct EpiBf16 {
    static constexpr bool PERM = true, AFTER_DRAIN = false, HAS_MID = false; static_assert(ACT == 0 || ACT == 1, "EpiBf16: ACT is 0 (none) or 1 (gelu_pk)");
    bf16_t* O; int ldc; const float* bias; int split_cols; size_t split_stride; float scale0;
    __device__ __forceinline__ void operator()(const f32x4 (&acc)[2][2][4][2], const Unit& u, int wr, int wc, int fr, int fq) const {
        const int row0 = u.pm * BM + wr * 64 + fr; int colt = u.pn * BM; bf16_t* base = O;
        float sc = 1.f; if (split_cols) { const int t = colt / split_cols; base += (size_t)t * split_stride; colt -= t * split_cols; if (t == 0) sc = scale0; }
        const int col0 = colt + wc * 32 + 8 * fq, bcol0 = u.pn * BM + wc * 32 + 8 * fq;
        f32x4 bv[2][2];
#pragma unroll
        for (int bj = 0; bj < 2; ++bj)
#pragma unroll
            for (int n = 0; n < 2; ++n) bv[bj][n] = bias ? *(const f32x4*)(bias + bcol0 + bj * HALF + 4 * n) : (f32x4){0.f, 0.f, 0.f, 0.f};
#pragma unroll
        for (int ai = 0; ai < 2; ++ai)
#pragma unroll
            for (int m = 0; m < 4; ++m) { bf16_t* rowp = base + (size_t)(row0 + ai * HALF + m * 16) * ldc + col0;
#pragma unroll
                for (int bj = 0; bj < 2; ++bj) { f32x4 v0 = acc[ai][bj][m][0] + bv[bj][0], v1 = acc[ai][bj][m][1] + bv[bj][1];
                    if (ACT == 1) { f32x2 a = gelu_pk((f32x2){v0[0], v0[1]}), b = gelu_pk((f32x2){v0[2], v0[3]}), c = gelu_pk((f32x2){v1[0], v1[1]}), d = gelu_pk((f32x2){v1[2], v1[3]});
                        v0 = (f32x4){a.x, a.y, b.x, b.y}; v1 = (f32x4){c.x, c.y, d.x, d.y}; }
                    v0 = v0 * sc; v1 = v1 * sc; u32x4 w; w.x = cvt_pk_bf16(v0[0], v0[1]); w.y = cvt_pk_bf16(v0[2], v0[3]); w.z = cvt_pk_bf16(v1[0], v1[1]); w.w = cvt_pk_bf16(v1[2], v1[3]);
                    *(u32x4*)(rowp + bj * HALF) = w; } }
    }
};
struct EpiF32 {
    static constexpr bool PERM = false, AFTER_DRAIN = false, HAS_MID = false;
    float* C; int ldc; const float* bias;
    __device__ __forceinline__ void operator()(const f32x4 (&acc)[2][2][4][2], const Unit& u, int wr, int wc, int fr, int fq) const {
        const int row0 = u.pm * BM + wr * 64 + fr, col0 = u.pn * BM + wc * 32 + 4 * fq;
        f32x4 bv[2][2];
#pragma unroll
        for (int bj = 0; bj < 2; ++bj)
#pragma unroll
            for (int n = 0; n < 2; ++n) bv[bj][n] = bias ? *(const f32x4*)(bias + col0 + bj * HALF + n * 16) : (f32x4){0.f, 0.f, 0.f, 0.f};
#pragma unroll
        for (int ai = 0; ai < 2; ++ai)
#pragma unroll
            for (int m = 0; m < 4; ++m) { float* rowp = C + (size_t)(row0 + ai * HALF + m * 16) * ldc + col0;
#pragma unroll
                for (int bj = 0; bj < 2; ++bj)
#pragma unroll
                    for (int n = 0; n < 2; ++n) *(f32x4*)(rowp + bj * HALF + n * 16) = acc[ai][bj][m][n] + bv[bj][n]; }
    }
};
template <class Epi, class Sched, bool ALIGN_EPI = false, bool SP2 = false>
__device__ __forceinline__ void gemm_phase(PG8_LAS unsigned char* lds, const Gemm g, const Sched& S, const Epi& E, int wave_id) {
    int tid_ = wave_id * 64 + (int)__builtin_amdgcn_mbcnt_hi(~0u, __builtin_amdgcn_mbcnt_lo(~0u, 0u)); asm volatile("" : "+v"(tid_));
    const int tid = tid_, wid = __builtin_amdgcn_readfirstlane(tid >> 6), lane = tid & 63, wr = wid >> 2, wc = wid & 3, fr = lane & 15, fq = lane >> 4;
    const int K = g.K, nt = K / BK;
    unsigned voffA[2], voffB[2];
#pragma unroll
    for (int i = 0; i < 2; ++i) { int R, C; stage_rc(tid * 16 + i * 8192, R, C); const int Rb = Epi::PERM ? ((R & ~31) + perm32(R & 31)) : R;
        voffA[i] = (unsigned)(R * K + C) * 2u; voffB[i] = (unsigned)(Rb * K + C) * 2u; }
    const size_t kstep = (size_t)(BK * 2);
    const size_t hstep = (size_t)HALF * K * 2;
    const size_t tstep = 2 * hstep;
    const unsigned ldsw = (unsigned)wid * 1024u;
    const int aoff = lds_byte(wr * 64 + fr, fq * 8), boff = lds_byte(wc * 32 + fr, fq * 8);
#define PG8_SA(b, h) (((b) * 2 + (h)) * HTB)
#define PG8_SB(b, h) ((4 + (b) * 2 + (h)) * HTB)
#define PG8_STAGE(bufoff, gbase, voff) do { _Pragma("unroll") for (int _i = 0; _i < 2; ++_i) \
        __builtin_amdgcn_global_load_lds((const unsigned*)((const char*)(gbase) + (voff)[_i]), (PG8_LAS unsigned*)(lds + (bufoff) + ldsw + _i * 8192), 16, 0, 0); } while (0)
#define PG8_LDA(dst, b, h) do { _Pragma("unroll") for (int m = 0; m < 4; ++m) _Pragma("unroll") for (int k = 0; k < 2; ++k) dst[m][k] = *(const PG8_LAS bf16x8*)(lds + PG8_SA(b, h) + aoff + m * 2048 + k * 1024); } while (0)
#define PG8_LDB(dst, b, h) do { _Pragma("unroll") for (int n = 0; n < 2; ++n) _Pragma("unroll") for (int k = 0; k < 2; ++k) dst[n][k] = *(const PG8_LAS bf16x8*)(lds + PG8_SB(b, h) + boff + n * 2048 + k * 1024); } while (0)
#define PG8_MMA(ai, bj, At, Bt) do { __builtin_amdgcn_s_setprio(1); _Pragma("unroll") for (int m = 0; m < 4; ++m) _Pragma("unroll") for (int n = 0; n < 2; ++n) _Pragma("unroll") for (int k = 0; k < 2; ++k) \
        acc[ai][bj][m][n] = __builtin_amdgcn_mfma_f32_16x16x32_bf16(Bt[n][k], At[m][k], acc[ai][bj][m][n], 0, 0, 0); __builtin_amdgcn_s_setprio(0); } while (0)
#define PG8_WAIT_V(n) asm volatile("s_waitcnt vmcnt(" #n ")" ::: "memory")
#define PG8_WAIT_L(n) asm volatile("s_waitcnt lgkmcnt(" #n ")" ::: "memory")
#define PG8_BAR __builtin_amdgcn_s_barrier()
#define PG8_SCHED __builtin_amdgcn_sched_barrier(0)
    Unit cur, nxt; int ui = 0;
    if (!S.next(0, cur)) return;
    f32x4 acc[2][2][4][2];
#pragma unroll
    for (int a = 0; a < 2; ++a)
#pragma unroll
        for (int b = 0; b < 2; ++b)
#pragma unroll
            for (int m = 0; m < 4; ++m)
#pragma unroll
                for (int n = 0; n < 2; ++n) acc[a][b][m][n] = (f32x4){0.f, 0.f, 0.f, 0.f};
    bf16x8 At[4][2], B0[2][2], B1[2][2];
    const char* cA = (const char*)g.A + (size_t)cur.pm * tstep; const char* cB = (const char*)g.Bt + (size_t)cur.pn * tstep;
    S.a_ready(cur);
    if constexpr (SP2) {
        PG8_STAGE(PG8_SB(0, 0), cB, voffB); PG8_STAGE(PG8_SB(0, 1), cB + hstep, voffB); PG8_STAGE(PG8_SA(0, 0), cA, voffA); PG8_STAGE(PG8_SA(0, 1), cA + hstep, voffA);
        if (wr == 1) PG8_BAR;
        PG8_WAIT_V(2); PG8_BAR;
        PG8_STAGE(PG8_SB(1, 0), cB + kstep, voffB); PG8_STAGE(PG8_SA(1, 0), cA + kstep, voffA); PG8_STAGE(PG8_SB(1, 1), cB + hstep + kstep, voffB);
        PG8_WAIT_V(6); PG8_BAR;
    } else {
        PG8_STAGE(PG8_SB(0, 0), cB, voffB); PG8_STAGE(PG8_SA(0, 0), cA, voffA); PG8_STAGE(PG8_SB(0, 1), cB + hstep, voffB); PG8_STAGE(PG8_SA(0, 1), cA + hstep, voffA);
        if (wr == 1) PG8_BAR;
        PG8_WAIT_V(4); PG8_BAR;
        PG8_STAGE(PG8_SB(1, 0), cB + kstep, voffB); PG8_STAGE(PG8_SA(1, 0), cA + kstep, voffA); PG8_STAGE(PG8_SB(1, 1), cB + hstep + kstep, voffB);
        PG8_WAIT_V(6); PG8_BAR;
    }
    for (;;) {
        const bool has_next = S.next(ui + 1, nxt);
        const char* nA = has_next ? (const char*)g.A + (size_t)nxt.pm * tstep : cA; const char* nB = has_next ? (const char*)g.Bt + (size_t)nxt.pn * tstep : cB;
        for (int t = 0; t < nt; t += 2) {
            const bool last = (t == nt - 2);
            const char* a1 = cA + (size_t)(t + 1) * kstep;
            const char* a2 = last ? nA : cA + (size_t)(t + 2) * kstep; const char* b2 = last ? nB : cB + (size_t)(t + 2) * kstep;
            const char* a3 = a2 + kstep; const char* b3 = b2 + kstep;
            if (last && has_next) S.a_ready(nxt);
            if constexpr (Epi::HAS_MID) { if (t == nt / 2) E.mid(acc, cur, wr, wc, fr, fq); }
            if constexpr (SP2) {
            PG8_LDB(B0, 0, 0); PG8_LDB(B1, 0, 1); PG8_SCHED; PG8_LDA(At, 0, 0); PG8_STAGE(PG8_SA(1, 1), a1 + hstep, voffA);
            PG8_WAIT_V(8); PG8_WAIT_L(0); PG8_BAR; PG8_MMA(0, 0, At, B0); PG8_MMA(0, 1, At, B1); PG8_BAR; PG8_SCHED;
            PG8_LDA(At, 0, 1); PG8_STAGE(PG8_SB(0, 0), b2, voffB); PG8_STAGE(PG8_SB(0, 1), b2 + hstep, voffB); PG8_STAGE(PG8_SA(0, 0), a2, voffA);
            PG8_WAIT_V(8); PG8_WAIT_L(0); PG8_BAR; PG8_MMA(1, 0, At, B0); PG8_MMA(1, 1, At, B1); PG8_BAR; PG8_SCHED;
            PG8_LDB(B0, 1, 0); PG8_LDB(B1, 1, 1); PG8_SCHED; PG8_LDA(At, 1, 0); PG8_STAGE(PG8_SA(0, 1), a2 + hstep, voffA);
            PG8_WAIT_V(8); PG8_WAIT_L(0); PG8_BAR; PG8_MMA(0, 0, At, B0); PG8_MMA(0, 1, At, B1); PG8_BAR; PG8_SCHED;
            PG8_LDA(At, 1, 1); PG8_STAGE(PG8_SB(1, 0), b3, voffB); PG8_STAGE(PG8_SB(1, 1), b3 + hstep, voffB); PG8_STAGE(PG8_SA(1, 0), a3, voffA);
            PG8_WAIT_V(8); PG8_WAIT_L(0); PG8_BAR; PG8_MMA(1, 0, At, B0); PG8_MMA(1, 1, At, B1); PG8_BAR; PG8_SCHED;
            } else {
            PG8_LDB(B0, 0, 0); PG8_SCHED; PG8_LDA(At, 0, 0); PG8_STAGE(PG8_SA(1, 1), a1 + hstep, voffA);
            PG8_WAIT_L(8); PG8_BAR; PG8_WAIT_L(0); PG8_MMA(0, 0, At, B0); PG8_BAR; PG8_SCHED;
            PG8_LDB(B1, 0, 1); PG8_STAGE(PG8_SB(0, 0), b2, voffB);
            PG8_BAR; PG8_WAIT_L(0); PG8_MMA(0, 1, At, B1); PG8_BAR;
            PG8_LDA(At, 0, 1); PG8_STAGE(PG8_SA(0, 0), a2, voffA);
            PG8_BAR; PG8_WAIT_L(0); PG8_MMA(1, 0, At, B0); PG8_BAR; PG8_SCHED;
            PG8_STAGE(PG8_SB(0, 1), b2 + hstep, voffB);
            PG8_WAIT_V(6); PG8_BAR; PG8_MMA(1, 1, At, B1); PG8_BAR;
            PG8_LDB(B0, 1, 0); PG8_SCHED; PG8_LDA(At, 1, 0); PG8_STAGE(PG8_SA(0, 1), a2 + hstep, voffA);
            PG8_WAIT_L(8); PG8_BAR; PG8_WAIT_L(0); PG8_MMA(0, 0, At, B0); PG8_BAR; PG8_SCHED;
            PG8_LDB(B1, 1, 1); PG8_STAGE(PG8_SB(1, 0), b3, voffB);
            PG8_BAR; PG8_WAIT_L(0); PG8_MMA(0, 1, At, B1); PG8_BAR;
            PG8_LDA(At, 1, 1); PG8_STAGE(PG8_SA(1, 0), a3, voffA);
            PG8_BAR; PG8_WAIT_L(0); PG8_MMA(1, 0, At, B0); PG8_BAR; PG8_SCHED;
            PG8_STAGE(PG8_SB(1, 1), b3 + hstep, voffB);
            PG8_WAIT_V(6); PG8_BAR; PG8_MMA(1, 1, At, B1); PG8_BAR;
            }
        }
        if constexpr (ALIGN_EPI) { if (wr == 0) PG8_BAR; }
        if constexpr (!Epi::AFTER_DRAIN) { E(acc, cur, wr, wc, fr, fq); S.done(cur); }
        if (!has_next) break;
#pragma unroll
        for (int a = 0; a < 2; ++a)
#pragma unroll
            for (int b = 0; b < 2; ++b)
#pragma unroll
                for (int m = 0; m < 4; ++m)
#pragma unroll
                    for (int n = 0; n < 2; ++n) acc[a][b][m][n] = (f32x4){0.f, 0.f, 0.f, 0.f};
        cur = nxt; cA = nA; cB = nB; ++ui;
        if constexpr (ALIGN_EPI) { if (wr == 1) PG8_BAR; }
    }
    PG8_WAIT_V(0);
    if constexpr (!ALIGN_EPI) { if (wr == 0) PG8_BAR; }
    PG8_BAR;
    if constexpr (Epi::AFTER_DRAIN) { E.fused(acc, cur, wr, wc, fr, fq, lds, wid, lane); S.done(cur); }
#undef PG8_SA
#undef PG8_SB
#undef PG8_STAGE
#undef PG8_LDA
#undef PG8_LDB
#undef PG8_MMA
#undef PG8_WAIT_V
#undef PG8_WAIT_L
#undef PG8_BAR
#undef PG8_SCHED
}
}

#define DEV __device__ __forceinline__
#define LAS __attribute__((address_space(3)))
typedef unsigned short bf16;
typedef float f32x4 __attribute__((ext_vector_type(4)));
typedef unsigned u32x4 __attribute__((ext_vector_type(4)));
typedef unsigned u32x2 __attribute__((ext_vector_type(2)));

constexpr int D = 1024, NTOK = 10240, NCTX = 8192, DEPTH = 4, NH = 16, HP = 64, NGRP = 4, NST = 128, DIN = 8224;
constexpr int NPROJ = 8192;
constexpr int NCHUNK = 80;
constexpr float EPS = 1e-6f;
constexpr int PC_XBC = 0, PC_ZM = 2048, PC_U = 3072, PC_V = 4096, PC_ZG = 5120, PC_GLM = 6144, PC_GLG = 7168;

constexpr size_t MiB = 1u << 20;
constexpr size_t WS_CTL = 0, CTL_BYTES = 2 * MiB;
constexpr size_t CTL_SSQ = 64 * 1024;
constexpr size_t CTL_SSQX = 256 * 1024;
constexpr size_t CTL_GSUM = 512 * 1024;
constexpr size_t CTL_SW = 1 * MiB;
constexpr size_t WS_MOD = 2 * MiB;
constexpr size_t WS_GN = WS_MOD + 256 * 1024;
constexpr size_t WS_WDT = WS_GN + 192 * 1024;
constexpr size_t WS_WSPB = 3 * MiB;
constexpr size_t WS_DTRAW = 4 * MiB;
constexpr size_t WS_WIN = 6 * MiB;
constexpr size_t WS_WMG = WS_WIN + 64 * MiB;
constexpr size_t WS_WO = WS_WMG + 16 * MiB;
constexpr size_t WS_HBUF = WS_WO + 8 * MiB;
constexpr size_t WS_AMG = WS_HBUF + 20 * MiB;
constexpr size_t WS_PROJ = WS_AMG + 40 * MiB;
constexpr size_t WS_XBUF = WS_PROJ + 160 * MiB;
constexpr size_t WS_MRG = WS_XBUF + 40 * MiB;
constexpr size_t WS_XBCS = WS_MRG + 20 * MiB;
constexpr size_t WS_SINB = WS_XBCS + 40 * MiB;
constexpr size_t WS_TB = WS_SINB + 40 * MiB;
constexpr size_t WS_END = WS_TB + 6 * MiB;

#ifndef DUP_MASK
#define DUP_MASK 0
#endif
constexpr size_t CTL_DUMMY = 1536 * 1024;
constexpr int LDS_BYTES = 155648;

DEV float bf2f(unsigned v) { return __uint_as_float(v << 16); }
DEV unsigned f2bf(float f) { unsigned u = __float_as_uint(f); return (u + 0x7fffu + ((u >> 16) & 1u)) >> 16; }
DEV unsigned pk2(float lo, float hi) { return f2bf(lo) | (f2bf(hi) << 16); }
DEV float sigmoid_f(float x) { return __builtin_amdgcn_rcpf(1.f + __expf(-x)); }
DEV float silu_f(float x) { return x * __builtin_amdgcn_rcpf(1.f + __expf(-x)); }
DEV float gelu_f(float x) { return x * sigmoid_f(1.5957691216f * (x + 0.044715f * x * x * x)); }
DEV float softplus_f(float x) { const float e = __expf(x); const float sm = e * (1.f - e * (0.5f - e * 0.33333333f)); return x > 20.f ? x : (e < 0.03f ? sm : __logf(1.f + e)); }
DEV float shfl_idx(float v, int src_lane) { return __int_as_float(__builtin_amdgcn_ds_bpermute(src_lane << 2, __float_as_int(v))); }
DEV float shfl_x(float v, int o, int lane) { return shfl_idx(v, lane ^ o); }
DEV float wave_sum(float v, int lane) {
#pragma unroll
    for (int o = 1; o < 64; o <<= 1) v += shfl_x(v, o, lane);
    return v;
}

struct Args { const float* in[23]; float* out; unsigned char* ws; int step_lo, step_hi; };

struct Frame {
    LAS unsigned char* lds;
    int tid, lane, wave, G, bid, z;
    const float* const* in;
    float* out; unsigned char* ws;
};
DEV Frame launder(const Frame& F0) {
    Frame F = F0;
    F.z = 0; asm volatile("" : "+s"(F.z), "+s"(F.out), "+s"(F.ws), "+s"(F.G), "+s"(F.bid), "+s"(F.wave));
    F.tid = F.wave * 64 + (int)__builtin_amdgcn_mbcnt_hi(~0u, __builtin_amdgcn_mbcnt_lo(~0u, 0u));
    asm volatile("" : "+v"(F.tid));
    F.lane = F.tid & 63;
    return F;
}
#define IN_XP 0
#define IN_XS 1
#define IN_STATE 2
#define IN_C 3
#define IN_CCTX 4
#define IN_WADA 5
#define IN_BADA 6
#define IN_NORMW 7
#define IN_WIN 8
#define IN_CONVW 9
#define IN_CONVB 10
#define IN_DTBIAS 11
#define IN_ALOG 12
#define IN_DSKIP 13
#define IN_SSMNW 14
#define IN_WOUTM 15
#define IN_LNW 16
#define IN_LNB 17
#define IN_WSP 18
#define IN_BSP 19
#define IN_WOUTG 20
#define IN_WOUT 21
#define IN_FNW 22

DEV int scan_to_row(int sr, int layer) {
    if (sr < NCTX || !(layer & 1)) return sr;
    const int lb = (sr - NCTX) >> 10, q = (sr - NCTX) & 1023;
    return NCTX + lb * 1024 + (q & 15) * 64 + (q >> 4);
}

DEV void ph_mod(const Frame& F0) {
    Frame F = launder(F0);
    LAS float* sc = (LAS float*)F.lds;
    LAS float* part = sc + 3 * 1024;
    for (int i = F.tid; i < 3 * 1024; i += 512) { const int v = i >> 10, k = i & 1023; const float c = v == 0 ? F.in[IN_CCTX + F.z][k] : F.in[IN_C + F.z][(v - 1) * 1024 + k]; sc[i] = silu_f(c); }
    __syncthreads();
    float* mod = (float*)(F.ws + WS_MOD);
    for (int it = F.bid; it < DEPTH * 48; it += F.G) {
        const int l = it / 48, jl = F.tid & 63, j = (it % 48) * 64 + jl, kq = F.tid >> 6;
        const float* w = F.in[IN_WADA + F.z] + (size_t)l * 1024 * 3072 + (size_t)(kq * 128) * 3072 + j;
        float a0 = 0.f, a1 = 0.f, a2 = 0.f;
#pragma unroll 16
        for (int k = 0; k < 128; ++k) { const float wv = w[(size_t)k * 3072]; a0 += sc[kq * 128 + k] * wv; a1 += sc[1024 + kq * 128 + k] * wv; a2 += sc[2048 + kq * 128 + k] * wv; }
        __syncthreads();
        part[(kq * 3 + 0) * 64 + jl] = a0; part[(kq * 3 + 1) * 64 + jl] = a1; part[(kq * 3 + 2) * 64 + jl] = a2;
        __syncthreads();
        if (F.tid < 192) { const int v = F.tid >> 6, jj = F.tid & 63, col = (it % 48) * 64 + jj; float t = F.in[IN_BADA + F.z][l * 3072 + col];
#pragma unroll
            for (int q = 0; q < 8; ++q) t += part[(q * 3 + v) * 64 + jj];
            mod[(l * 3 + v) * 3072 + col] = t; }
    }
}

DEV void cvt_item(const float* W, int ldw, int k0, int n0, bf16* WT, int ldt, int k0d, int drow0, LAS float* scr, int lane, const float* shift3, float* sw3) {
    float wv_[32];
#pragma unroll
    for (int i = 0; i < 32; ++i) wv_[i] = W[(size_t)(k0 + 2 * i + (lane >> 5)) * ldw + n0 + (lane & 31)];
#pragma unroll
    for (int i = 0; i < 32; ++i) scr[(2 * i + (lane >> 5)) * 33 + (lane & 31)] = wv_[i];
    asm volatile("s_waitcnt lgkmcnt(0)" ::: "memory");
    const int c = lane & 7;
#pragma unroll
    for (int j = 0; j < 4; ++j) { const int n = (lane >> 3) + 8 * j; const LAS float* s = scr + (8 * c) * 33 + n;
        u32x4 o; o.x = pk2(s[0 * 33], s[1 * 33]); o.y = pk2(s[2 * 33], s[3 * 33]); o.z = pk2(s[4 * 33], s[5 * 33]); o.w = pk2(s[6 * 33], s[7 * 33]);
        *(u32x4*)(WT + (size_t)(drow0 + n) * ldt + k0d + 8 * c) = o; }
    if (shift3) {
        const int n = lane & 31, kh = (lane >> 5) * 32;
        float a0 = 0.f, a1 = 0.f, a2 = 0.f;
#pragma unroll 8
        for (int kk = 0; kk < 32; ++kk) { const float wv = scr[(kh + kk) * 33 + n]; a0 += shift3[k0 + kh + kk] * wv; a1 += shift3[3072 + k0 + kh + kk] * wv; a2 += shift3[6144 + k0 + kh + kk] * wv; }
        a0 += shfl_x(a0, 32, lane); a1 += shfl_x(a1, 32, lane); a2 += shfl_x(a2, 32, lane);
        if (lane < 32) { atomicAdd(sw3 + n0 + n, a0); atomicAdd(sw3 + DIN + n0 + n, a1); atomicAdd(sw3 + 2 * DIN + n0 + n, a2); }
    }
    asm volatile("s_waitcnt lgkmcnt(0)" ::: "memory");
}
DEV void ph_cvt(const Frame& F0, int l, int wg0, int nwg) {
    Frame F = launder(F0);
    asm volatile("" : "+s"(l));
    if (F.bid < wg0) return;
    LAS float* scr = (LAS float*)(F.lds + F.wave * 16384);
    const int gw = (F.bid - wg0) * 8 + F.wave, NGW = nwg * 8;
    constexpr int I_IN = 16 * 257, I_O = 16 * 32, PER_L = I_IN + 3 * I_O;
    for (int it = gw; it < PER_L; it += NGW) {
        int r = it;
        if (r < I_IN) { const int kb = r / 257, nb = r % 257;
            const float* shift3 = (const float*)(F.ws + WS_MOD) + (size_t)l * 3 * 3072;
            float* sw3 = (float*)(F.ws + WS_CTL + CTL_SW) + (size_t)l * 3 * DIN;
            if (nb == 96) cvt_item(F.in[IN_WIN + F.z] + (size_t)l * 1024 * DIN, DIN, 64 * kb, 3072, (bf16*)(F.ws + WS_WDT) + (size_t)l * 32 * 1024, 1024, 64 * kb, 0, scr, F.lane, shift3, sw3);
            else { const int c = 32 * nb;
                int drow;
                if (c < 3072) drow = c;
                else if (c < 4128) { const int cc = c - 3104; drow = (12 + (cc >> 7)) * 256 + (cc & 127); }
                else if (c < 5152) drow = 5120 + (c - 4128);
                else if (c < 6176) { const int cc = c - 5152; drow = (12 + (cc >> 7)) * 256 + 128 + (cc & 127); }
                else drow = 6144 + (c - 6176);
                cvt_item(F.in[IN_WIN + F.z] + (size_t)l * 1024 * DIN, DIN, 64 * kb, c, (bf16*)(F.ws + WS_WIN) + (size_t)l * NPROJ * 1024, 1024, 64 * kb, drow, scr, F.lane, shift3, sw3); }
            continue; }
        r -= I_IN;
        const int which = r / I_O; r %= I_O; const int kb = r >> 5, nb = r & 31;
        const float* W = (which == 0 ? F.in[IN_WOUTM + F.z] : which == 1 ? F.in[IN_WOUTG + F.z] : F.in[IN_WOUT + F.z]) + (size_t)l * 1024 * 1024;
        if (which < 2) cvt_item(W, 1024, 64 * kb, 32 * nb, (bf16*)(F.ws + WS_WMG) + (size_t)l * 1024 * 2048, 2048, which * 1024 + 64 * kb, 32 * nb, scr, F.lane, nullptr, nullptr);
        else cvt_item(W, 1024, 64 * kb, 32 * nb, (bf16*)(F.ws + WS_WO) + (size_t)l * 1024 * 1024, 1024, 64 * kb, 32 * nb, scr, F.lane, nullptr, nullptr);
    }
}
DEV void ph_gn(const Frame& F0) {
    Frame F = launder(F0);
    float* gn = (float*)(F.ws + WS_GN);
    for (int i = F.bid * 512 + F.tid; i < DEPTH * 3 * 1024; i += F.G * 512) { const int c = i & 1023, lv = i >> 10, l = lv / 3;
        gn[i] = F.in[IN_NORMW + F.z][l * 1024 + c] * (1.f + ((const float*)(F.ws + WS_MOD))[lv * 3072 + 1024 + c]); }
    const f32x4* wsp = (const f32x4*)F.in[IN_WSP + F.z]; u32x2* wb = (u32x2*)(F.ws + WS_WSPB);
    for (int i = F.bid * 512 + F.tid; i < DEPTH * 8 * 128 * 128 / 4; i += F.G * 512) { const f32x4 w = wsp[i]; u32x2 o; o.x = pk2(w.x, w.y); o.y = pk2(w.z, w.w); wb[i] = o; }
}

DEV void ph_prep0(const Frame& F0) {
    Frame F = launder(F0);
    const int gw = F.bid * 8 + F.wave, NGW = F.G * 8;
    const float* nw = F.in[IN_NORMW + F.z];
    float* ssqx = (float*)(F.ws + WS_CTL + CTL_SSQX);
    for (int row = gw; row < NTOK; row += NGW) {
        const int mv = row < NCTX ? 0 : 1 + ((row - NCTX) >> 10);
        const float* md = (const float*)(F.ws + WS_MOD) + mv * 3072;
        const f32x4* xr = (const f32x4*)(row < NCTX ? F.in[IN_XP + F.z] + (size_t)row * D : F.in[IN_XS + F.z] + (size_t)(row - NCTX) * D) + F.lane;
        f32x4 v[4]; float s = 0.f;
#pragma unroll
        for (int j = 0; j < 4; ++j) { v[j] = xr[64 * j]; s += (v[j].x * v[j].x + v[j].y * v[j].y) + (v[j].z * v[j].z + v[j].w * v[j].w); }
        s = wave_sum(s, F.lane);
        if (F.lane == 0) ssqx[row] = s;
        unsigned long long* o8 = (unsigned long long*)((bf16*)(F.ws + WS_HBUF) + (size_t)row * D) + F.lane;
#pragma unroll
        for (int j = 0; j < 4; ++j) { const int c0 = 4 * (F.lane + 64 * j);
            const f32x4 w4 = *(const f32x4*)(nw + c0), sc = *(const f32x4*)(md + 1024 + c0);
            v[j] = v[j] * w4 * (sc + 1.f);
            o8[64 * j] = (unsigned long long)pk2(v[j].x, v[j].y) | ((unsigned long long)pk2(v[j].z, v[j].w) << 32); }
    }
}

DEV void ph_final(const Frame& F0) {
    Frame F = launder(F0);
    const int gw = F.bid * 8 + F.wave, NGW = F.G * 8;
    const float* nw = F.in[IN_FNW + F.z];
    const float* ssqx = (const float*)(F.ws + WS_CTL + CTL_SSQX) + 4 * NTOK;
    for (int row = gw; row < NTOK; row += NGW) {
        const f32x4* xr = (const f32x4*)((const float*)(F.ws + WS_XBUF) + (size_t)row * D) + F.lane;
        const float rstd = rsqrtf(ssqx[row] * (1.f / D) + EPS);
        f32x4* o = (f32x4*)(F.out + (size_t)row * D) + F.lane;
#pragma unroll
        for (int j = 0; j < 4; ++j) o[64 * j] = xr[64 * j] * rstd * *(const f32x4*)(nw + 4 * (F.lane + 64 * j));
    }
}

typedef short bf16x8 __attribute__((ext_vector_type(8)));
typedef short s16x4 __attribute__((ext_vector_type(4)));
typedef float f32x16 __attribute__((ext_vector_type(16)));
typedef float f32x2 __attribute__((ext_vector_type(2)));
typedef __bf16 bf16x2_t __attribute__((ext_vector_type(2)));
#define MFMA32(a, b, c) __builtin_amdgcn_mfma_f32_32x32x16_bf16((a), (b), (c), 0, 0, 0)
DEV unsigned pkbf(float a, float b) { const f32x2 v = {a, b}; return __builtin_bit_cast(unsigned, __builtin_convertvector(v, bf16x2_t)); }
DEV bf16x8 pack8(float a0, float a1, float a2, float a3, float a4, float a5, float a6, float a7) {
    u32x4 p; p.x = pkbf(a0, a1); p.y = pkbf(a2, a3); p.z = pkbf(a4, a5); p.w = pkbf(a6, a7); return __builtin_bit_cast(bf16x8, p); }
DEV int crow(int r, int hh) { return (r & 3) + 8 * (r >> 2) + 4 * hh; }

struct ChunkGeo { int seq_row0, pos0, L; bool cm; };
DEV ChunkGeo chunk_geo(int ck, int layer) {
    ChunkGeo g;
    if (ck < 64) { g.seq_row0 = (ck >> 1) * 256; g.pos0 = (ck & 1) * 128; g.L = 256; g.cm = false; }
    else { const int lb = (ck - 64) >> 3; g.seq_row0 = NCTX + lb * 1024; g.pos0 = ((ck - 64) & 7) * 128; g.L = 1024; g.cm = (layer & 1) != 0; }
    return g;
}
DEV int geo_row(const ChunkGeo& g, int Q) { return g.seq_row0 + (g.cm ? (Q & 15) * 64 + (Q >> 4) : Q); }

DEV void chunk_tables2(Frame& F, int layer, const ChunkGeo& geo, int h, LAS float* tb) {
    if (F.wave < 2) {
        const int dir = F.wave;
        const float a = -__expf(F.in[IN_ALOG + F.z][layer * 32 + dir * 16 + h]);
        const float bias = F.in[IN_DTBIAS + F.z][layer * 32 + dir * 16 + h];
        const float* dtr = (const float*)(F.ws + WS_DTRAW);
        const int q0 = 2 * F.lane;
        const float d0 = softplus_f(dtr[(size_t)geo_row(geo, geo.pos0 + q0) * 32 + dir * 16 + h] + bias);
        const float d1 = softplus_f(dtr[(size_t)geo_row(geo, geo.pos0 + q0 + 1) * 32 + dir * 16 + h] + bias);
        const float a0 = d0 * a, a1 = d1 * a;
        float sc = a0 + a1, c0, c1, tot;
        if (dir == 0) {
#pragma unroll
            for (int o = 1; o < 64; o <<= 1) { const float t = shfl_idx(sc, (F.lane - o) & 63); if (F.lane >= o) sc += t; }
            c1 = sc; c0 = sc - a1; tot = shfl_idx(c1, 63);
        } else {
#pragma unroll
            for (int o = 1; o < 64; o <<= 1) { const float t = shfl_idx(sc, (F.lane + o) & 63); if (F.lane + o < 64) sc += t; }
            c0 = sc; c1 = sc - a0; tot = shfl_idx(c0, 0);
        }
        LAS float* t = tb + dir * 128 + q0;
        t[0] = c0; t[1] = c1; t[256] = d0; t[257] = d1; t[512] = __expf(c0); t[513] = __expf(c1);
        t[768] = d0 * __expf(tot - c0); t[769] = d1 * __expf(tot - c1);
    }
    __syncthreads();
}

template <int NC, int MODE>
DEV void stage_conv(Frame& F, int layer, const ChunkGeo& geo, int col0, LAS unsigned char* img0, LAS unsigned char* img1, int pitch, const LAS float* tb, bf16* gdst = nullptr) {
    constexpr int CG = NC / 8, NT = CG * 32;
    if (F.tid < NT) {
        const int cg = F.tid % CG, tg = F.tid / CG, ch0 = col0 + cg * 8, q0 = tg * 4;
        const bf16* proj = (const bf16*)(F.ws + WS_PROJ);
        float x[8][8];
#pragma unroll
        for (int i = 0; i < 8; ++i) {
            const int Q = geo.pos0 + q0 - 2 + i;
            u32x4 raw = {0u, 0u, 0u, 0u};
            if (Q >= 0 && Q < geo.L) raw = *(const u32x4*)(proj + (size_t)geo_row(geo, Q) * NPROJ + PC_XBC + ch0);
            x[i][0] = bf2f(raw.x & 0xffffu); x[i][1] = bf2f(raw.x >> 16); x[i][2] = bf2f(raw.y & 0xffffu); x[i][3] = bf2f(raw.y >> 16);
            x[i][4] = bf2f(raw.z & 0xffffu); x[i][5] = bf2f(raw.z >> 16); x[i][6] = bf2f(raw.w & 0xffffu); x[i][7] = bf2f(raw.w >> 16);
        }
        const float* cw = F.in[IN_CONVW + F.z] + layer * 5 * 2048 + ch0; const float* cb = F.in[IN_CONVB + F.z] + layer * 2048 + ch0;
        float acc[4][8];
        { const f32x4 b0 = *(const f32x4*)cb, b1 = *(const f32x4*)(cb + 4);
#pragma unroll
          for (int t = 0; t < 4; ++t) { acc[t][0] = b0.x; acc[t][1] = b0.y; acc[t][2] = b0.z; acc[t][3] = b0.w; acc[t][4] = b1.x; acc[t][5] = b1.y; acc[t][6] = b1.z; acc[t][7] = b1.w; } }
#pragma unroll
        for (int k = 0; k < 5; ++k) {
            const f32x4 w0 = *(const f32x4*)(cw + k * 2048), w1 = *(const f32x4*)(cw + k * 2048 + 4);
            const float w[8] = {w0.x, w0.y, w0.z, w0.w, w1.x, w1.y, w1.z, w1.w};
#pragma unroll
            for (int t = 0; t < 4; ++t)
#pragma unroll
                for (int c = 0; c < 8; ++c) acc[t][c] += w[c] * x[t + k][c];
        }
#pragma unroll
        for (int t = 0; t < 4; ++t) {
            float v[8];
#pragma unroll
            for (int c = 0; c < 8; ++c) v[c] = silu_f(acc[t][c]);
            const int s = q0 + t;
            if (MODE == 0) {
                u32x4 o; o.x = pkbf(v[0], v[1]); o.y = pkbf(v[2], v[3]); o.z = pkbf(v[4], v[5]); o.w = pkbf(v[6], v[7]);
                *(LAS u32x4*)(img0 + s * pitch + cg * 16) = o;
            } else if (MODE == 2) {
                u32x4 o; o.x = pkbf(v[0], v[1]); o.y = pkbf(v[2], v[3]); o.z = pkbf(v[4], v[5]); o.w = pkbf(v[6], v[7]);
                *(u32x4*)(gdst + (size_t)s * 2048 + cg * 8) = o;
            } else {
                const float sf = tb[768 + s], sb = tb[896 + s];
                u32x4 o; o.x = pkbf(v[0] * sf, v[1] * sf); o.y = pkbf(v[2] * sf, v[3] * sf); o.z = pkbf(v[4] * sf, v[5] * sf); o.w = pkbf(v[6] * sf, v[7] * sf);
                *(LAS u32x4*)(img0 + s * pitch + cg * 16) = o;
                o.x = pkbf(v[0] * sb, v[1] * sb); o.y = pkbf(v[2] * sb, v[3] * sb); o.z = pkbf(v[4] * sb, v[5] * sb); o.w = pkbf(v[6] * sb, v[7] * sb);
                *(LAS u32x4*)(img1 + s * pitch + cg * 16) = o;
            }
        }
    }
}

DEV bf16x8 tr2(const LAS unsigned char* img, int pitch, int row0, int row1, int col0, int lane) {
    const int i = lane & 15, blk = (lane >> 4) & 1;
    const int off = (i >> 2) * pitch + (col0 + 16 * blk + 4 * (i & 3)) * 2;
    const s16x4 lo = __builtin_amdgcn_ds_read_tr16_b64_v4i16((LAS s16x4*)(img + row0 * pitch + off));
    const s16x4 hi = __builtin_amdgcn_ds_read_tr16_b64_v4i16((LAS s16x4*)(img + row1 * pitch + off));
    return __builtin_shufflevector(lo, hi, 0, 1, 2, 3, 4, 5, 6, 7);
}

DEV void conv_unit(Frame& F, int layer, int ck, int q) {
    const ChunkGeo geo = chunk_geo(ck, layer);
    {
        const int dir = F.wave & 1, h = 4 * q + (F.wave >> 1);
        const float a = -__expf(F.in[IN_ALOG + F.z][layer * 32 + dir * 16 + h]);
        const float bias = F.in[IN_DTBIAS + F.z][layer * 32 + dir * 16 + h];
        const float* dtr = (const float*)(F.ws + WS_DTRAW);
        const int q0 = 2 * F.lane;
        const float d0 = softplus_f(dtr[(size_t)geo_row(geo, geo.pos0 + q0) * 32 + dir * 16 + h] + bias);
        const float d1 = softplus_f(dtr[(size_t)geo_row(geo, geo.pos0 + q0 + 1) * 32 + dir * 16 + h] + bias);
        const float a0 = d0 * a, a1 = d1 * a;
        float sc = a0 + a1, c0, c1, tot;
        if (dir == 0) {
#pragma unroll
            for (int o = 1; o < 64; o <<= 1) { const float t = shfl_idx(sc, (F.lane - o) & 63); if (F.lane >= o) sc += t; }
            c1 = sc; c0 = sc - a1; tot = shfl_idx(c1, 63);
        } else {
#pragma unroll
            for (int o = 1; o < 64; o <<= 1) { const float t = shfl_idx(sc, (F.lane + o) & 63); if (F.lane + o < 64) sc += t; }
            c0 = sc; c1 = sc - a0; tot = shfl_idx(c0, 0);
        }
        float* tbase = (float*)(F.ws + WS_TB) + (size_t)(ck * 16 + h) * 1024;
        *(f32x2*)(tbase + q0 * 4 + dir * 2) = (f32x2){c0, d0}; *(f32x2*)(tbase + (q0 + 1) * 4 + dir * 2) = (f32x2){c1, d1};
        float* t = tbase + dir * 128 + q0;
        *(f32x2*)(t + 512) = (f32x2){__expf(c0), __expf(c1)};
        *(f32x2*)(t + 768) = (f32x2){d0 * __expf(tot - c0), d1 * __expf(tot - c1)};
    }
    bf16* dst = (bf16*)(F.ws + WS_XBCS) + (size_t)ck * 128 * 2048;
#pragma unroll 1
    for (int j = 0; j < 4; ++j) { const int col0 = q * 512 + j * 128; stage_conv<128, 2>(F, layer, geo, col0, nullptr, nullptr, 0, nullptr, dst + col0); }
}
DEV void ph_b0(const Frame& F0, int layer) {
    Frame F = launder(F0);
    asm volatile("" : "+s"(layer));
    for (int it = F.bid; it < NCHUNK * 4; it += F.G) { Frame Fi = launder(F); conv_unit(Fi, layer, it >> 2, it & 3); }
}

struct S1Regs { u32x4 bq[4], xq[2]; float wf[2], wb[2], atF, atB; };
DEV void s1_load(Frame& F, int ck, int h, S1Regs& R) {
    const bf16* xc = (const bf16*)(F.ws + WS_XBCS) + (size_t)ck * 128 * 2048;
    const float* T = (const float*)(F.ws + WS_TB) + (size_t)(ck * 16 + h) * 1024;
    { const int ch = F.tid & 15, r0 = F.tid >> 4;
#pragma unroll
      for (int p = 0; p < 4; ++p) R.bq[p] = *(const u32x4*)(xc + (size_t)(r0 + 32 * p) * 2048 + 1024 + (h >> 2) * 128 + ch * 8); }
    { const int ch = F.tid & 7, r0 = F.tid >> 3;
#pragma unroll
      for (int p = 0; p < 2; ++p) { const int row = r0 + 64 * p; R.xq[p] = *(const u32x4*)(xc + (size_t)row * 2048 + h * 64 + ch * 8); R.wf[p] = T[768 + row]; R.wb[p] = T[896 + row]; } }
    R.atF = T[127 * 4]; R.atB = T[2];
}
DEV void s1_store(Frame& F, const S1Regs& R, LAS unsigned char* Bi, LAS unsigned char* XF, LAS unsigned char* XB) {
    { const int ch = F.tid & 15, r0 = F.tid >> 4;
#pragma unroll
      for (int p = 0; p < 4; ++p) *(LAS u32x4*)(Bi + (r0 + 32 * p) * 320 + ch * 16) = R.bq[p]; }
    { const int ch = F.tid & 7, r0 = F.tid >> 3;
#pragma unroll
      for (int p = 0; p < 2; ++p) { const int row = r0 + 64 * p; const u32x4 r = R.xq[p]; const float wf = R.wf[p], wb = R.wb[p];
          const float v[8] = {bf2f(r.x & 0xffffu), bf2f(r.x >> 16), bf2f(r.y & 0xffffu), bf2f(r.y >> 16), bf2f(r.z & 0xffffu), bf2f(r.z >> 16), bf2f(r.w & 0xffffu), bf2f(r.w >> 16)};
          u32x4 o; o.x = pkbf(v[0] * wf, v[1] * wf); o.y = pkbf(v[2] * wf, v[3] * wf); o.z = pkbf(v[4] * wf, v[5] * wf); o.w = pkbf(v[6] * wf, v[7] * wf);
          *(LAS u32x4*)(XF + row * 192 + ch * 16) = o;
          o.x = pkbf(v[0] * wb, v[1] * wb); o.y = pkbf(v[2] * wb, v[3] * wb); o.z = pkbf(v[4] * wb, v[5] * wb); o.w = pkbf(v[6] * wb, v[7] * wb);
          *(LAS u32x4*)(XB + row * 192 + ch * 16) = o; } }
}
DEV void sin_store(Frame& F, const f32x16& S, int ck, int h, int dir, int wpi, int wni) {
    bf16* o = (bf16*)(F.ws + WS_SINB) + ((size_t)(ck * 16 + h) * 2 + dir) * 8192 + (32 * wpi) * 128 + 32 * wni + (F.lane & 31);
    const int hh = F.lane >> 5;
#pragma unroll
    for (int r = 0; r < 16; r += 2) { const unsigned w = pkbf(S[r], S[r + 1]); o[crow(r, hh) * 128] = (bf16)(w & 0xffffu); o[crow(r + 1, hh) * 128] = (bf16)(w >> 16); }
}
DEV void s1_ctx_unit(Frame& F, int layer, int seq, int h) {
    LAS unsigned char* Bi = F.lds + 4096; LAS unsigned char* XF = Bi + 128 * 320; LAS unsigned char* XB = XF + 128 * 192;
    const int hh = F.lane >> 5, wpi = F.wave >> 2, wni = F.wave & 3;
    f32x16 sf[2], sb[2]; float aF[2], aB[2];
    S1Regs R;
    s1_load(F, 2 * seq, h, R);
#pragma unroll
    for (int c = 0; c < 2; ++c) {
        __syncthreads();
        s1_store(F, R, Bi, XF, XB);
        aF[c] = R.atF; aB[c] = R.atB;
        __syncthreads();
        if (c == 0) s1_load(F, 2 * seq + 1, h, R);
#pragma unroll
        for (int r = 0; r < 16; ++r) { sf[c][r] = 0.f; sb[c][r] = 0.f; }
#pragma unroll
        for (int ks = 0; ks < 8; ++ks) {
            const int k0 = 16 * ks + 8 * hh;
            const bf16x8 b = tr2(Bi, 320, k0, k0 + 4, 32 * wni, F.lane);
            const bf16x8 xf = tr2(XF, 192, k0, k0 + 4, 32 * wpi, F.lane);
            const bf16x8 xb = tr2(XB, 192, k0, k0 + 4, 32 * wpi, F.lane);
            sf[c] = MFMA32(xf, b, sf[c]); sb[c] = MFMA32(xb, b, sb[c]);
        }
    }
    sin_store(F, sf[0], 2 * seq + 1, h, 0, wpi, wni);
    sin_store(F, sb[1], 2 * seq, h, 1, wpi, wni);
    const float eF = __expf(aF[1]), eB = __expf(aB[0]);
    float* o = F.out + (size_t)10485760 + ((size_t)((seq * 4 + layer) * 2) * 16 + h) * 8192 + (32 * wpi) * 128 + 32 * wni + (F.lane & 31);
#pragma unroll
    for (int r = 0; r < 16; ++r) { const int p = crow(r, hh); o[p * 128] = eF * sf[0][r] + sf[1][r]; o[(size_t)16 * 8192 + p * 128] = eB * sb[1][r] + sb[0][r]; }
}
DEV void s1_lat_unit(Frame& F, int layer, int lb, int h, int dir) {
    LAS unsigned char* Bi = F.lds + 4096; LAS unsigned char* XF = Bi + 128 * 320; LAS unsigned char* XB = XF + 128 * 192;
    const int hh = F.lane >> 5, wpi = F.wave >> 2, wni = F.wave & 3;
    const LAS unsigned char* XA = dir ? XB : XF;
    S1Regs R;
    s1_load(F, 64 + 8 * lb + (dir ? 7 : 0), h, R);
    f32x16 S;
    { const float* s0 = F.in[IN_STATE + F.z] + ((size_t)((lb * 4 + layer) * 2 + dir) * 16 + h) * 8192 + (32 * wpi) * 128 + 32 * wni + (F.lane & 31);
#pragma unroll
      for (int r = 0; r < 16; ++r) S[r] = s0[crow(r, hh) * 128]; }
#pragma unroll 1
    for (int i = 0; i < 8; ++i) {
        const int ck = 64 + 8 * lb + (dir ? 7 - i : i);
        sin_store(F, S, ck, h, dir, wpi, wni);
        if (i == 7) break;
        __syncthreads();
        s1_store(F, R, Bi, XF, XB);
        const float e = __expf(dir ? R.atB : R.atF);
        __syncthreads();
        if (i < 6) s1_load(F, 64 + 8 * lb + (dir ? 6 - i : i + 1), h, R);
        f32x16 st;
#pragma unroll
        for (int r = 0; r < 16; ++r) st[r] = 0.f;
#pragma unroll
        for (int ks = 0; ks < 8; ++ks) {
            const int k0 = 16 * ks + 8 * hh;
            const bf16x8 b = tr2(Bi, 320, k0, k0 + 4, 32 * wni, F.lane);
            const bf16x8 xa = tr2(XA, 192, k0, k0 + 4, 32 * wpi, F.lane);
            st = MFMA32(xa, b, st);
        }
#pragma unroll
        for (int r = 0; r < 16; ++r) S[r] = e * S[r] + st[r];
    }
}

template <int NC>
DEV void stage_copy(Frame& F, const bf16* src, LAS unsigned char* img, int pitch) {
    constexpr int CPR = NC / 8, RPP = 512 / CPR;
    const int ch = F.tid % CPR, r0 = F.tid / CPR;
#pragma unroll
    for (int p = 0; p < 128 / RPP; ++p) { const int row = r0 + p * RPP; *(LAS u32x4*)(img + row * pitch + ch * 16) = *(const u32x4*)(src + (size_t)row * 2048 + ch * 8); }
}

struct S2Head { u32x4 xq[2], sq[4]; };
DEV void s2_head_load(Frame& F, const ChunkGeo& geo, int ck, int h, S2Head& H) {
    const bool nzf = ck >= 64 || (ck & 1) == 1, nzb = ck >= 64 || (ck & 1) == 0;
    const bf16* xc = (const bf16*)(F.ws + WS_XBCS) + (size_t)ck * 128 * 2048;
    { const int ch = F.tid & 7, r0 = F.tid >> 3;
#pragma unroll
      for (int p = 0; p < 2; ++p) H.xq[p] = *(const u32x4*)(xc + (size_t)(r0 + 64 * p) * 2048 + h * 64 + ch * 8); }
    { const bf16* S = (const bf16*)(F.ws + WS_SINB) + (size_t)(ck * 16 + h) * 2 * 8192;
      const int ch = F.tid & 15, r0 = F.tid >> 4;
#pragma unroll
      for (int p = 0; p < 4; ++p) { H.sq[p] = (u32x4){0u, 0u, 0u, 0u}; if (p < 2 ? nzf : nzb) H.sq[p] = *(const u32x4*)(S + (size_t)(r0 + 32 * p) * 128 + ch * 8); } }
}
DEV void s2_head_store(Frame& F, const S2Head& H, LAS unsigned char* Xi, LAS unsigned char* Si) {
    { const int ch = F.tid & 7, r0 = F.tid >> 3;
#pragma unroll
      for (int p = 0; p < 2; ++p) *(LAS u32x4*)(Xi + (r0 + 64 * p) * 192 + ch * 16) = H.xq[p]; }
    { const int ch = F.tid & 15, r0 = F.tid >> 4;
#pragma unroll
      for (int p = 0; p < 4; ++p) *(LAS u32x4*)(Si + (r0 + 32 * p) * 272 + ch * 16) = H.sq[p]; }
}
DEV void s2_unit(Frame& F, int layer, int ck, int g, int hp, bool dummy) {
    LAS float* tb0 = (LAS float*)F.lds;
    LAS unsigned char* Ci = F.lds + 8192;
    LAS unsigned char* Bi = Ci + 128 * 272;
    LAS unsigned char* Xi = Bi + 128 * 272;
    LAS unsigned char* Si = Xi + 128 * 192;
    LAS unsigned char* stg = Ci;
    bf16* AM = (bf16*)(F.ws + WS_AMG);
    float* SSQ = dummy ? (float*)(F.ws + WS_CTL + CTL_DUMMY) : (float*)(F.ws + WS_CTL + CTL_SSQ) + layer * NTOK;
    const int hh = F.lane >> 5, li = F.wave & 3, sh = F.wave >> 2, l31 = F.lane & 31, l = 32 * li + l31;
    const ChunkGeo geo = chunk_geo(ck, layer);
    const bool has_in = ck >= 64 || (ck & 1) == (sh ^ 1);
    S2Head H;
    {
        const bf16* xc = (const bf16*)(F.ws + WS_XBCS) + (size_t)ck * 128 * 2048;
        u32x4 cq[4], bq[4];
        { const int ch = F.tid & 15, r0 = F.tid >> 4;
#pragma unroll
          for (int p = 0; p < 4; ++p) { cq[p] = *(const u32x4*)(xc + (size_t)(r0 + 32 * p) * 2048 + 1536 + g * 128 + ch * 8); bq[p] = *(const u32x4*)(xc + (size_t)(r0 + 32 * p) * 2048 + 1024 + g * 128 + ch * 8); } }
        const u32x4 tq = *(const u32x4*)((const float*)(F.ws + WS_TB) + (size_t)(ck * 16 + 4 * g + 2 * hp) * 1024 + F.tid * 4);
        s2_head_load(F, geo, ck, 4 * g + 2 * hp, H);
        { const int ch = F.tid & 15, r0 = F.tid >> 4;
#pragma unroll
          for (int p = 0; p < 4; ++p) { *(LAS u32x4*)(Ci + (r0 + 32 * p) * 272 + ch * 16) = cq[p]; *(LAS u32x4*)(Bi + (r0 + 32 * p) * 272 + ch * 16) = bq[p]; } }
        *(LAS u32x4*)(tb0 + F.tid * 4) = tq;
        s2_head_store(F, H, Xi, Si);
    }
    __syncthreads();
    bf16x8 cf[8];
#pragma unroll
    for (int ks = 0; ks < 8; ++ks) cf[ks] = *(const LAS bf16x8*)(Ci + l * 272 + (16 * ks + 8 * hh) * 2);
    f32x16 gt[2];
#pragma unroll
    for (int sj = 0; sj < 2; ++sj) {
#pragma unroll
        for (int r = 0; r < 16; ++r) gt[sj][r] = 0.f;
#pragma unroll
        for (int ks = 0; ks < 8; ++ks) { const bf16x8 a = *(const LAS bf16x8*)(Bi + (32 * (2 * sh + sj) + l31) * 272 + (16 * ks + 8 * hh) * 2); gt[sj] = MFMA32(a, cf[ks], gt[sj]); }
    }
#pragma unroll 1
    for (int j = 0; j < 2; ++j) {
        const int h = 4 * g + 2 * hp + j;
        const LAS float* tb = tb0 + 1024 * j;
        u32x2 zq[4];
#pragma unroll
        for (int v = 0; v < 4; ++v) zq[v] = *(const u32x2*)((const bf16*)(F.ws + WS_PROJ) + (size_t)geo_row(geo, geo.pos0 + F.wave * 16 + 4 * v + (F.lane >> 4)) * NPROJ + PC_ZM + h * 64 + 4 * (F.lane & 15));
        if (j == 0) s2_head_load(F, geo, ck, h + 1, H);
        const float dsk = F.in[IN_DSKIP + F.z][layer * 16 + h];
        const float acFl = tb[4 * l], acBl = tb[4 * l + 2];
        f32x16 accd[2];
#pragma unroll
        for (int r = 0; r < 16; ++r) { accd[0][r] = 0.f; accd[1][r] = 0.f; }
        if (has_in) {
#pragma unroll
            for (int pi = 0; pi < 2; ++pi) {
#pragma unroll
                for (int ks = 0; ks < 8; ++ks) { const bf16x8 sb = *(const LAS bf16x8*)(Si + sh * (64 * 272) + (32 * pi + l31) * 272 + (16 * ks + 8 * hh) * 2); accd[pi] = MFMA32(cf[ks], sb, accd[pi]); }
#pragma unroll
                for (int r = 0; r < 16; ++r) accd[pi][r] *= tb[512 + sh * 128 + 32 * li + crow(r, hh)];
            }
        }
#pragma unroll
        for (int sj = 0; sj < 2; ++sj) {
            const int si = 2 * sh + sj;
            float m[16];
#pragma unroll
            for (int r = 0; r < 16; ++r) {
                const int s = 32 * si + crow(r, hh);
                const f32x4 ts = *(const LAS f32x4*)(tb + 4 * s);
                float w;
                if (si < li) w = __expf(acFl - ts.x) * ts.y;
                else if (si > li) w = __expf(acBl - ts.z) * ts.w;
                else { const float wf = __expf(fminf(acFl - ts.x, 0.f)) * ts.y, wb = __expf(fminf(acBl - ts.z, 0.f)) * ts.w; w = l > s ? wf : (l < s ? wb : ts.y + ts.w); }
                m[r] = gt[sj][r] * w + (l == s ? dsk : 0.f);
            }
#pragma unroll
            for (int t = 0; t < 2; ++t) {
                const bf16x8 ma = pack8(m[8 * t], m[8 * t + 1], m[8 * t + 2], m[8 * t + 3], m[8 * t + 4], m[8 * t + 5], m[8 * t + 6], m[8 * t + 7]);
                const int r0 = 32 * si + 16 * t + 4 * hh;
#pragma unroll
                for (int pi = 0; pi < 2; ++pi) { const bf16x8 xb = tr2(Xi, 192, r0, r0 + 8, 32 * pi, F.lane); accd[pi] = MFMA32(ma, xb, accd[pi]); }
            }
        }
        __syncthreads();
#pragma unroll
        for (int pi = 0; pi < 2; ++pi)
#pragma unroll
            for (int r = 0; r < 16; ++r) *(LAS float*)(stg + sh * (128 * 272) + (32 * li + crow(r, hh)) * 272 + (32 * pi + l31) * 4) = accd[pi][r];
        if (j == 0) s2_head_store(F, H, Xi, Si);
        __syncthreads();
        const int c4 = F.lane & 15;
        const f32x4 nw = *(const f32x4*)(F.in[IN_SSMNW + F.z] + layer * D + h * 64 + 4 * c4);
#pragma unroll
        for (int v = 0; v < 4; ++v) {
            const int lr = F.wave * 16 + 4 * v + (F.lane >> 4);
            const f32x4 y0 = *(const LAS f32x4*)(stg + lr * 272 + c4 * 16), y1 = *(const LAS f32x4*)(stg + 128 * 272 + lr * 272 + c4 * 16);
            const int row = geo_row(geo, geo.pos0 + lr);
            const u32x2 zr = zq[v];
            f32x4 y = y0 + y1;
            y.x *= bf2f(zr.x & 0xffffu); y.y *= bf2f(zr.x >> 16); y.z *= bf2f(zr.y & 0xffffu); y.w *= bf2f(zr.y >> 16);
            float q = (y.x * y.x + y.y * y.y) + (y.z * y.z + y.w * y.w);
            q += shfl_x(q, 1, F.lane); q += shfl_x(q, 2, F.lane); q += shfl_x(q, 4, F.lane); q += shfl_x(q, 8, F.lane);
            if (c4 == 0) atomicAdd(SSQ + row, q);
            y = y * nw;
            u32x2 o; o.x = pkbf(y.x, y.y); o.y = pkbf(y.z, y.w);
            *(u32x2*)(AM + (size_t)row * 2048 + h * 64 + 4 * c4) = o;
        }
        if (j == 0) __syncthreads();
    }
}

DEV void gmlp_unit(Frame& F, int layer, int vb) {
    LAS unsigned char* Vi = F.lds;
    LAS unsigned char* stg = F.lds + 128 * 320;
    LAS unsigned char* Wi = stg + 128 * 528;
    const bf16* proj = (const bf16*)(F.ws + WS_PROJ);
    const float* gsum = (const float*)(F.ws + WS_CTL + CTL_GSUM) + (size_t)layer * NTOK * 2;
    bf16* ag = (bf16*)(F.ws + WS_AMG) + 1024;
    const int hh = F.lane >> 5, ti = F.wave >> 1, cj = F.wave & 1, l31 = F.lane & 31;
    {
        const int ck = vb >> 3, g = vb & 7;
        u32x2 uq[8];
#pragma unroll
        for (int v = 0; v < 8; ++v) { const size_t ro = (size_t)(ck * 128 + F.wave * 16 + 2 * v + hh) * NPROJ + g * 128 + 4 * l31; uq[v] = *(const u32x2*)(proj + ro + PC_U); }
        {
            const bf16* wsrc = (const bf16*)(F.ws + WS_WSPB) + (size_t)(layer * 8 + g) * 128 * 128;
            const int ch = F.tid & 15, r0 = F.tid >> 4;
            u32x4 wq[4];
#pragma unroll
            for (int p = 0; p < 4; ++p) wq[p] = *(const u32x4*)(wsrc + (size_t)(r0 + 32 * p) * 128 + ch * 8);
#pragma unroll
            for (int p = 0; p < 4; ++p) *(LAS u32x4*)(Wi + (r0 + 32 * p) * 272 + ch * 16) = wq[p];
        }
        {
            const int s = F.tid >> 2, c0 = (F.tid & 3) * 32, row = ck * 128 + s;
            const float mu = gsum[row * 2] * (1.f / D), rstd = rsqrtf(fmaxf(gsum[row * 2 + 1] * (1.f / D) - mu * mu, 0.f) + EPS);
            const float* lnw = F.in[IN_LNW + F.z] + layer * D + g * 128 + c0; const float* lnb = F.in[IN_LNB + F.z] + layer * D + g * 128 + c0;
#pragma unroll
            for (int j = 0; j < 4; ++j) {
                const u32x4 r = *(const u32x4*)(proj + (size_t)row * NPROJ + PC_V + g * 128 + c0 + 8 * j);
                const f32x4 w0 = *(const f32x4*)(lnw + 8 * j), w1 = *(const f32x4*)(lnw + 8 * j + 4), b0 = *(const f32x4*)(lnb + 8 * j), b1 = *(const f32x4*)(lnb + 8 * j + 4);
                float v[8] = {bf2f(r.x & 0xffffu), bf2f(r.x >> 16), bf2f(r.y & 0xffffu), bf2f(r.y >> 16), bf2f(r.z & 0xffffu), bf2f(r.z >> 16), bf2f(r.w & 0xffffu), bf2f(r.w >> 16)};
                const float ww[8] = {w0.x, w0.y, w0.z, w0.w, w1.x, w1.y, w1.z, w1.w}, bb[8] = {b0.x, b0.y, b0.z, b0.w, b1.x, b1.y, b1.z, b1.w};
#pragma unroll
                for (int c = 0; c < 8; ++c) v[c] = (v[c] - mu) * rstd * ww[c] + bb[c];
                u32x4 o; o.x = pkbf(v[0], v[1]); o.y = pkbf(v[2], v[3]); o.z = pkbf(v[4], v[5]); o.w = pkbf(v[6], v[7]);
                *(LAS u32x4*)(Vi + s * 320 + (c0 + 8 * j) * 2) = o;
            }
        }
        __syncthreads();
        f32x16 acc[2];
#pragma unroll
        for (int r = 0; r < 16; ++r) { acc[0][r] = 0.f; acc[1][r] = 0.f; }
#pragma unroll
        for (int ks = 0; ks < 8; ++ks) {
            const int k0 = 16 * ks + 8 * hh;
            const bf16x8 a = *(const LAS bf16x8*)(Wi + (32 * ti + l31) * 272 + k0 * 2);
#pragma unroll
            for (int c = 0; c < 2; ++c) { const bf16x8 b = tr2(Vi, 320, k0, k0 + 4, 64 * cj + 32 * c, F.lane); acc[c] = MFMA32(a, b, acc[c]); }
        }
#pragma unroll
        for (int c = 0; c < 2; ++c)
#pragma unroll
            for (int r = 0; r < 16; ++r) *(LAS float*)(stg + (32 * ti + crow(r, hh)) * 528 + (64 * cj + 32 * c + l31) * 4) = acc[c][r];
        __syncthreads();
        const float* bsp = F.in[IN_BSP + F.z] + (layer * 8 + g) * 128;
#pragma unroll
        for (int v = 0; v < 8; ++v) {
            const int t = F.wave * 16 + 2 * v + hh, row = ck * 128 + t;
            const f32x4 sv = *(const LAS f32x4*)(stg + t * 528 + l31 * 16) + bsp[t];
            const u32x2 ur = uq[v];
            u32x2 o;
            o.x = pkbf(bf2f(ur.x & 0xffffu) * sv.x, bf2f(ur.x >> 16) * sv.y);
            o.y = pkbf(bf2f(ur.y & 0xffffu) * sv.z, bf2f(ur.y >> 16) * sv.w);
            *(u32x2*)(ag + (size_t)row * 2048 + g * 128 + 4 * l31) = o;
        }
    }
}

constexpr int CW_QUEUE = 8192;
DEV void ph_queue(const Frame& F0, int layer, int which, int qidx, bool dummy) {
    Frame F = launder(F0);
    asm volatile("" : "+s"(layer));
    unsigned* head = (unsigned*)(F.ws + WS_CTL) + CW_QUEUE + 64 * qidx;
    volatile LAS unsigned* slot = (volatile LAS unsigned*)(F.lds + LDS_BYTES - 256) + 16;
    const int N = which == 0 ? 64 + 512 : 640 + 640;
    __syncthreads();
    if (F.tid == 0) *slot = atomicAdd(head, 1u);
    __syncthreads();
    int it = (int)*slot;
    while (it < N) {
        unsigned nxt = 0u;
        Frame Fi = launder(F);
        if (Fi.tid == 0) nxt = atomicAdd((unsigned*)(Fi.ws + WS_CTL) + CW_QUEUE + 64 * qidx, 1u);
        if (which == 0) {
            if (it < 64) s1_lat_unit(Fi, layer, it >> 5, (it >> 1) & 15, it & 1);
            else s1_ctx_unit(Fi, layer, (it - 64) >> 4, (it - 64) & 15);
        } else {
            if (it < 640) s2_unit(Fi, layer, it >> 3, (it >> 1) & 3, it & 1, dummy);
            else gmlp_unit(Fi, layer, it - 640);
        }
        __syncthreads();
        if (nxt != 0u) *slot = nxt;
        __syncthreads();
        it = (int)*slot;
    }
}

DEV void ph_dt(const Frame& F0, int layer) {
    Frame F = launder(F0);
    asm volatile("" : "+s"(layer));
    LAS unsigned char* Ai = F.lds;
    LAS unsigned char* Wi = F.lds + 40 * 2064;
    LAS float* red = (LAS float*)F.lds;
    const int hh = F.lane >> 5, l31 = F.lane & 31;
    for (int u = F.bid; u < NTOK / 40; u += F.G) {
        __syncthreads();
        {   const bf16* A = (const bf16*)(F.ws + WS_HBUF) + (size_t)u * 40 * D;
            const bf16* W = (const bf16*)(F.ws + WS_WDT) + (size_t)layer * 32 * 1024;
            u32x4 aq[10], wq[8];
#pragma unroll
            for (int j = 0; j < 10; ++j) { const int c = F.tid + 512 * j; aq[j] = *(const u32x4*)(A + (size_t)(c >> 7) * D + (c & 127) * 8); }
#pragma unroll
            for (int j = 0; j < 8; ++j) { const int c = F.tid + 512 * j; wq[j] = *(const u32x4*)(W + (size_t)(c >> 7) * 1024 + (c & 127) * 8); }
#pragma unroll
            for (int j = 0; j < 10; ++j) { const int c = F.tid + 512 * j; *(LAS u32x4*)(Ai + (c >> 7) * 2064 + (c & 127) * 16) = aq[j]; }
#pragma unroll
            for (int j = 0; j < 8; ++j) { const int c = F.tid + 512 * j; *(LAS u32x4*)(Wi + (c >> 7) * 2064 + (c & 127) * 16) = wq[j]; }
        }
        __syncthreads();
        f32x16 acc[2];
#pragma unroll
        for (int r = 0; r < 16; ++r) { acc[0][r] = 0.f; acc[1][r] = 0.f; }
#pragma unroll
        for (int ks = 0; ks < 8; ++ks) {
            const int kb = (128 * F.wave + 16 * ks + 8 * hh) * 2;
            const bf16x8 b = *(const LAS bf16x8*)(Wi + l31 * 2064 + kb);
            const bf16x8 a0 = *(const LAS bf16x8*)(Ai + l31 * 2064 + kb), a1 = *(const LAS bf16x8*)(Ai + (32 + l31) * 2064 + kb);
            acc[0] = MFMA32(a0, b, acc[0]); acc[1] = MFMA32(a1, b, acc[1]);
        }
        __syncthreads();
#pragma unroll
        for (int t = 0; t < 2; ++t)
#pragma unroll
            for (int r = 0; r < 16; ++r) red[((F.wave * 2 + t) * 32 + crow(r, hh)) * 32 + l31] = acc[t][r];
        __syncthreads();
        for (int o = F.tid; o < 40 * 32; o += 512) {
            const int r = o >> 5, j = o & 31, t = r >> 5, rr = r & 31;
            float v = 0.f;
#pragma unroll
            for (int w = 0; w < 8; ++w) v += red[((w * 2 + t) * 32 + rr) * 32 + j];
            const int row = u * 40 + r;
            const float rs = rsqrtf(((const float*)(F.ws + WS_CTL + CTL_SSQX))[(size_t)layer * NTOK + row] * (1.f / D) + EPS);
            const float swv = ((const float*)(F.ws + WS_CTL + CTL_SW))[(size_t)(layer * 3 + (row < NCTX ? 0 : 1 + ((row - NCTX) >> 10))) * DIN + 3072 + j];
            ((float*)(F.ws + WS_DTRAW))[(size_t)row * 32 + j] = v * rs + swv;
        }
    }
}

#define XB_TMO      128
#define XB_XCNT(j)  (256  + 64 * (j))
#define XB_XSUB(j)  (1280 + 64 * (j))
#define XB_XGEN(j)  (2304 + 64 * (j))
#define XB_TOP      3328
#define XB_TOPGEN   3392
#define XCD_BAR_WORDS 3456
#define XB_SPIN_CAP (1u << 18)

__device__ __forceinline__ unsigned xb_ld(unsigned* p)              { return __hip_atomic_load(p, __ATOMIC_RELAXED, __HIP_MEMORY_SCOPE_AGENT); }
__device__ __forceinline__ unsigned xb_add(unsigned* p, unsigned v) { return __hip_atomic_fetch_add(p, v, __ATOMIC_RELAXED, __HIP_MEMORY_SCOPE_AGENT); }
__device__ __forceinline__ unsigned xb_xcc_id() { return (unsigned)__builtin_amdgcn_s_getreg((3 << 11) | 20) & 0xFu; }
#define XB_SPIN(cond, bar) do { unsigned _sp = 0; while (cond) { __builtin_amdgcn_s_sleep(1); \
    if ((++_sp & 255u) == 0u) { if (xb_ld(&(bar)[XB_TMO])) break; if (_sp > XB_SPIN_CAP) { atomicAdd(&(bar)[XB_TMO], 1u); break; } } } } while (0)

struct XcdBarrier {
    unsigned* bar; unsigned x;
    volatile LAS unsigned* st;
};

__device__ __forceinline__ XcdBarrier xcd_barrier_post(unsigned* bar, volatile LAS unsigned* st) {
    XcdBarrier b; b.bar = bar; b.x = xb_xcc_id(); b.st = st;
    if (threadIdx.x == 0) (void)xb_add(&bar[XB_XCNT(b.x)], 1u);
    return b;
}
__device__ __forceinline__ void xcd_barrier_complete(unsigned* bar, unsigned x, unsigned& nloc, unsigned& nx) {
    const unsigned G = gridDim.x * gridDim.y * gridDim.z;
    unsigned sum, cnt, mine, sp = 0u;
    for (;;) {
        sum = 0u; cnt = 0u; mine = 0u;
#pragma unroll
        for (unsigned j = 0; j < 16; ++j) { const unsigned c = xb_ld(&bar[XB_XCNT(j)]); sum += c; cnt += (c > 0u) ? 1u : 0u; mine = (j == x) ? c : mine; }
        if (sum == G) break;
        __builtin_amdgcn_s_sleep(1);
        if ((++sp & 255u) == 0u) { if (xb_ld(&bar[XB_TMO])) break; if (sp > XB_SPIN_CAP) { atomicAdd(&bar[XB_TMO], 1u); break; } }
    }
    nloc = mine > 0u ? mine : 1u; nx = cnt > 0u ? cnt : 1u;
}

__device__ __forceinline__ void xcd_barrier(const XcdBarrier& b) {
    asm volatile("s_waitcnt vmcnt(0)" ::: "memory");
    __syncthreads();
    if (threadIdx.x == 0) {
        unsigned* bar = b.bar;
        __builtin_amdgcn_s_waitcnt(0);
        unsigned nloc = b.st[0], nx = b.st[1];
        if (nloc == 0u) { xcd_barrier_complete(bar, b.x, nloc, nx); b.st[0] = nloc; b.st[1] = nx; }
        const unsigned old = xb_add(&bar[XB_XSUB(b.x)], 1u);
        const unsigned gen = old / nloc;
        if (old + 1u == (gen + 1u) * nloc) {
            __builtin_amdgcn_fence(__ATOMIC_RELEASE, "agent");
            asm volatile("s_waitcnt vmcnt(0)" ::: "memory");
            const unsigned og = xb_add(&bar[XB_TOP], 1u);
            const unsigned tg = og / nx;
            if (og + 1u == (tg + 1u) * nx) xb_add(&bar[XB_TOPGEN], 1u);
            else XB_SPIN(xb_ld(&bar[XB_TOPGEN]) == tg, bar);
            __builtin_amdgcn_fence(__ATOMIC_ACQUIRE, "agent");
            xb_add(&bar[XB_XGEN(b.x)], 1u);
            asm volatile("s_waitcnt vmcnt(0)" ::: "memory");
        } else {
            XB_SPIN(xb_ld(&bar[XB_XGEN(b.x)]) == gen, bar);
            __builtin_amdgcn_fence(__ATOMIC_ACQUIRE, "agent");
            asm volatile("s_waitcnt vmcnt(0)" ::: "memory");
        }
    }
    __syncthreads();
}

struct EpiIn {
    static constexpr bool PERM = true, AFTER_DRAIN = false, HAS_MID = false;
    bf16* O; const float* ssqx; const float* sw; float* gsum;
    __device__ __forceinline__ void operator()(const f32x4 (&acc)[2][2][4][2], const pg8::Unit& u, int wr, int wc, int fr, int fq) const {
        int row0 = u.pm * 256 + wr * 64 + fr, cl = wc * 32 + 8 * fq;
        asm volatile("" : "+v"(row0), "+v"(cl));
        const int mv = u.pm < 32 ? 0 : 1 + ((u.pm - 32) >> 2);
        const int kind = u.pn < 8 ? 0 : u.pn < 12 ? 1 : u.pn < 20 ? 2 : u.pn < 24 ? 3 : 4;
        int nat[2], oc[2];
        if (u.pn < 12) { nat[0] = u.pn * 256; nat[1] = nat[0] + 128; oc[0] = nat[0]; oc[1] = nat[1]; }
        else if (u.pn < 20) { nat[0] = 3104 + (u.pn - 12) * 128; nat[1] = 5152 + (u.pn - 12) * 128; oc[0] = PC_U + (u.pn - 12) * 128; oc[1] = oc[0]; }
        else if (u.pn < 24) { nat[0] = 4128 + (u.pn - 20) * 256; nat[1] = nat[0] + 128; oc[0] = PC_V + (u.pn - 20) * 256; oc[1] = oc[0] + 128; }
        else { nat[0] = 6176 + (u.pn - 24) * 256; nat[1] = nat[0] + 128; oc[0] = PC_GLM + (u.pn - 24) * 256; oc[1] = oc[0] + 128; }
        f32x4 bv[2][2];
#pragma unroll
        for (int bj = 0; bj < 2; ++bj)
#pragma unroll
            for (int n = 0; n < 2; ++n) bv[bj][n] = *(const f32x4*)(sw + mv * DIN + nat[bj] + cl + 4 * n);
#pragma unroll
        for (int ai = 0; ai < 2; ++ai)
#pragma unroll
            for (int m = 0; m < 4; ++m) {
                const int r = row0 + ai * 128 + m * 16;
                const float rs = rsqrtf(ssqx[r] * (1.f / D) + EPS);
                float v[2][8];
#pragma unroll
                for (int bj = 0; bj < 2; ++bj)
#pragma unroll
                    for (int j = 0; j < 4; ++j) { v[bj][j] = acc[ai][bj][m][0][j] * rs + bv[bj][0][j]; v[bj][4 + j] = acc[ai][bj][m][1][j] * rs + bv[bj][1][j]; }
                if (kind == 2) {
#pragma unroll
                    for (int j = 0; j < 8; ++j) v[0][j] = gelu_f(v[0][j]) * silu_f(v[1][j]);
                    u32x4 w; w.x = pkbf(v[0][0], v[0][1]); w.y = pkbf(v[0][2], v[0][3]); w.z = pkbf(v[0][4], v[0][5]); w.w = pkbf(v[0][6], v[0][7]);
                    *(u32x4*)(O + (size_t)r * NPROJ + oc[0] + cl) = w;
                } else {
                    float s1 = 0.f, s2 = 0.f;
#pragma unroll
                    for (int bj = 0; bj < 2; ++bj) {
                        if (kind == 1) {
#pragma unroll
                            for (int j = 0; j < 8; ++j) v[bj][j] = silu_f(v[bj][j]);
                        } else if (kind == 3) {
#pragma unroll
                            for (int j = 0; j < 8; ++j) { v[bj][j] = gelu_f(v[bj][j]); s1 += v[bj][j]; s2 += v[bj][j] * v[bj][j]; }
                        } else if (kind == 4) {
#pragma unroll
                            for (int j = 0; j < 8; ++j) v[bj][j] = sigmoid_f(v[bj][j]);
                        }
                        u32x4 w; w.x = pkbf(v[bj][0], v[bj][1]); w.y = pkbf(v[bj][2], v[bj][3]); w.z = pkbf(v[bj][4], v[bj][5]); w.w = pkbf(v[bj][6], v[bj][7]);
                        *(u32x4*)(O + (size_t)r * NPROJ + oc[bj] + cl) = w;
                    }
                    if (kind == 3) {
                        const int ln = fr + 16 * fq; s1 += shfl_x(s1, 16, ln); s1 += shfl_x(s1, 32, ln); s2 += shfl_x(s2, 16, ln); s2 += shfl_x(s2, 32, ln);
                        if (fq == 0) { atomicAdd(gsum + 2 * r, s1); atomicAdd(gsum + 2 * r + 1, s2); }
                    }
                }
                asm volatile("" ::: "memory");
            }
    }
};
struct EpiMerge {
    static constexpr bool PERM = true, AFTER_DRAIN = false, HAS_MID = true;
    bf16* O; const bf16* proj; const float* ssq;
    __device__ __forceinline__ void mid(f32x4 (&acc)[2][2][4][2], const pg8::Unit& u, int wr, int wc, int fr, int fq) const {
        int row0 = u.pm * 256 + wr * 64 + fr, col0 = u.pn * 256 + wc * 32 + 8 * fq;
        asm volatile("" : "+v"(row0), "+v"(col0));
#pragma unroll
        for (int ai = 0; ai < 2; ++ai)
#pragma unroll
            for (int m = 0; m < 4; ++m) {
                const int r = row0 + ai * 128 + m * 16;
                const float rs = rsqrtf(ssq[r] * (1.f / D) + EPS);
#pragma unroll
                for (int bj = 0; bj < 2; ++bj) {
                    const u32x4 gm = *(const u32x4*)(proj + (size_t)r * NPROJ + PC_GLM + col0 + bj * 128), gg = *(const u32x4*)(proj + (size_t)r * NPROJ + PC_GLG + col0 + bj * 128);
                    acc[ai][bj][m][0][0] *= bf2f(gm.x & 0xffffu) * rs / bf2f(gg.x & 0xffffu); acc[ai][bj][m][0][1] *= bf2f(gm.x >> 16) * rs / bf2f(gg.x >> 16);
                    acc[ai][bj][m][0][2] *= bf2f(gm.y & 0xffffu) * rs / bf2f(gg.y & 0xffffu); acc[ai][bj][m][0][3] *= bf2f(gm.y >> 16) * rs / bf2f(gg.y >> 16);
                    acc[ai][bj][m][1][0] *= bf2f(gm.z & 0xffffu) * rs / bf2f(gg.z & 0xffffu); acc[ai][bj][m][1][1] *= bf2f(gm.z >> 16) * rs / bf2f(gg.z >> 16);
                    acc[ai][bj][m][1][2] *= bf2f(gm.w & 0xffffu) * rs / bf2f(gg.w & 0xffffu); acc[ai][bj][m][1][3] *= bf2f(gm.w >> 16) * rs / bf2f(gg.w >> 16);
                }
                asm volatile("" ::: "memory");
            }
    }
    __device__ __forceinline__ void operator()(const f32x4 (&acc)[2][2][4][2], const pg8::Unit& u, int wr, int wc, int fr, int fq) const {
        int row0 = u.pm * 256 + wr * 64 + fr, col0 = u.pn * 256 + wc * 32 + 8 * fq;
        asm volatile("" : "+v"(row0), "+v"(col0));
#pragma unroll
        for (int ai = 0; ai < 2; ++ai)
#pragma unroll
            for (int m = 0; m < 4; ++m) {
                const int r = row0 + ai * 128 + m * 16;
#pragma unroll
                for (int bj = 0; bj < 2; ++bj) {
                    const u32x4 gg = *(const u32x4*)(proj + (size_t)r * NPROJ + PC_GLG + col0 + bj * 128);
                    u32x4 w;
                    w.x = pkbf(acc[ai][bj][m][0][0] * bf2f(gg.x & 0xffffu), acc[ai][bj][m][0][1] * bf2f(gg.x >> 16));
                    w.y = pkbf(acc[ai][bj][m][0][2] * bf2f(gg.y & 0xffffu), acc[ai][bj][m][0][3] * bf2f(gg.y >> 16));
                    w.z = pkbf(acc[ai][bj][m][1][0] * bf2f(gg.z & 0xffffu), acc[ai][bj][m][1][1] * bf2f(gg.z >> 16));
                    w.w = pkbf(acc[ai][bj][m][1][2] * bf2f(gg.w & 0xffffu), acc[ai][bj][m][1][3] * bf2f(gg.w >> 16));
                    *(u32x4*)(O + (size_t)r * D + col0 + bj * 128) = w;
                }
                asm volatile("" ::: "memory");
            }
    }
};
struct EpiOut {
    static constexpr bool PERM = true, AFTER_DRAIN = false, HAS_MID = false;
    const float* xp; const float* xs; const float* xold; float* xnew; bf16* hx; const float* mod; const float* gn; float* ssqn;
    __device__ __forceinline__ void operator()(const f32x4 (&acc)[2][2][4][2], const pg8::Unit& u, int wr, int wc, int fr, int fq) const {
        int row0 = u.pm * 256 + wr * 64 + fr, col0 = u.pn * 256 + wc * 32 + 8 * fq;
        asm volatile("" : "+v"(row0), "+v"(col0));
        const int mv = u.pm < 32 ? 0 : 1 + ((u.pm - 32) >> 2);
        const float* xo = xold ? xold : (u.pm < 32 ? xp : xs - (size_t)NCTX * D);
        const float* gate = mod + mv * 3072 + 2048 + col0;
        const float* g2 = gn ? gn + mv * 1024 + col0 : nullptr;
#pragma unroll
        for (int ai = 0; ai < 2; ++ai)
#pragma unroll
            for (int m = 0; m < 4; ++m) {
                const int r = row0 + ai * 128 + m * 16;
                float q = 0.f;
#pragma unroll
                for (int bj = 0; bj < 2; ++bj) {
                    const size_t off = (size_t)r * D + col0 + bj * 128;
                    const f32x4 x0 = *(const f32x4*)(xo + off), x1 = *(const f32x4*)(xo + off + 4);
                    const f32x4 ga0 = *(const f32x4*)(gate + bj * 128), ga1 = *(const f32x4*)(gate + bj * 128 + 4);
                    const f32x4 n0 = x0 + ga0 * acc[ai][bj][m][0], n1 = x1 + ga1 * acc[ai][bj][m][1];
                    *(f32x4*)(xnew + off) = n0; *(f32x4*)(xnew + off + 4) = n1;
                    q += (n0.x * n0.x + n0.y * n0.y) + (n0.z * n0.z + n0.w * n0.w) + (n1.x * n1.x + n1.y * n1.y) + (n1.z * n1.z + n1.w * n1.w);
                    if (g2) { const f32x4 h0 = n0 * *(const f32x4*)(g2 + bj * 128), h1 = n1 * *(const f32x4*)(g2 + bj * 128 + 4);
                        u32x4 w; w.x = pkbf(h0.x, h0.y); w.y = pkbf(h0.z, h0.w); w.z = pkbf(h1.x, h1.y); w.w = pkbf(h1.z, h1.w);
                        *(u32x4*)(hx + off) = w; }
                }
                { const int ln = fr + 16 * fq; q += shfl_x(q, 16, ln); q += shfl_x(q, 32, ln); }
                if (fq == 0) atomicAdd(ssqn + r, q);
                asm volatile("" ::: "memory");
            }
    }
};

constexpr int CW_BAR = 4096;
constexpr int MISC_OFF = LDS_BYTES - 256;

__global__ void __launch_bounds__(512, 2) mega(Args args) {
    extern __shared__ __attribute__((aligned(16))) unsigned char lds[];
    Frame F;
    F.lds = (LAS unsigned char*)lds; F.tid = threadIdx.x; F.lane = F.tid & 63; F.wave = __builtin_amdgcn_readfirstlane(F.tid >> 6);
    F.G = gridDim.x; F.bid = blockIdx.x; F.in = args.in; F.out = args.out; F.ws = args.ws; F.z = 0;
    volatile LAS unsigned* MISC = (volatile LAS unsigned*)(F.lds + MISC_OFF);
    if (F.tid < 64) MISC[F.tid] = 0u;
    __syncthreads();
    (void)xcd_barrier_post((unsigned*)(F.ws + WS_CTL) + CW_BAR, MISC + 8);
#define GRID_BAR() do { Frame Fb = launder(F); XcdBarrier b_; b_.bar = (unsigned*)(Fb.ws + WS_CTL) + CW_BAR; b_.x = xb_xcc_id(); b_.st = (volatile LAS unsigned*)(Fb.lds + MISC_OFF) + 8; xcd_barrier(b_); } while (0)
    ph_mod(F); GRID_BAR();
    ph_cvt(F, 0, 0, F.G); ph_gn(F); ph_prep0(F); GRID_BAR();
    for (int layer = 0; layer < DEPTH; ++layer) {
        { Frame Fg = launder(F);
          pg8::Gemm g{(const bf16*)(Fg.ws + WS_HBUF), (const bf16*)(Fg.ws + WS_WIN) + (size_t)layer * NPROJ * 1024, NTOK, NPROJ, D};
          pg8::StaticOrder S; S.init(NTOK, NPROJ, Fg.G, Fg.bid);
          EpiIn E{(bf16*)(Fg.ws + WS_PROJ), (const float*)(Fg.ws + WS_CTL + CTL_SSQX) + (size_t)layer * NTOK, (const float*)(Fg.ws + WS_CTL + CTL_SW) + (size_t)layer * 3 * DIN,
                  (float*)(Fg.ws + WS_CTL + CTL_GSUM) + (size_t)layer * NTOK * 2};
          pg8::gemm_phase<EpiIn, pg8::StaticOrder, true, true>(Fg.lds, g, S, E, Fg.wave); }
        ph_dt(F, layer);
        GRID_BAR();
        ph_b0(F, layer); GRID_BAR();
        if (DUP_MASK & 1) { ph_b0(F, layer); GRID_BAR(); }
        ph_queue(F, layer, 0, layer, false); GRID_BAR();
        if (DUP_MASK & 2) { ph_queue(F, layer, 0, 8 + layer, false); GRID_BAR(); }
        ph_queue(F, layer, 1, 4 + layer, false); GRID_BAR();
        if (DUP_MASK & 4) { ph_queue(F, layer, 1, 12 + layer, true); GRID_BAR(); }
        { Frame Fg = launder(F);
          pg8::Gemm g{(const bf16*)(Fg.ws + WS_AMG), (const bf16*)(Fg.ws + WS_WMG) + (size_t)layer * 1024 * 2048, NTOK, D, 2048};
          pg8::StaticOrder S; S.init(NTOK, D, Fg.G, Fg.bid);
          EpiMerge E{(bf16*)(Fg.ws + WS_MRG), (const bf16*)(Fg.ws + WS_PROJ), (const float*)(Fg.ws + WS_CTL + CTL_SSQ) + (size_t)layer * NTOK};
          pg8::gemm_phase<EpiMerge, pg8::StaticOrder, true, true>(Fg.lds, g, S, E, Fg.wave); }
        if (layer + 1 < DEPTH) ph_cvt(F, layer + 1, 160, F.G - 160);
        GRID_BAR();
        { Frame Fg = launder(F);
          pg8::Gemm g{(const bf16*)(Fg.ws + WS_MRG), (const bf16*)(Fg.ws + WS_WO) + (size_t)layer * 1024 * 1024, NTOK, D, D};
          pg8::StaticOrder S; S.init(NTOK, D, Fg.G, Fg.bid);
          EpiOut E{Fg.in[IN_XP + Fg.z], Fg.in[IN_XS + Fg.z], layer == 0 ? nullptr : (const float*)(Fg.ws + WS_XBUF), (float*)(Fg.ws + WS_XBUF), (bf16*)(Fg.ws + WS_HBUF),
                   (const float*)(Fg.ws + WS_MOD) + (size_t)layer * 3 * 3072, layer + 1 < DEPTH ? (const float*)(Fg.ws + WS_GN) + (size_t)(layer + 1) * 3 * 1024 : nullptr,
                   (float*)(Fg.ws + WS_CTL + CTL_SSQX) + (size_t)(layer + 1) * NTOK};
          pg8::gemm_phase<EpiOut, pg8::StaticOrder, true, true>(Fg.lds, g, S, E, Fg.wave); }
        GRID_BAR();
    }
    ph_final(F);
}

extern "C" void kernel_launch(void* const* d_in, const int* in_sizes, int n_in, void* d_out, int out_size, void* d_ws, size_t ws_size, hipStream_t stream) {
    static int grid = 0;
    if (grid == 0) {
        if (n_in != 23 || ws_size < WS_END) { fprintf(stderr, "kernel_launch: need 23 inputs and %zu bytes of workspace; got %d, %zu\n", (size_t)WS_END, n_in, ws_size); grid = -1; return; }
        int dev = 0, cus = 0;
        if (hipGetDevice(&dev) != hipSuccess || hipDeviceGetAttribute(&cus, hipDeviceAttributeMultiprocessorCount, dev) != hipSuccess) { grid = -1; return; }
        if (hipFuncSetAttribute((const void*)mega, hipFuncAttributeMaxDynamicSharedMemorySize, LDS_BYTES) != hipSuccess) { fprintf(stderr, "kernel_launch: hipFuncSetAttribute failed\n"); grid = -1; return; }
        grid = cus;
    }
    if (grid < 0) return;
    if (hipMemsetAsync((char*)d_ws + WS_CTL, 0, CTL_BYTES, stream) != hipSuccess) return;
    Args a{};
    for (int i = 0; i < 23; ++i) a.in[i] = (const float*)d_in[i];
    a.out = (float*)d_out; a.ws = (unsigned char*)d_ws;
    hipLaunchKernelGGL(mega, dim3(grid), dim3(512), LDS_BYTES, stream, a);
}
```

```cpp
#define DUP_MASK 0
#include <hip/hip_runtime.h>
#include <cstdio>
#include <cstdint>
namespace pg8 {
#define PG8_LAS __attribute__((address_space(3)))
typedef unsigned short bf16_t;
typedef short bf16x8 __attribute__((ext_vector_type(8)));
typedef float f32x4 __attribute__((ext_vector_type(4)));
typedef unsigned u32x4 __attribute__((ext_vector_type(4)));
constexpr int BM = 256, BK = 64, HALF = 128, HTB = HALF * BK * 2  , STAGE_BYTES = 8 * HTB, NXCD = 8, WGM = 8;

__host__ __device__ __forceinline__ int lds_byte(int r, int c) { const int st = (r >> 4) * 2 + (c >> 5), rr = r & 15, cc = c & 31, ob = rr * 64 + cc * 2; return st * 1024 + (ob ^ (((ob >> 9) & 1) << 5)); }
__host__ __device__ __forceinline__ void stage_rc(int b, int& R, int& C) { const int st = b / 1024, sb = b % 1024, swz = sb ^ (((sb >> 9) & 1) << 5); R = (st >> 1) * 16 + swz / 64; C = (st & 1) * 32 + (swz % 64) / 2; }
__host__ __device__ __forceinline__ int perm32(int rho) { const int n = rho >> 4, i = rho & 15; return 8 * (i >> 2) + 4 * n + (i & 3); }

struct Unit { int pm, pn; };
struct Gemm { const bf16_t* A; const bf16_t* Bt; int M, N, K; };

struct StaticOrder {
    int nM, nN, nwg, G, c;
    __host__ __device__ void init(int M, int N, int G_, int c_) { nM = M / BM; nN = N / BM; nwg = nM * nN; G = G_; c = c_; }
    __host__ __device__ bool next(int i, Unit& u) const {
        const long L = (long)i * G + c; if (L >= nwg) return false;
        int wgid = (int)L; { const int q = nwg / NXCD, r = nwg % NXCD, xcd = wgid % NXCD, off = wgid / NXCD; wgid = (xcd < r ? xcd * (q + 1) : r * (q + 1) + (xcd - r) * q) + off; }
        const int nig = WGM * nN, gid = wgid / nig, fm = gid * WGM, gsz = (nM - fm) < WGM ? (nM - fm) : WGM;
        u.pm = fm + ((wgid % nig) % gsz); u.pn = (wgid % nig) / gsz; return true;
    }
    __device__ __forceinline__ void a_ready(const Unit&) const {}
    __device__ __forceinline__ void done(const Unit&) const {}
};

__device__ __forceinline__ unsigned cvt_pk_bf16(float lo, float hi) { unsigned r; asm volatile("v_cvt_pk_bf16_f32 %0, %1, %2" : "=v"(r) : "v"(lo), "v"(hi)); return r; }
typedef float f32x2 __attribute__((ext_vector_type(2)));
__device__ __forceinline__ f32x2 gelu_pk(f32x2 v) {
    const f32x2 av = __builtin_elementwise_abs(v), d = av * 0.2316418882f + 1.0f;
    f32x2 t; t.x = __builtin_amdgcn_rcpf(d.x); t.y = __builtin_amdgcn_rcpf(d.y);
    f32x2 q = t * 0.5307027145f + (-0.7265760135f); q = q * t + 0.7107068705f; q = q * t + (-0.142248368f); q = q * t + 0.127414796f; q = q * t;
    const f32x2 s = (v * v) * (-0.72134752044f);
    f32x2 e; e.x = __builtin_amdgcn_exp2f(s.x); e.y = __builtin_amdgcn_exp2f(s.y);
    const f32x2 m = v * (q * e), r = v - m;
    f32x2 o; o.x = v.x < 0.f ? m.x : r.x; o.y = v.y < 0.f ? m.y : r.y; return o;
}

template <int ACT  > struct EpiBf16 {
    static constexpr bool PERM = true, AFTER_DRAIN = false, HAS_MID = false; static_assert(ACT == 0 || ACT == 1, "EpiBf16: ACT is 0 (none) or 1 (gelu_pk)");
    bf16_t* O; int ldc; const float* bias; int split_cols; size_t split_stride; float scale0;
    __device__ __forceinline__ void operator()(const f32x4 (&acc)[2][2][4][2], const Unit& u, int wr, int wc, int fr, int fq) const {
        const int row0 = u.pm * BM + wr * 64 + fr; int colt = u.pn * BM; bf16_t* base = O;
        float sc = 1.f; if (split_cols) { const int t = colt / split_cols; base += (size_t)t * split_stride; colt -= t * split_cols; if (t == 0) sc = scale0; }
        const int col0 = colt + wc * 32 + 8 * fq, bcol0 = u.pn * BM + wc * 32 + 8 * fq;
        f32x4 bv[2][2];
#pragma unroll
        for (int bj = 0; bj < 2; ++bj)
#pragma unroll
            for (int n = 0; n < 2; ++n) bv[bj][n] = bias ? *(const f32x4*)(bias + bcol0 + bj * HALF + 4 * n) : (f32x4){0.f, 0.f, 0.f, 0.f};
#pragma unroll
        for (int ai = 0; ai < 2; ++ai)
#pragma unroll
            for (int m = 0; m < 4; ++m) { bf16_t* rowp = base + (size_t)(row0 + ai * HALF + m * 16) * ldc + col0;
#pragma unroll
                for (int bj = 0; bj < 2; ++bj) { f32x4 v0 = acc[ai][bj][m][0] + bv[bj][0], v1 = acc[ai][bj][m][1] + bv[bj][1];
                    if (ACT == 1) { f32x2 a = gelu_pk((f32x2){v0[0], v0[1]}), b = gelu_pk((f32x2){v0[2], v0[3]}), c = gelu_pk((f32x2){v1[0], v1[1]}), d = gelu_pk((f32x2){v1[2], v1[3]});
                        v0 = (f32x4){a.x, a.y, b.x, b.y}; v1 = (f32x4){c.x, c.y, d.x, d.y}; }
                    v0 = v0 * sc; v1 = v1 * sc; u32x4 w; w.x = cvt_pk_bf16(v0[0], v0[1]); w.y = cvt_pk_bf16(v0[2], v0[3]); w.z = cvt_pk_bf16(v1[0], v1[1]); w.w = cvt_pk_bf16(v1[2], v1[3]);
                    *(u32x4*)(rowp + bj * HALF) = w; } }
    }
};
struct EpiF32 {
    static constexpr bool PERM = false, AFTER_DRAIN = false, HAS_MID = false;
    float* C; int ldc; const float* bias;
    __device__ __forceinline__ void operator()(const f32x4 (&acc)[2][2][4][2], const Unit& u, int wr, int wc, int fr, int fq) const {
        const int row0 = u.pm * BM + wr * 64 + fr, col0 = u.pn * BM + wc * 32 + 4 * fq;
        f32x4 bv[2][2];
#pragma unroll
        for (int bj = 0; bj < 2; ++bj)
#pragma unroll
            for (int n = 0; n < 2; ++n) bv[bj][n] = bias ? *(const f32x4*)(bias + col0 + bj * HALF + n * 16) : (f32x4){0.f, 0.f, 0.f, 0.f};
#pragma unroll
        for (int ai = 0; ai < 2; ++ai)
#pragma unroll
            for (int m = 0; m < 4; ++m) { float* rowp = C + (size_t)(row0 + ai * HALF + m * 16) * ldc + col0;
#pragma unroll
                for (int bj = 0; bj < 2; ++bj)
#pragma unroll
                    for (int n = 0; n < 2; ++n) *(f32x4*)(rowp + bj * HALF + n * 16) = acc[ai][bj][m][n] + bv[bj][n]; }
    }
};
template <class Epi, class Sched, bool ALIGN_EPI = false, bool SP2 = false>
__device__ __forceinline__ void gemm_phase(PG8_LAS unsigned char* lds, const Gemm g, const Sched& S, const Epi& E, int wave_id) {
    int tid_ = wave_id * 64 + (int)__builtin_amdgcn_mbcnt_hi(~0u, __builtin_amdgcn_mbcnt_lo(~0u, 0u)); asm volatile("" : "+v"(tid_));
    const int tid = tid_, wid = __builtin_amdgcn_readfirstlane(tid >> 6), lane = tid & 63, wr = wid >> 2, wc = wid & 3, fr = lane & 15, fq = lane >> 4;
    const int K = g.K, nt = K / BK;
    unsigned voffA[2], voffB[2];
#pragma unroll
    for (int i = 0; i < 2; ++i) { int R, C; stage_rc(tid * 16 + i * 8192, R, C); const int Rb = Epi::PERM ? ((R & ~31) + perm32(R & 31)) : R;
        voffA[i] = (unsigned)(R * K + C) * 2u; voffB[i] = (unsigned)(Rb * K + C) * 2u; }
    const size_t kstep = (size_t)(BK * 2);
    const size_t hstep = (size_t)HALF * K * 2;
    const size_t tstep = 2 * hstep;
    const unsigned ldsw = (unsigned)wid * 1024u;
    const int aoff = lds_byte(wr * 64 + fr, fq * 8), boff = lds_byte(wc * 32 + fr, fq * 8);
#define PG8_SA(b, h) (((b) * 2 + (h)) * HTB)
#define PG8_SB(b, h) ((4 + (b) * 2 + (h)) * HTB)
#define PG8_STAGE(bufoff, gbase, voff) do { _Pragma("unroll") for (int _i = 0; _i < 2; ++_i) \
        __builtin_amdgcn_global_load_lds((const unsigned*)((const char*)(gbase) + (voff)[_i]), (PG8_LAS unsigned*)(lds + (bufoff) + ldsw + _i * 8192), 16, 0, 0); } while (0)
#define PG8_LDA(dst, b, h) do { _Pragma("unroll") for (int m = 0; m < 4; ++m) _Pragma("unroll") for (int k = 0; k < 2; ++k) dst[m][k] = *(const PG8_LAS bf16x8*)(lds + PG8_SA(b, h) + aoff + m * 2048 + k * 1024); } while (0)
#define PG8_LDB(dst, b, h) do { _Pragma("unroll") for (int n = 0; n < 2; ++n) _Pragma("unroll") for (int k = 0; k < 2; ++k) dst[n][k] = *(const PG8_LAS bf16x8*)(lds + PG8_SB(b, h) + boff + n * 2048 + k * 1024); } while (0)
#define PG8_MMA(ai, bj, At, Bt) do { __builtin_amdgcn_s_setprio(1); _Pragma("unroll") for (int m = 0; m < 4; ++m) _Pragma("unroll") for (int n = 0; n < 2; ++n) _Pragma("unroll") for (int k = 0; k < 2; ++k) \
        acc[ai][bj][m][n] = __builtin_amdgcn_mfma_f32_16x16x32_bf16(Bt[n][k], At[m][k], acc[ai][bj][m][n], 0, 0, 0); __builtin_amdgcn_s_setprio(0); } while (0)
#define PG8_WAIT_V(n) asm volatile("s_waitcnt vmcnt(" #n ")" ::: "memory")
#define PG8_WAIT_L(n) asm volatile("s_waitcnt lgkmcnt(" #n ")" ::: "memory")
#define PG8_BAR __builtin_amdgcn_s_barrier()
#define PG8_SCHED __builtin_amdgcn_sched_barrier(0)
    Unit cur, nxt; int ui = 0;
    if (!S.next(0, cur)) return;
    f32x4 acc[2][2][4][2];
#pragma unroll
    for (int a = 0; a < 2; ++a)
#pragma unroll
        for (int b = 0; b < 2; ++b)
#pragma unroll
            for (int m = 0; m < 4; ++m)
#pragma unroll
                for (int n = 0; n < 2; ++n) acc[a][b][m][n] = (f32x4){0.f, 0.f, 0.f, 0.f};
    bf16x8 At[4][2], B0[2][2], B1[2][2];
    const char* cA = (const char*)g.A + (size_t)cur.pm * tstep; const char* cB = (const char*)g.Bt + (size_t)cur.pn * tstep;
    S.a_ready(cur);
    if constexpr (SP2) {
        PG8_STAGE(PG8_SB(0, 0), cB, voffB); PG8_STAGE(PG8_SB(0, 1), cB + hstep, voffB); PG8_STAGE(PG8_SA(0, 0), cA, voffA); PG8_STAGE(PG8_SA(0, 1), cA + hstep, voffA);
        if (wr == 1) PG8_BAR;
        PG8_WAIT_V(2); PG8_BAR;
        PG8_STAGE(PG8_SB(1, 0), cB + kstep, voffB); PG8_STAGE(PG8_SA(1, 0), cA + kstep, voffA); PG8_STAGE(PG8_SB(1, 1), cB + hstep + kstep, voffB);
        PG8_WAIT_V(6); PG8_BAR;
    } else {
        PG8_STAGE(PG8_SB(0, 0), cB, voffB); PG8_STAGE(PG8_SA(0, 0), cA, voffA); PG8_STAGE(PG8_SB(0, 1), cB + hstep, voffB); PG8_STAGE(PG8_SA(0, 1), cA + hstep, voffA);
        if (wr == 1) PG8_BAR;
        PG8_WAIT_V(4); PG8_BAR;
        PG8_STAGE(PG8_SB(1, 0), cB + kstep, voffB); PG8_STAGE(PG8_SA(1, 0), cA + kstep, voffA); PG8_STAGE(PG8_SB(1, 1), cB + hstep + kstep, voffB);
        PG8_WAIT_V(6); PG8_BAR;
    }
    for (;;) {
        const bool has_next = S.next(ui + 1, nxt);
        const char* nA = has_next ? (const char*)g.A + (size_t)nxt.pm * tstep : cA; const char* nB = has_next ? (const char*)g.Bt + (size_t)nxt.pn * tstep : cB;
        for (int t = 0; t < nt; t += 2) {
            const bool last = (t == nt - 2);
            const char* a1 = cA + (size_t)(t + 1) * kstep;
            const char* a2 = last ? nA : cA + (size_t)(t + 2) * kstep; const char* b2 = last ? nB : cB + (size_t)(t + 2) * kstep;
            const char* a3 = a2 + kstep; const char* b3 = b2 + kstep;
            if (last && has_next) S.a_ready(nxt);
            if constexpr (Epi::HAS_MID) { if (t == nt / 2) E.mid(acc, cur, wr, wc, fr, fq); }
            if constexpr (SP2) {
            PG8_LDB(B0, 0, 0); PG8_LDB(B1, 0, 1); PG8_SCHED; PG8_LDA(At, 0, 0); PG8_STAGE(PG8_SA(1, 1), a1 + hstep, voffA);
            PG8_WAIT_V(8); PG8_WAIT_L(0); PG8_BAR; PG8_MMA(0, 0, At, B0); PG8_MMA(0, 1, At, B1); PG8_BAR; PG8_SCHED;
            PG8_LDA(At, 0, 1); PG8_STAGE(PG8_SB(0, 0), b2, voffB); PG8_STAGE(PG8_SB(0, 1), b2 + hstep, voffB); PG8_STAGE(PG8_SA(0, 0), a2, voffA);
            PG8_WAIT_V(8); PG8_WAIT_L(0); PG8_BAR; PG8_MMA(1, 0, At, B0); PG8_MMA(1, 1, At, B1); PG8_BAR; PG8_SCHED;
            PG8_LDB(B0, 1, 0); PG8_LDB(B1, 1, 1); PG8_SCHED; PG8_LDA(At, 1, 0); PG8_STAGE(PG8_SA(0, 1), a2 + hstep, voffA);
            PG8_WAIT_V(8); PG8_WAIT_L(0); PG8_BAR; PG8_MMA(0, 0, At, B0); PG8_MMA(0, 1, At, B1); PG8_BAR; PG8_SCHED;
            PG8_LDA(At, 1, 1); PG8_STAGE(PG8_SB(1, 0), b3, voffB); PG8_STAGE(PG8_SB(1, 1), b3 + hstep, voffB); PG8_STAGE(PG8_SA(1, 0), a3, voffA);
            PG8_WAIT_V(8); PG8_WAIT_L(0); PG8_BAR; PG8_MMA(1, 0, At, B0); PG8_MMA(1, 1, At, B1); PG8_BAR; PG8_SCHED;
            } else {
            PG8_LDB(B0, 0, 0); PG8_SCHED; PG8_LDA(At, 0, 0); PG8_STAGE(PG8_SA(1, 1), a1 + hstep, voffA);
            PG8_WAIT_L(8); PG8_BAR; PG8_WAIT_L(0); PG8_MMA(0, 0, At, B0); PG8_BAR; PG8_SCHED;
            PG8_LDB(B1, 0, 1); PG8_STAGE(PG8_SB(0, 0), b2, voffB);
            PG8_BAR; PG8_WAIT_L(0); PG8_MMA(0, 1, At, B1); PG8_BAR;
            PG8_LDA(At, 0, 1); PG8_STAGE(PG8_SA(0, 0), a2, voffA);
            PG8_BAR; PG8_WAIT_L(0); PG8_MMA(1, 0, At, B0); PG8_BAR; PG8_SCHED;
            PG8_STAGE(PG8_SB(0, 1), b2 + hstep, voffB);
            PG8_WAIT_V(6); PG8_BAR; PG8_MMA(1, 1, At, B1); PG8_BAR;
            PG8_LDB(B0, 1, 0); PG8_SCHED; PG8_LDA(At, 1, 0); PG8_STAGE(PG8_SA(0, 1), a2 + hstep, voffA);
            PG8_WAIT_L(8); PG8_BAR; PG8_WAIT_L(0); PG8_MMA(0, 0, At, B0); PG8_BAR; PG8_SCHED;
            PG8_LDB(B1, 1, 1); PG8_STAGE(PG8_SB(1, 0), b3, voffB);
            PG8_BAR; PG8_WAIT_L(0); PG8_MMA(0, 1, At, B1); PG8_BAR;
            PG8_LDA(At, 1, 1); PG8_STAGE(PG8_SA(1, 0), a3, voffA);
            PG8_BAR; PG8_WAIT_L(0); PG8_MMA(1, 0, At, B0); PG8_BAR; PG8_SCHED;
            PG8_STAGE(PG8_SB(1, 1), b3 + hstep, voffB);
            PG8_WAIT_V(6); PG8_BAR; PG8_MMA(1, 1, At, B1); PG8_BAR;
            }
        }
        if constexpr (ALIGN_EPI) { if (wr == 0) PG8_BAR; }
        if constexpr (!Epi::AFTER_DRAIN) { E(acc, cur, wr, wc, fr, fq); S.done(cur); }
        if (!has_next) break;
#pragma unroll
        for (int a = 0; a < 2; ++a)
#pragma unroll
            for (int b = 0; b < 2; ++b)
#pragma unroll
                for (int m = 0; m < 4; ++m)
#pragma unroll
                    for (int n = 0; n < 2; ++n) acc[a][b][m][n] = (f32x4){0.f, 0.f, 0.f, 0.f};
        cur = nxt; cA = nA; cB = nB; ++ui;
        if constexpr (ALIGN_EPI) { if (wr == 1) PG8_BAR; }
    }
    PG8_WAIT_V(0);
    if constexpr (!ALIGN_EPI) { if (wr == 0) PG8_BAR; }
    PG8_BAR;
    if constexpr (Epi::AFTER_DRAIN) { E.fused(acc, cur, wr, wc, fr, fq, lds, wid, lane); S.done(cur); }
#undef PG8_SA
#undef PG8_SB
#undef PG8_STAGE
#undef PG8_LDA
#undef PG8_LDB
#undef PG8_MMA
#undef PG8_WAIT_V
#undef PG8_WAIT_L
#undef PG8_BAR
#undef PG8_SCHED
}
}

#define DEV __device__ __forceinline__
#define LAS __attribute__((address_space(3)))
typedef unsigned short bf16;
typedef float f32x4 __attribute__((ext_vector_type(4)));
typedef unsigned u32x4 __attribute__((ext_vector_type(4)));
typedef unsigned u32x2 __attribute__((ext_vector_type(2)));

constexpr int D = 1024, NTOK = 10240, NCTX = 8192, DEPTH = 4, NH = 16, HP = 64, NGRP = 4, NST = 128, DIN = 8224;
constexpr int NPROJ = 8192;
constexpr int NCHUNK = 80;
constexpr float EPS = 1e-6f;
constexpr int PC_XBC = 0, PC_ZM = 2048, PC_U = 3072, PC_V = 4096, PC_ZG = 5120, PC_GLM = 6144, PC_GLG = 7168;

constexpr size_t MiB = 1u << 20;
constexpr size_t WS_CTL = 0, CTL_BYTES = 2 * MiB;
constexpr size_t CTL_SSQ = 64 * 1024;
constexpr size_t CTL_SSQX = 256 * 1024;
constexpr size_t CTL_GSUM = 512 * 1024;
constexpr size_t CTL_SW = 1 * MiB;
constexpr size_t WS_MOD = 2 * MiB;
constexpr size_t WS_GN = WS_MOD + 256 * 1024;
constexpr size_t WS_WDT = WS_GN + 192 * 1024;
constexpr size_t WS_WSPB = 3 * MiB;
constexpr size_t WS_DTRAW = 4 * MiB;
constexpr size_t WS_WIN = 6 * MiB;
constexpr size_t WS_WMG = WS_WIN + 64 * MiB;
constexpr size_t WS_WO = WS_WMG + 16 * MiB;
constexpr size_t WS_HBUF = WS_WO + 8 * MiB;
constexpr size_t WS_AMG = WS_HBUF + 20 * MiB;
constexpr size_t WS_PROJ = WS_AMG + 40 * MiB;
constexpr size_t WS_XBUF = WS_PROJ + 160 * MiB;
constexpr size_t WS_MRG = WS_XBUF + 40 * MiB;
constexpr size_t WS_XBCS = WS_MRG + 20 * MiB;
constexpr size_t WS_SINB = WS_XBCS + 40 * MiB;
constexpr size_t WS_TB = WS_SINB + 40 * MiB;
constexpr int TBW = 1536;
constexpr size_t WS_END = WS_TB + 8 * MiB;

#ifndef DUP_MASK
#define DUP_MASK 0
#endif
constexpr size_t CTL_DUMMY = 1536 * 1024;
constexpr int LDS_BYTES = 155648;

DEV float bf2f(unsigned v) { return __uint_as_float(v << 16); }
DEV unsigned f2bf(float f) { unsigned u = __float_as_uint(f); return (u + 0x7fffu + ((u >> 16) & 1u)) >> 16; }
DEV unsigned pk2(float lo, float hi) { return f2bf(lo) | (f2bf(hi) << 16); }
DEV float sigmoid_f(float x) { return __builtin_amdgcn_rcpf(1.f + __expf(-x)); }
DEV float silu_f(float x) { return x * __builtin_amdgcn_rcpf(1.f + __expf(-x)); }
DEV float gelu_f(float x) { return x * sigmoid_f(1.5957691216f * (x + 0.044715f * x * x * x)); }
DEV float softplus_f(float x) { const float e = __expf(x); const float sm = e * (1.f - e * (0.5f - e * 0.33333333f)); return x > 20.f ? x : (e < 0.03f ? sm : __logf(1.f + e)); }
DEV float shfl_idx(float v, int src_lane) { return __int_as_float(__builtin_amdgcn_ds_bpermute(src_lane << 2, __float_as_int(v))); }
DEV float shfl_x(float v, int o, int lane) { return shfl_idx(v, lane ^ o); }
DEV float wave_sum(float v, int lane) {
#pragma unroll
    for (int o = 1; o < 64; o <<= 1) v += shfl_x(v, o, lane);
    return v;
}

struct Args { const float* in[23]; float* out; unsigned char* ws; int step_lo, step_hi; };

struct Frame {
    LAS unsigned char* lds;
    int tid, lane, wave, G, bid, z;
    const float* const* in;
    float* out; unsigned char* ws;
};
DEV Frame launder(const Frame& F0) {
    Frame F = F0;
    F.z = 0; asm volatile("" : "+s"(F.z), "+s"(F.out), "+s"(F.ws), "+s"(F.G), "+s"(F.bid), "+s"(F.wave));
    F.tid = F.wave * 64 + (int)__builtin_amdgcn_mbcnt_hi(~0u, __builtin_amdgcn_mbcnt_lo(~0u, 0u));
    asm volatile("" : "+v"(F.tid));
    F.lane = F.tid & 63;
    return F;
}
#define IN_XP 0
#define IN_XS 1
#define IN_STATE 2
#define IN_C 3
#define IN_CCTX 4
#define IN_WADA 5
#define IN_BADA 6
#define IN_NORMW 7
#define IN_WIN 8
#define IN_CONVW 9
#define IN_CONVB 10
#define IN_DTBIAS 11
#define IN_ALOG 12
#define IN_DSKIP 13
#define IN_SSMNW 14
#define IN_WOUTM 15
#define IN_LNW 16
#define IN_LNB 17
#define IN_WSP 18
#define IN_BSP 19
#define IN_WOUTG 20
#define IN_WOUT 21
#define IN_FNW 22

DEV int scan_to_row(int sr, int layer) {
    if (sr < NCTX || !(layer & 1)) return sr;
    const int lb = (sr - NCTX) >> 10, q = (sr - NCTX) & 1023;
    return NCTX + lb * 1024 + (q & 15) * 64 + (q >> 4);
}

DEV void ph_mod(const Frame& F0) {
    Frame F = launder(F0);
    LAS float* sc = (LAS float*)F.lds;
    LAS float* part = sc + 3 * 1024;
    for (int i = F.tid; i < 3 * 1024; i += 512) { const int v = i >> 10, k = i & 1023; const float c = v == 0 ? F.in[IN_CCTX + F.z][k] : F.in[IN_C + F.z][(v - 1) * 1024 + k]; sc[i] = silu_f(c); }
    __syncthreads();
    float* mod = (float*)(F.ws + WS_MOD);
    for (int it = F.bid; it < DEPTH * 48; it += F.G) {
        const int l = it / 48, jl = F.tid & 63, j = (it % 48) * 64 + jl, kq = F.tid >> 6;
        const float* w = F.in[IN_WADA + F.z] + (size_t)l * 1024 * 3072 + (size_t)(kq * 128) * 3072 + j;
        float a0 = 0.f, a1 = 0.f, a2 = 0.f;
#pragma unroll 16
        for (int k = 0; k < 128; ++k) { const float wv = w[(size_t)k * 3072]; a0 += sc[kq * 128 + k] * wv; a1 += sc[1024 + kq * 128 + k] * wv; a2 += sc[2048 + kq * 128 + k] * wv; }
        __syncthreads();
        part[(kq * 3 + 0) * 64 + jl] = a0; part[(kq * 3 + 1) * 64 + jl] = a1; part[(kq * 3 + 2) * 64 + jl] = a2;
        __syncthreads();
        if (F.tid < 192) { const int v = F.tid >> 6, jj = F.tid & 63, col = (it % 48) * 64 + jj; float t = F.in[IN_BADA + F.z][l * 3072 + col];
#pragma unroll
            for (int q = 0; q < 8; ++q) t += part[(q * 3 + v) * 64 + jj];
            mod[(l * 3 + v) * 3072 + col] = t; }
    }
}

DEV void cvt_item(const float* W, int ldw, int k0, int n0, bf16* WT, int ldt, int k0d, int drow0, LAS float* scr, int lane, const float* shift3, float* sw3) {
    float wv_[32];
#pragma unroll
    for (int i = 0; i < 32; ++i) wv_[i] = W[(size_t)(k0 + 2 * i + (lane >> 5)) * ldw + n0 + (lane & 31)];
#pragma unroll
    for (int i = 0; i < 32; ++i) scr[(2 * i + (lane >> 5)) * 33 + (lane & 31)] = wv_[i];
    asm volatile("s_waitcnt lgkmcnt(0)" ::: "memory");
    const int c = lane & 7;
#pragma unroll
    for (int j = 0; j < 4; ++j) { const int n = (lane >> 3) + 8 * j; const LAS float* s = scr + (8 * c) * 33 + n;
        u32x4 o; o.x = pk2(s[0 * 33], s[1 * 33]); o.y = pk2(s[2 * 33], s[3 * 33]); o.z = pk2(s[4 * 33], s[5 * 33]); o.w = pk2(s[6 * 33], s[7 * 33]);
        *(u32x4*)(WT + (size_t)(drow0 + n) * ldt + k0d + 8 * c) = o; }
    if (shift3) {
        const int n = lane & 31, kh = (lane >> 5) * 32;
        float a0 = 0.f, a1 = 0.f, a2 = 0.f;
#pragma unroll 8
        for (int kk = 0; kk < 32; ++kk) { const float wv = scr[(kh + kk) * 33 + n]; a0 += shift3[k0 + kh + kk] * wv; a1 += shift3[3072 + k0 + kh + kk] * wv; a2 += shift3[6144 + k0 + kh + kk] * wv; }
        a0 += shfl_x(a0, 32, lane); a1 += shfl_x(a1, 32, lane); a2 += shfl_x(a2, 32, lane);
        if (lane < 32) { atomicAdd(sw3 + n0 + n, a0); atomicAdd(sw3 + DIN + n0 + n, a1); atomicAdd(sw3 + 2 * DIN + n0 + n, a2); }
    }
    asm volatile("s_waitcnt lgkmcnt(0)" ::: "memory");
}
DEV void ph_cvt(const Frame& F0, int l, int wg0, int nwg) {
    Frame F = launder(F0);
    asm volatile("" : "+s"(l));
    if (F.bid < wg0) return;
    LAS float* scr = (LAS float*)(F.lds + F.wave * 16384);
    const int gw = (F.bid - wg0) * 8 + F.wave, NGW = nwg * 8;
    constexpr int I_IN = 16 * 257, I_O = 16 * 32, PER_L = I_IN + 3 * I_O;
    for (int it = gw; it < PER_L; it += NGW) {
        int r = it;
        if (r < I_IN) { const int kb = r / 257, nb = r % 257;
            const float* shift3 = (const float*)(F.ws + WS_MOD) + (size_t)l * 3 * 3072;
            float* sw3 = (float*)(F.ws + WS_CTL + CTL_SW) + (size_t)l * 3 * DIN;
            if (nb == 96) cvt_item(F.in[IN_WIN + F.z] + (size_t)l * 1024 * DIN, DIN, 64 * kb, 3072, (bf16*)(F.ws + WS_WDT) + (size_t)l * 32 * 1024, 1024, 64 * kb, 0, scr, F.lane, shift3, sw3);
            else { const int c = 32 * nb;
                int drow;
                if (c < 3072) drow = c;
                else if (c < 4128) { const int cc = c - 3104; drow = (12 + (cc >> 7)) * 256 + (cc & 127); }
                else if (c < 5152) drow = 5120 + (c - 4128);
                else if (c < 6176) { const int cc = c - 5152; drow = (12 + (cc >> 7)) * 256 + 128 + (cc & 127); }
                else if (c < 7200) { const int cc = c - 6176; drow = (24 + (cc >> 7)) * 256 + (cc & 127); }
                else { const int cc = c - 7200; drow = (24 + (cc >> 7)) * 256 + 128 + (cc & 127); }
                cvt_item(F.in[IN_WIN + F.z] + (size_t)l * 1024 * DIN, DIN, 64 * kb, c, (bf16*)(F.ws + WS_WIN) + (size_t)l * NPROJ * 1024, 1024, 64 * kb, drow, scr, F.lane, shift3, sw3); }
            continue; }
        r -= I_IN;
        const int which = r / I_O; r %= I_O; const int kb = r >> 5, nb = r & 31;
        const float* W = (which == 0 ? F.in[IN_WOUTM + F.z] : which == 1 ? F.in[IN_WOUTG + F.z] : F.in[IN_WOUT + F.z]) + (size_t)l * 1024 * 1024;
        if (which < 2) cvt_item(W, 1024, 64 * kb, 32 * nb, (bf16*)(F.ws + WS_WMG) + (size_t)l * 1024 * 2048, 2048, which * 1024 + 64 * kb, 32 * nb, scr, F.lane, nullptr, nullptr);
        else cvt_item(W, 1024, 64 * kb, 32 * nb, (bf16*)(F.ws + WS_WO) + (size_t)l * 1024 * 1024, 1024, 64 * kb, 32 * nb, scr, F.lane, nullptr, nullptr);
    }
}
DEV void ph_gn(const Frame& F0) {
    Frame F = launder(F0);
    float* gn = (float*)(F.ws + WS_GN);
    for (int i = F.bid * 512 + F.tid; i < DEPTH * 3 * 1024; i += F.G * 512) { const int c = i & 1023, lv = i >> 10, l = lv / 3;
        gn[i] = F.in[IN_NORMW + F.z][l * 1024 + c] * (1.f + ((const float*)(F.ws + WS_MOD))[lv * 3072 + 1024 + c]); }
    const f32x4* wsp = (const f32x4*)F.in[IN_WSP + F.z]; u32x2* wb = (u32x2*)(F.ws + WS_WSPB);
    for (int i = F.bid * 512 + F.tid; i < DEPTH * 8 * 128 * 128 / 4; i += F.G * 512) { const f32x4 w = wsp[i]; u32x2 o; o.x = pk2(w.x, w.y); o.y = pk2(w.z, w.w); wb[i] = o; }
}

DEV void ph_prep0(const Frame& F0) {
    Frame F = launder(F0);
    const int gw = F.bid * 8 + F.wave, NGW = F.G * 8;
    const float* nw = F.in[IN_NORMW + F.z];
    float* ssqx = (float*)(F.ws + WS_CTL + CTL_SSQX);
    for (int row = gw; row < NTOK; row += NGW) {
        const int mv = row < NCTX ? 0 : 1 + ((row - NCTX) >> 10);
        const float* md = (const float*)(F.ws + WS_MOD) + mv * 3072;
        const f32x4* xr = (const f32x4*)(row < NCTX ? F.in[IN_XP + F.z] + (size_t)row * D : F.in[IN_XS + F.z] + (size_t)(row - NCTX) * D) + F.lane;
        f32x4 v[4]; float s = 0.f;
#pragma unroll
        for (int j = 0; j < 4; ++j) { v[j] = xr[64 * j]; s += (v[j].x * v[j].x + v[j].y * v[j].y) + (v[j].z * v[j].z + v[j].w * v[j].w); }
        s = wave_sum(s, F.lane);
        if (F.lane == 0) ssqx[row] = s;
        unsigned long long* o8 = (unsigned long long*)((bf16*)(F.ws + WS_HBUF) + (size_t)row * D) + F.lane;
#pragma unroll
        for (int j = 0; j < 4; ++j) { const int c0 = 4 * (F.lane + 64 * j);
            const f32x4 w4 = *(const f32x4*)(nw + c0), sc = *(const f32x4*)(md + 1024 + c0);
            v[j] = v[j] * w4 * (sc + 1.f);
            o8[64 * j] = (unsigned long long)pk2(v[j].x, v[j].y) | ((unsigned long long)pk2(v[j].z, v[j].w) << 32); }
    }
}

DEV void ph_final(const Frame& F0) {
    Frame F = launder(F0);
    const int gw = F.bid * 8 + F.wave, NGW = F.G * 8;
    const float* nw = F.in[IN_FNW + F.z];
    const float* ssqx = (const float*)(F.ws + WS_CTL + CTL_SSQX) + 4 * NTOK;
    for (int row = gw; row < NTOK; row += NGW) {
        const f32x4* xr = (const f32x4*)((const float*)(F.ws + WS_XBUF) + (size_t)row * D) + F.lane;
        const float rstd = rsqrtf(ssqx[row] * (1.f / D) + EPS);
        f32x4* o = (f32x4*)(F.out + (size_t)row * D) + F.lane;
#pragma unroll
        for (int j = 0; j < 4; ++j) o[64 * j] = xr[64 * j] * rstd * *(const f32x4*)(nw + 4 * (F.lane + 64 * j));
    }
}

typedef short bf16x8 __attribute__((ext_vector_type(8)));
typedef short s16x4 __attribute__((ext_vector_type(4)));
typedef float f32x16 __attribute__((ext_vector_type(16)));
typedef float f32x2 __attribute__((ext_vector_type(2)));
typedef __bf16 bf16x2_t __attribute__((ext_vector_type(2)));
#define MFMA32(a, b, c) __builtin_amdgcn_mfma_f32_32x32x16_bf16((a), (b), (c), 0, 0, 0)
DEV unsigned pkbf(float a, float b) { const f32x2 v = {a, b}; return __builtin_bit_cast(unsigned, __builtin_convertvector(v, bf16x2_t)); }
DEV bf16x8 pack8(float a0, float a1, float a2, float a3, float a4, float a5, float a6, float a7) {
    u32x4 p; p.x = pkbf(a0, a1); p.y = pkbf(a2, a3); p.z = pkbf(a4, a5); p.w = pkbf(a6, a7); return __builtin_bit_cast(bf16x8, p); }
DEV int crow(int r, int hh) { return (r & 3) + 8 * (r >> 2) + 4 * hh; }

struct ChunkGeo { int seq_row0, pos0, L; bool cm; };
DEV ChunkGeo chunk_geo(int ck, int layer) {
    ChunkGeo g;
    if (ck < 64) { g.seq_row0 = (ck >> 1) * 256; g.pos0 = (ck & 1) * 128; g.L = 256; g.cm = false; }
    else { const int lb = (ck - 64) >> 3; g.seq_row0 = NCTX + lb * 1024; g.pos0 = ((ck - 64) & 7) * 128; g.L = 1024; g.cm = (layer & 1) != 0; }
    return g;
}
DEV int geo_row(const ChunkGeo& g, int Q) { return g.seq_row0 + (g.cm ? (Q & 15) * 64 + (Q >> 4) : Q); }

DEV void chunk_tables2(Frame& F, int layer, const ChunkGeo& geo, int h, LAS float* tb) {
    if (F.wave < 2) {
        const int dir = F.wave;
        const float a = -__expf(F.in[IN_ALOG + F.z][layer * 32 + dir * 16 + h]);
        const float bias = F.in[IN_DTBIAS + F.z][layer * 32 + dir * 16 + h];
        const float* dtr = (const float*)(F.ws + WS_DTRAW);
        const int q0 = 2 * F.lane;
        const float d0 = softplus_f(dtr[(size_t)geo_row(geo, geo.pos0 + q0) * 32 + dir * 16 + h] + bias);
        const float d1 = softplus_f(dtr[(size_t)geo_row(geo, geo.pos0 + q0 + 1) * 32 + dir * 16 + h] + bias);
        const float a0 = d0 * a, a1 = d1 * a;
        float sc = a0 + a1, c0, c1, tot;
        if (dir == 0) {
#pragma unroll
            for (int o = 1; o < 64; o <<= 1) { const float t = shfl_idx(sc, (F.lane - o) & 63); if (F.lane >= o) sc += t; }
            c1 = sc; c0 = sc - a1; tot = shfl_idx(c1, 63);
        } else {
#pragma unroll
            for (int o = 1; o < 64; o <<= 1) { const float t = shfl_idx(sc, (F.lane + o) & 63); if (F.lane + o < 64) sc += t; }
            c0 = sc; c1 = sc - a0; tot = shfl_idx(c0, 0);
        }
        LAS float* t = tb + dir * 128 + q0;
        t[0] = c0; t[1] = c1; t[256] = d0; t[257] = d1; t[512] = __expf(c0); t[513] = __expf(c1);
        t[768] = d0 * __expf(tot - c0); t[769] = d1 * __expf(tot - c1);
    }
    __syncthreads();
}

template <int NC, int MODE>
DEV void stage_conv(Frame& F, int layer, const ChunkGeo& geo, int col0, LAS unsigned char* img0, LAS unsigned char* img1, int pitch, const LAS float* tb, bf16* gdst = nullptr) {
    constexpr int CG = NC / 8, NT = CG * 32;
    if (F.tid < NT) {
        const int cg = F.tid % CG, tg = F.tid / CG, ch0 = col0 + cg * 8, q0 = tg * 4;
        const bf16* proj = (const bf16*)(F.ws + WS_PROJ);
        float x[8][8];
#pragma unroll
        for (int i = 0; i < 8; ++i) {
            const int Q = geo.pos0 + q0 - 2 + i;
            u32x4 raw = {0u, 0u, 0u, 0u};
            if (Q >= 0 && Q < geo.L) raw = *(const u32x4*)(proj + (size_t)geo_row(geo, Q) * NPROJ + PC_XBC + ch0);
            x[i][0] = bf2f(raw.x & 0xffffu); x[i][1] = bf2f(raw.x >> 16); x[i][2] = bf2f(raw.y & 0xffffu); x[i][3] = bf2f(raw.y >> 16);
            x[i][4] = bf2f(raw.z & 0xffffu); x[i][5] = bf2f(raw.z >> 16); x[i][6] = bf2f(raw.w & 0xffffu); x[i][7] = bf2f(raw.w >> 16);
        }
        const float* cw = F.in[IN_CONVW + F.z] + layer * 5 * 2048 + ch0; const float* cb = F.in[IN_CONVB + F.z] + layer * 2048 + ch0;
        float acc[4][8];
        { const f32x4 b0 = *(const f32x4*)cb, b1 = *(const f32x4*)(cb + 4);
#pragma unroll
          for (int t = 0; t < 4; ++t) { acc[t][0] = b0.x; acc[t][1] = b0.y; acc[t][2] = b0.z; acc[t][3] = b0.w; acc[t][4] = b1.x; acc[t][5] = b1.y; acc[t][6] = b1.z; acc[t][7] = b1.w; } }
#pragma unroll
        for (int k = 0; k < 5; ++k) {
            const f32x4 w0 = *(const f32x4*)(cw + k * 2048), w1 = *(const f32x4*)(cw + k * 2048 + 4);
            const float w[8] = {w0.x, w0.y, w0.z, w0.w, w1.x, w1.y, w1.z, w1.w};
#pragma unroll
            for (int t = 0; t < 4; ++t)
#pragma unroll
                for (int c = 0; c < 8; ++c) acc[t][c] += w[c] * x[t + k][c];
        }
#pragma unroll
        for (int t = 0; t < 4; ++t) {
            float v[8];
#pragma unroll
            for (int c = 0; c < 8; ++c) v[c] = silu_f(acc[t][c]);
            const int s = q0 + t;
            if (MODE == 0) {
                u32x4 o; o.x = pkbf(v[0], v[1]); o.y = pkbf(v[2], v[3]); o.z = pkbf(v[4], v[5]); o.w = pkbf(v[6], v[7]);
                *(LAS u32x4*)(img0 + s * pitch + cg * 16) = o;
            } else if (MODE == 2) {
                u32x4 o; o.x = pkbf(v[0], v[1]); o.y = pkbf(v[2], v[3]); o.z = pkbf(v[4], v[5]); o.w = pkbf(v[6], v[7]);
                *(u32x4*)(gdst + (size_t)s * 2048 + cg * 8) = o;
            } else {
                const float sf = tb[768 + s], sb = tb[896 + s];
                u32x4 o; o.x = pkbf(v[0] * sf, v[1] * sf); o.y = pkbf(v[2] * sf, v[3] * sf); o.z = pkbf(v[4] * sf, v[5] * sf); o.w = pkbf(v[6] * sf, v[7] * sf);
                *(LAS u32x4*)(img0 + s * pitch + cg * 16) = o;
                o.x = pkbf(v[0] * sb, v[1] * sb); o.y = pkbf(v[2] * sb, v[3] * sb); o.z = pkbf(v[4] * sb, v[5] * sb); o.w = pkbf(v[6] * sb, v[7] * sb);
                *(LAS u32x4*)(img1 + s * pitch + cg * 16) = o;
            }
        }
    }
}

DEV bf16x8 tr2(const LAS unsigned char* img, int pitch, int row0, int row1, int col0, int lane) {
    const int i = lane & 15, blk = (lane >> 4) & 1;
    const int off = (i >> 2) * pitch + (col0 + 16 * blk + 4 * (i & 3)) * 2;
    const s16x4 lo = __builtin_amdgcn_ds_read_tr16_b64_v4i16((LAS s16x4*)(img + row0 * pitch + off));
    const s16x4 hi = __builtin_amdgcn_ds_read_tr16_b64_v4i16((LAS s16x4*)(img + row1 * pitch + off));
    return __builtin_shufflevector(lo, hi, 0, 1, 2, 3, 4, 5, 6, 7);
}

DEV void conv_unit(Frame& F, int layer, int ck, int j16) {
    const ChunkGeo geo = chunk_geo(ck, layer);
    if (F.wave < 2) {
        const int dir = F.wave & 1, h = j16;
        const float a = -__expf(F.in[IN_ALOG + F.z][layer * 32 + dir * 16 + h]);
        const float bias = F.in[IN_DTBIAS + F.z][layer * 32 + dir * 16 + h];
        const float* dtr = (const float*)(F.ws + WS_DTRAW);
        const int q0 = 2 * F.lane;
        const float d0 = softplus_f(dtr[(size_t)geo_row(geo, geo.pos0 + q0) * 32 + dir * 16 + h] + bias);
        const float d1 = softplus_f(dtr[(size_t)geo_row(geo, geo.pos0 + q0 + 1) * 32 + dir * 16 + h] + bias);
        const float a0 = d0 * a, a1 = d1 * a;
        float sc = a0 + a1, c0, c1, tot;
        if (dir == 0) {
#pragma unroll
            for (int o = 1; o < 64; o <<= 1) { const float t = shfl_idx(sc, (F.lane - o) & 63); if (F.lane >= o) sc += t; }
            c1 = sc; c0 = sc - a1; tot = shfl_idx(c1, 63);
        } else {
#pragma unroll
            for (int o = 1; o < 64; o <<= 1) { const float t = shfl_idx(sc, (F.lane + o) & 63); if (F.lane + o < 64) sc += t; }
            c0 = sc; c1 = sc - a0; tot = shfl_idx(c0, 0);
        }
        float* tbase = (float*)(F.ws + WS_TB) + (size_t)(ck * 16 + h) * TBW;
        *(f32x2*)(tbase + q0 * 4 + dir * 2) = (f32x2){c0, d0}; *(f32x2*)(tbase + (q0 + 1) * 4 + dir * 2) = (f32x2){c1, d1};
        float* t = tbase + dir * 128 + q0;
        *(f32x2*)(t + 512) = (f32x2){__expf(c0), __expf(c1)};
        *(f32x2*)(t + 768) = (f32x2){d0 * __expf(tot - c0), d1 * __expf(tot - c1)};
        const float cbs = shfl_idx(c0, F.lane & ~15), cbe = shfl_idx(c1, F.lane | 15);
        if (dir == 0) { *(f32x2*)(t + 1024) = (f32x2){d0 * __expf(cbe - c0), d1 * __expf(cbe - c1)}; *(f32x2*)(t + 1280) = (f32x2){__expf(c0 - cbs), __expf(c1 - cbs)}; }
        else          { *(f32x2*)(t + 1024) = (f32x2){d0 * __expf(cbs - c0), d1 * __expf(cbs - c1)}; *(f32x2*)(t + 1280) = (f32x2){__expf(c0 - cbe), __expf(c1 - cbe)}; }
    }
    bf16* dst = (bf16*)(F.ws + WS_XBCS) + (size_t)ck * 128 * 2048;
    stage_conv<128, 2>(F, layer, geo, j16 * 128, nullptr, nullptr, 0, nullptr, dst + j16 * 128);
}
DEV void ph_b0(const Frame& F0, int layer) {
    Frame F = launder(F0);
    asm volatile("" : "+s"(layer));
    for (int it = F.bid; it < NCHUNK * 16; it += F.G) { Frame Fi = launder(F); conv_unit(Fi, layer, it >> 4, it & 15); }
}

struct S1Regs { u32x4 bq[4], xq[2]; float wf[2], wb[2], atF, atB; };
DEV void s1_load(Frame& F, int ck, int h, S1Regs& R) {
    const bf16* xc = (const bf16*)(F.ws + WS_XBCS) + (size_t)ck * 128 * 2048;
    const float* T = (const float*)(F.ws + WS_TB) + (size_t)(ck * 16 + h) * TBW;
    { const int ch = F.tid & 15, r0 = F.tid >> 4;
#pragma unroll
      for (int p = 0; p < 4; ++p) R.bq[p] = *(const u32x4*)(xc + (size_t)(r0 + 32 * p) * 2048 + 1024 + (h >> 2) * 128 + ch * 8); }
    { const int ch = F.tid & 7, r0 = F.tid >> 3;
#pragma unroll
      for (int p = 0; p < 2; ++p) { const int row = r0 + 64 * p; R.xq[p] = *(const u32x4*)(xc + (size_t)row * 2048 + h * 64 + ch * 8); R.wf[p] = T[768 + row]; R.wb[p] = T[896 + row]; } }
    R.atF = T[127 * 4]; R.atB = T[2];
}
DEV void s1_store(Frame& F, const S1Regs& R, LAS unsigned char* Bi, LAS unsigned char* XF, LAS unsigned char* XB) {
    { const int ch = F.tid & 15, r0 = F.tid >> 4;
#pragma unroll
      for (int p = 0; p < 4; ++p) *(LAS u32x4*)(Bi + (r0 + 32 * p) * 320 + ch * 16) = R.bq[p]; }
    { const int ch = F.tid & 7, r0 = F.tid >> 3;
#pragma unroll
      for (int p = 0; p < 2; ++p) { const int row = r0 + 64 * p; const u32x4 r = R.xq[p]; const float wf = R.wf[p], wb = R.wb[p];
          const float v[8] = {bf2f(r.x & 0xffffu), bf2f(r.x >> 16), bf2f(r.y & 0xffffu), bf2f(r.y >> 16), bf2f(r.z & 0xffffu), bf2f(r.z >> 16), bf2f(r.w & 0xffffu), bf2f(r.w >> 16)};
          u32x4 o; o.x = pkbf(v[0] * wf, v[1] * wf); o.y = pkbf(v[2] * wf, v[3] * wf); o.z = pkbf(v[4] * wf, v[5] * wf); o.w = pkbf(v[6] * wf, v[7] * wf);
          *(LAS u32x4*)(XF + row * 192 + ch * 16) = o;
          o.x = pkbf(v[0] * wb, v[1] * wb); o.y = pkbf(v[2] * wb, v[3] * wb); o.z = pkbf(v[4] * wb, v[5] * wb); o.w = pkbf(v[6] * wb, v[7] * wb);
          *(LAS u32x4*)(XB + row * 192 + ch * 16) = o; } }
}
DEV void sin_store(Frame& F, const f32x16& S, int ck, int h, int dir, int wpi, int wni) {
    bf16* o = (bf16*)(F.ws + WS_SINB) + ((size_t)(ck * 16 + h) * 2 + dir) * 8192 + (32 * wpi) * 128 + 32 * wni + (F.lane & 31);
    const int hh = F.lane >> 5;
#pragma unroll
    for (int r = 0; r < 16; r += 2) { const unsigned w = pkbf(S[r], S[r + 1]); o[crow(r, hh) * 128] = (bf16)(w & 0xffffu); o[crow(r + 1, hh) * 128] = (bf16)(w >> 16); }
}
DEV void s1_ctx_unit(Frame& F, int layer, int seq, int h) {
    LAS unsigned char* Bi = F.lds + 4096; LAS unsigned char* XF = Bi + 128 * 320; LAS unsigned char* XB = XF + 128 * 192;
    const int hh = F.lane >> 5, wpi = F.wave >> 2, wni = F.wave & 3;
    f32x16 sf[2], sb[2]; float aF[2], aB[2];
    S1Regs R;
    s1_load(F, 2 * seq, h, R);
#pragma unroll
    for (int c = 0; c < 2; ++c) {
        __syncthreads();
        s1_store(F, R, Bi, XF, XB);
        aF[c] = R.atF; aB[c] = R.atB;
        __syncthreads();
        if (c == 0) s1_load(F, 2 * seq + 1, h, R);
#pragma unroll
        for (int r = 0; r < 16; ++r) { sf[c][r] = 0.f; sb[c][r] = 0.f; }
#pragma unroll
        for (int ks = 0; ks < 8; ++ks) {
            const int k0 = 16 * ks + 8 * hh;
            const bf16x8 b = tr2(Bi, 320, k0, k0 + 4, 32 * wni, F.lane);
            const bf16x8 xf = tr2(XF, 192, k0, k0 + 4, 32 * wpi, F.lane);
            const bf16x8 xb = tr2(XB, 192, k0, k0 + 4, 32 * wpi, F.lane);
            sf[c] = MFMA32(xf, b, sf[c]); sb[c] = MFMA32(xb, b, sb[c]);
        }
    }
    sin_store(F, sf[0], 2 * seq + 1, h, 0, wpi, wni);
    sin_store(F, sb[1], 2 * seq, h, 1, wpi, wni);
    const float eF = __expf(aF[1]), eB = __expf(aB[0]);
    float* o = F.out + (size_t)10485760 + ((size_t)((seq * 4 + layer) * 2) * 16 + h) * 8192 + (32 * wpi) * 128 + 32 * wni + (F.lane & 31);
#pragma unroll
    for (int r = 0; r < 16; ++r) { const int p = crow(r, hh); o[p * 128] = eF * sf[0][r] + sf[1][r]; o[(size_t)16 * 8192 + p * 128] = eB * sb[1][r] + sb[0][r]; }
}
DEV void s1_lat_unit(Frame& F, int layer, int lb, int h, int dir) {
    LAS unsigned char* Bi = F.lds + 4096; LAS unsigned char* XF = Bi + 128 * 320; LAS unsigned char* XB = XF + 128 * 192;
    const int hh = F.lane >> 5, wpi = F.wave >> 2, wni = F.wave & 3;
    const LAS unsigned char* XA = dir ? XB : XF;
    S1Regs R;
    s1_load(F, 64 + 8 * lb + (dir ? 7 : 0), h, R);
    f32x16 S;
    { const float* s0 = F.in[IN_STATE + F.z] + ((size_t)((lb * 4 + layer) * 2 + dir) * 16 + h) * 8192 + (32 * wpi) * 128 + 32 * wni + (F.lane & 31);
#pragma unroll
      for (int r = 0; r < 16; ++r) S[r] = s0[crow(r, hh) * 128]; }
#pragma unroll 1
    for (int i = 0; i < 8; ++i) {
        const int ck = 64 + 8 * lb + (dir ? 7 - i : i);
        sin_store(F, S, ck, h, dir, wpi, wni);
        if (i == 7) break;
        __syncthreads();
        s1_store(F, R, Bi, XF, XB);
        const float e = __expf(dir ? R.atB : R.atF);
        __syncthreads();
        if (i < 6) s1_load(F, 64 + 8 * lb + (dir ? 6 - i : i + 1), h, R);
        f32x16 st;
#pragma unroll
        for (int r = 0; r < 16; ++r) st[r] = 0.f;
#pragma unroll
        for (int ks = 0; ks < 8; ++ks) {
            const int k0 = 16 * ks + 8 * hh;
            const bf16x8 b = tr2(Bi, 320, k0, k0 + 4, 32 * wni, F.lane);
            const bf16x8 xa = tr2(XA, 192, k0, k0 + 4, 32 * wpi, F.lane);
            st = MFMA32(xa, b, st);
        }
#pragma unroll
        for (int r = 0; r < 16; ++r) S[r] = e * S[r] + st[r];
    }
}

template <int NC>
DEV void stage_copy(Frame& F, const bf16* src, LAS unsigned char* img, int pitch) {
    constexpr int CPR = NC / 8, RPP = 512 / CPR;
    const int ch = F.tid % CPR, r0 = F.tid / CPR;
#pragma unroll
    for (int p = 0; p < 128 / RPP; ++p) { const int row = r0 + p * RPP; *(LAS u32x4*)(img + row * pitch + ch * 16) = *(const u32x4*)(src + (size_t)row * 2048 + ch * 8); }
}

struct S2Head { u32x4 xq[2], sq[4]; };
DEV void s2_head_load(Frame& F, const ChunkGeo& geo, int ck, int h, S2Head& H) {
    const bool nzf = ck >= 64 || (ck & 1) == 1, nzb = ck >= 64 || (ck & 1) == 0;
    const bf16* xc = (const bf16*)(F.ws + WS_XBCS) + (size_t)ck * 128 * 2048;
    { const int ch = F.tid & 7, r0 = F.tid >> 3;
#pragma unroll
      for (int p = 0; p < 2; ++p) H.xq[p] = *(const u32x4*)(xc + (size_t)(r0 + 64 * p) * 2048 + h * 64 + ch * 8); }
    { const bf16* S = (const bf16*)(F.ws + WS_SINB) + (size_t)(ck * 16 + h) * 2 * 8192;
      const int ch = F.tid & 15, r0 = F.tid >> 4;
#pragma unroll
      for (int p = 0; p < 4; ++p) { H.sq[p] = (u32x4){0u, 0u, 0u, 0u}; if (p < 2 ? nzf : nzb) H.sq[p] = *(const u32x4*)(S + (size_t)(r0 + 32 * p) * 128 + ch * 8); } }
}
DEV void s2_head_store(Frame& F, const S2Head& H, LAS unsigned char* Xi, LAS unsigned char* Si) {
    { const int ch = F.tid & 7, r0 = F.tid >> 3;
#pragma unroll
      for (int p = 0; p < 2; ++p) *(LAS u32x4*)(Xi + (r0 + 64 * p) * 192 + ch * 16) = H.xq[p]; }
    { const int ch = F.tid & 15, r0 = F.tid >> 4;
#pragma unroll
      for (int p = 0; p < 4; ++p) *(LAS u32x4*)(Si + (r0 + 32 * p) * 272 + ch * 16) = H.sq[p]; }
}
DEV void s2_unit(Frame& F, int layer, int ck, int g, int hp, bool dummy) {
    LAS float* tb0 = (LAS float*)F.lds;
    LAS unsigned char* Ci = F.lds + 12288;
    LAS unsigned char* Bi = Ci + 128 * 272;
    LAS unsigned char* Xi = Bi + 128 * 272;
    LAS unsigned char* Si = Xi + 128 * 192;
    LAS unsigned char* stg = Ci;
    bf16* AM = (bf16*)(F.ws + WS_AMG);
    float* SSQ = dummy ? (float*)(F.ws + WS_CTL + CTL_DUMMY) : (float*)(F.ws + WS_CTL + CTL_SSQ) + layer * NTOK;
    const int hh = F.lane >> 5, li = F.wave & 3, sh = F.wave >> 2, l31 = F.lane & 31, l = 32 * li + l31;
    const ChunkGeo geo = chunk_geo(ck, layer);
    const bool has_in = ck >= 64 || (ck & 1) == (sh ^ 1);
    S2Head H;
    {
        const bf16* xc = (const bf16*)(F.ws + WS_XBCS) + (size_t)ck * 128 * 2048;
        u32x4 cq[4], bq[4];
        { const int ch = F.tid & 15, r0 = F.tid >> 4;
#pragma unroll
          for (int p = 0; p < 4; ++p) { cq[p] = *(const u32x4*)(xc + (size_t)(r0 + 32 * p) * 2048 + 1536 + g * 128 + ch * 8); bq[p] = *(const u32x4*)(xc + (size_t)(r0 + 32 * p) * 2048 + 1024 + g * 128 + ch * 8); } }
        const u32x4* tsrc = (const u32x4*)((const float*)(F.ws + WS_TB) + (size_t)(ck * 16 + 4 * g + 2 * hp) * TBW);
        const u32x4 tq = tsrc[F.tid]; u32x4 tq2 = {0u, 0u, 0u, 0u}; if (F.tid < 256) tq2 = tsrc[512 + F.tid];
        s2_head_load(F, geo, ck, 4 * g + 2 * hp, H);
        { const int ch = F.tid & 15, r0 = F.tid >> 4;
#pragma unroll
          for (int p = 0; p < 4; ++p) { *(LAS u32x4*)(Ci + (r0 + 32 * p) * 272 + ch * 16) = cq[p]; *(LAS u32x4*)(Bi + (r0 + 32 * p) * 272 + ch * 16) = bq[p]; } }
        *(LAS u32x4*)(tb0 + F.tid * 4) = tq; if (F.tid < 256) *(LAS u32x4*)(tb0 + 2048 + F.tid * 4) = tq2;
        s2_head_store(F, H, Xi, Si);
    }
    __syncthreads();
    bf16x8 cf[8];
#pragma unroll
    for (int ks = 0; ks < 8; ++ks) cf[ks] = *(const LAS bf16x8*)(Ci + l * 272 + (16 * ks + 8 * hh) * 2);
    f32x16 gt[2];
#pragma unroll
    for (int sj = 0; sj < 2; ++sj) {
#pragma unroll
        for (int r = 0; r < 16; ++r) gt[sj][r] = 0.f;
#pragma unroll
        for (int ks = 0; ks < 8; ++ks) { const bf16x8 a = *(const LAS bf16x8*)(Bi + (32 * (2 * sh + sj) + l31) * 272 + (16 * ks + 8 * hh) * 2); gt[sj] = MFMA32(a, cf[ks], gt[sj]); }
    }
#pragma unroll 1
    for (int j = 0; j < 2; ++j) {
        const int h = 4 * g + 2 * hp + j;
        const LAS float* tb = tb0 + TBW * j;
        u32x2 zq[4];
#pragma unroll
        for (int v = 0; v < 4; ++v) zq[v] = *(const u32x2*)((const bf16*)(F.ws + WS_PROJ) + (size_t)geo_row(geo, geo.pos0 + F.wave * 16 + 4 * v + (F.lane >> 4)) * NPROJ + PC_ZM + h * 64 + 4 * (F.lane & 15));
        if (j == 0) s2_head_load(F, geo, ck, h + 1, H);
        const float dsk = F.in[IN_DSKIP + F.z][layer * 16 + h];
        const float acFl = tb[4 * l], acBl = tb[4 * l + 2];
        f32x16 accd[2];
#pragma unroll
        for (int r = 0; r < 16; ++r) { accd[0][r] = 0.f; accd[1][r] = 0.f; }
        if (has_in) {
#pragma unroll
            for (int pi = 0; pi < 2; ++pi) {
#pragma unroll
                for (int ks = 0; ks < 8; ++ks) { const bf16x8 sb = *(const LAS bf16x8*)(Si + sh * (64 * 272) + (32 * pi + l31) * 272 + (16 * ks + 8 * hh) * 2); accd[pi] = MFMA32(cf[ks], sb, accd[pi]); }
#pragma unroll
                for (int r = 0; r < 16; ++r) accd[pi][r] *= tb[512 + sh * 128 + 32 * li + crow(r, hh)];
            }
        }
#pragma unroll
        for (int sj = 0; sj < 2; ++sj) {
            const int si = 2 * sh + sj;
            float m[16];
            if (si != li) {
                const int dofs = si < li ? 0 : 128;
                const float f2 = si < li ? __expf(tb[4 * (32 * li)] - tb[4 * (32 * si + 31)]) : __expf(tb[4 * (32 * li + 31) + 2] - tb[4 * (32 * si) + 2]);
                const float c = tb[1280 + dofs + l] * f2;
#pragma unroll
                for (int q4 = 0; q4 < 4; ++q4) { const f32x4 gs = *(const LAS f32x4*)(tb + 1024 + dofs + 32 * si + 8 * q4 + 4 * hh);
                    m[4 * q4] = gt[sj][4 * q4] * (c * gs.x); m[4 * q4 + 1] = gt[sj][4 * q4 + 1] * (c * gs.y); m[4 * q4 + 2] = gt[sj][4 * q4 + 2] * (c * gs.z); m[4 * q4 + 3] = gt[sj][4 * q4 + 3] * (c * gs.w); }
            } else {
#pragma unroll
                for (int r = 0; r < 16; ++r) {
                    const int s = 32 * si + crow(r, hh);
                    const f32x4 ts = *(const LAS f32x4*)(tb + 4 * s);
                    const float wf = __expf(fminf(acFl - ts.x, 0.f)) * ts.y, wb = __expf(fminf(acBl - ts.z, 0.f)) * ts.w;
                    const float w = l > s ? wf : (l < s ? wb : ts.y + ts.w);
                    m[r] = gt[sj][r] * w + (l == s ? dsk : 0.f);
                }
            }
#pragma unroll
            for (int t = 0; t < 2; ++t) {
                const bf16x8 ma = pack8(m[8 * t], m[8 * t + 1], m[8 * t + 2], m[8 * t + 3], m[8 * t + 4], m[8 * t + 5], m[8 * t + 6], m[8 * t + 7]);
                const int r0 = 32 * si + 16 * t + 4 * hh;
#pragma unroll
                for (int pi = 0; pi < 2; ++pi) { const bf16x8 xb = tr2(Xi, 192, r0, r0 + 8, 32 * pi, F.lane); accd[pi] = MFMA32(ma, xb, accd[pi]); }
            }
        }
        __syncthreads();
#pragma unroll
        for (int pi = 0; pi < 2; ++pi)
#pragma unroll
            for (int r = 0; r < 16; ++r) *(LAS float*)(stg + sh * (128 * 272) + (32 * li + crow(r, hh)) * 272 + (32 * pi + l31) * 4) = accd[pi][r];
        if (j == 0) s2_head_store(F, H, Xi, Si);
        __syncthreads();
        const int c4 = F.lane & 15;
        const f32x4 nw = *(const f32x4*)(F.in[IN_SSMNW + F.z] + layer * D + h * 64 + 4 * c4);
#pragma unroll
        for (int v = 0; v < 4; ++v) {
            const int lr = F.wave * 16 + 4 * v + (F.lane >> 4);
            const f32x4 y0 = *(const LAS f32x4*)(stg + lr * 272 + c4 * 16), y1 = *(const LAS f32x4*)(stg + 128 * 272 + lr * 272 + c4 * 16);
            const int row = geo_row(geo, geo.pos0 + lr);
            const u32x2 zr = zq[v];
            f32x4 y = y0 + y1;
            y.x *= bf2f(zr.x & 0xffffu); y.y *= bf2f(zr.x >> 16); y.z *= bf2f(zr.y & 0xffffu); y.w *= bf2f(zr.y >> 16);
            float q = (y.x * y.x + y.y * y.y) + (y.z * y.z + y.w * y.w);
            q += shfl_x(q, 1, F.lane); q += shfl_x(q, 2, F.lane); q += shfl_x(q, 4, F.lane); q += shfl_x(q, 8, F.lane);
            if (c4 == 0) atomicAdd(SSQ + row, q);
            y = y * nw;
            u32x2 o; o.x = pkbf(y.x, y.y); o.y = pkbf(y.z, y.w);
            *(u32x2*)(AM + (size_t)row * 2048 + h * 64 + 4 * c4) = o;
        }
        if (j == 0) __syncthreads();
    }
}

DEV void gmlp_unit(Frame& F, int layer, int vb) {
    LAS unsigned char* Vi = F.lds;
    LAS unsigned char* stg = F.lds + 128 * 320;
    LAS unsigned char* Wi = stg + 128 * 528;
    const bf16* proj = (const bf16*)(F.ws + WS_PROJ);
    const float* gsum = (const float*)(F.ws + WS_CTL + CTL_GSUM) + (size_t)layer * NTOK * 2;
    bf16* ag = (bf16*)(F.ws + WS_AMG) + 1024;
    const int hh = F.lane >> 5, ti = F.wave >> 1, cj = F.wave & 1, l31 = F.lane & 31;
    {
        const int ck = vb >> 3, g = vb & 7;
        u32x2 uq[8];
#pragma unroll
        for (int v = 0; v < 8; ++v) { const size_t ro = (size_t)(ck * 128 + F.wave * 16 + 2 * v + hh) * NPROJ + g * 128 + 4 * l31; uq[v] = *(const u32x2*)(proj + ro + PC_U); }
        {
            const bf16* wsrc = (const bf16*)(F.ws + WS_WSPB) + (size_t)(layer * 8 + g) * 128 * 128;
            const int ch = F.tid & 15, r0 = F.tid >> 4;
            u32x4 wq[4];
#pragma unroll
            for (int p = 0; p < 4; ++p) wq[p] = *(const u32x4*)(wsrc + (size_t)(r0 + 32 * p) * 128 + ch * 8);
#pragma unroll
            for (int p = 0; p < 4; ++p) *(LAS u32x4*)(Wi + (r0 + 32 * p) * 272 + ch * 16) = wq[p];
        }
        {
            const int s = F.tid >> 2, c0 = (F.tid & 3) * 32, row = ck * 128 + s;
            const float mu = gsum[row * 2] * (1.f / D), rstd = rsqrtf(fmaxf(gsum[row * 2 + 1] * (1.f / D) - mu * mu, 0.f) + EPS);
            const float* lnw = F.in[IN_LNW + F.z] + layer * D + g * 128 + c0; const float* lnb = F.in[IN_LNB + F.z] + layer * D + g * 128 + c0;
#pragma unroll
            for (int j = 0; j < 4; ++j) {
                const u32x4 r = *(const u32x4*)(proj + (size_t)row * NPROJ + PC_V + g * 128 + c0 + 8 * j);
                const f32x4 w0 = *(const f32x4*)(lnw + 8 * j), w1 = *(const f32x4*)(lnw + 8 * j + 4), b0 = *(const f32x4*)(lnb + 8 * j), b1 = *(const f32x4*)(lnb + 8 * j + 4);
                float v[8] = {bf2f(r.x & 0xffffu), bf2f(r.x >> 16), bf2f(r.y & 0xffffu), bf2f(r.y >> 16), bf2f(r.z & 0xffffu), bf2f(r.z >> 16), bf2f(r.w & 0xffffu), bf2f(r.w >> 16)};
                const float ww[8] = {w0.x, w0.y, w0.z, w0.w, w1.x, w1.y, w1.z, w1.w}, bb[8] = {b0.x, b0.y, b0.z, b0.w, b1.x, b1.y, b1.z, b1.w};
#pragma unroll
                for (int c = 0; c < 8; ++c) v[c] = (v[c] - mu) * rstd * ww[c] + bb[c];
                u32x4 o; o.x = pkbf(v[0], v[1]); o.y = pkbf(v[2], v[3]); o.z = pkbf(v[4], v[5]); o.w = pkbf(v[6], v[7]);
                *(LAS u32x4*)(Vi + s * 320 + (c0 + 8 * j) * 2) = o;
            }
        }
        __syncthreads();
        f32x16 acc[2];
#pragma unroll
        for (int r = 0; r < 16; ++r) { acc[0][r] = 0.f; acc[1][r] = 0.f; }
#pragma unroll
        for (int ks = 0; ks < 8; ++ks) {
            const int k0 = 16 * ks + 8 * hh;
            const bf16x8 a = *(const LAS bf16x8*)(Wi + (32 * ti + l31) * 272 + k0 * 2);
#pragma unroll
            for (int c = 0; c < 2; ++c) { const bf16x8 b = tr2(Vi, 320, k0, k0 + 4, 64 * cj + 32 * c, F.lane); acc[c] = MFMA32(a, b, acc[c]); }
        }
#pragma unroll
        for (int c = 0; c < 2; ++c)
#pragma unroll
            for (int r = 0; r < 16; ++r) *(LAS float*)(stg + (32 * ti + crow(r, hh)) * 528 + (64 * cj + 32 * c + l31) * 4) = acc[c][r];
        __syncthreads();
        const float* bsp = F.in[IN_BSP + F.z] + (layer * 8 + g) * 128;
#pragma unroll
        for (int v = 0; v < 8; ++v) {
            const int t = F.wave * 16 + 2 * v + hh, row = ck * 128 + t;
            const f32x4 sv = *(const LAS f32x4*)(stg + t * 528 + l31 * 16) + bsp[t];
            const u32x2 ur = uq[v];
            u32x2 o;
            o.x = pkbf(bf2f(ur.x & 0xffffu) * sv.x, bf2f(ur.x >> 16) * sv.y);
            o.y = pkbf(bf2f(ur.y & 0xffffu) * sv.z, bf2f(ur.y >> 16) * sv.w);
            *(u32x2*)(ag + (size_t)row * 2048 + g * 128 + 4 * l31) = o;
        }
    }
}

constexpr int CW_QUEUE = 8192;
DEV void ph_queue(const Frame& F0, int layer, int which, int qidx, bool dummy) {
    Frame F = launder(F0);
    asm volatile("" : "+s"(layer));
    unsigned* head = (unsigned*)(F.ws + WS_CTL) + CW_QUEUE + 64 * qidx;
    volatile LAS unsigned* slot = (volatile LAS unsigned*)(F.lds + LDS_BYTES - 256) + 16;
    const int N = which == 0 ? 64 + 512 : 640 + 640;
    __syncthreads();
    if (F.tid == 0) *slot = atomicAdd(head, 1u);
    __syncthreads();
    int it = (int)*slot;
    while (it < N) {
        unsigned nxt = 0u;
        Frame Fi = launder(F);
        if (Fi.tid == 0) nxt = atomicAdd((unsigned*)(Fi.ws + WS_CTL) + CW_QUEUE + 64 * qidx, 1u);
        if (which == 0) {
            if (it < 64) s1_lat_unit(Fi, layer, it >> 5, (it >> 1) & 15, it & 1);
            else s1_ctx_unit(Fi, layer, (it - 64) >> 4, (it - 64) & 15);
        } else {
            if (it < 640) s2_unit(Fi, layer, it >> 3, (it >> 1) & 3, it & 1, dummy);
            else gmlp_unit(Fi, layer, it - 640);
        }
        __syncthreads();
        if (nxt != 0u) *slot = nxt;
        __syncthreads();
        it = (int)*slot;
    }
}

DEV void ph_dt(const Frame& F0, int layer) {
    Frame F = launder(F0);
    asm volatile("" : "+s"(layer));
    LAS unsigned char* Ai = F.lds;
    LAS unsigned char* Wi = F.lds + 40 * 2064;
    LAS float* red = (LAS float*)F.lds;
    const int hh = F.lane >> 5, l31 = F.lane & 31;
    for (int u = F.bid; u < NTOK / 40; u += F.G) {
        __syncthreads();
        {   const bf16* A = (const bf16*)(F.ws + WS_HBUF) + (size_t)u * 40 * D;
            const bf16* W = (const bf16*)(F.ws + WS_WDT) + (size_t)layer * 32 * 1024;
            u32x4 aq[10], wq[8];
#pragma unroll
            for (int j = 0; j < 10; ++j) { const int c = F.tid + 512 * j; aq[j] = *(const u32x4*)(A + (size_t)(c >> 7) * D + (c & 127) * 8); }
#pragma unroll
            for (int j = 0; j < 8; ++j) { const int c = F.tid + 512 * j; wq[j] = *(const u32x4*)(W + (size_t)(c >> 7) * 1024 + (c & 127) * 8); }
#pragma unroll
            for (int j = 0; j < 10; ++j) { const int c = F.tid + 512 * j; *(LAS u32x4*)(Ai + (c >> 7) * 2064 + (c & 127) * 16) = aq[j]; }
#pragma unroll
            for (int j = 0; j < 8; ++j) { const int c = F.tid + 512 * j; *(LAS u32x4*)(Wi + (c >> 7) * 2064 + (c & 127) * 16) = wq[j]; }
        }
        __syncthreads();
        f32x16 acc[2];
#pragma unroll
        for (int r = 0; r < 16; ++r) { acc[0][r] = 0.f; acc[1][r] = 0.f; }
#pragma unroll
        for (int ks = 0; ks < 8; ++ks) {
            const int kb = (128 * F.wave + 16 * ks + 8 * hh) * 2;
            const bf16x8 b = *(const LAS bf16x8*)(Wi + l31 * 2064 + kb);
            const bf16x8 a0 = *(const LAS bf16x8*)(Ai + l31 * 2064 + kb), a1 = *(const LAS bf16x8*)(Ai + (32 + l31) * 2064 + kb);
            acc[0] = MFMA32(a0, b, acc[0]); acc[1] = MFMA32(a1, b, acc[1]);
        }
        __syncthreads();
#pragma unroll
        for (int t = 0; t < 2; ++t)
#pragma unroll
            for (int r = 0; r < 16; ++r) red[((F.wave * 2 + t) * 32 + crow(r, hh)) * 32 + l31] = acc[t][r];
        __syncthreads();
        for (int o = F.tid; o < 40 * 32; o += 512) {
            const int r = o >> 5, j = o & 31, t = r >> 5, rr = r & 31;
            float v = 0.f;
#pragma unroll
            for (int w = 0; w < 8; ++w) v += red[((w * 2 + t) * 32 + rr) * 32 + j];
            const int row = u * 40 + r;
            const float rs = rsqrtf(((const float*)(F.ws + WS_CTL + CTL_SSQX))[(size_t)layer * NTOK + row] * (1.f / D) + EPS);
            const float swv = ((const float*)(F.ws + WS_CTL + CTL_SW))[(size_t)(layer * 3 + (row < NCTX ? 0 : 1 + ((row - NCTX) >> 10))) * DIN + 3072 + j];
            ((float*)(F.ws + WS_DTRAW))[(size_t)row * 32 + j] = v * rs + swv;
        }
    }
}

#define XB_TMO      128
#define XB_XCNT(j)  (256  + 64 * (j))
#define XB_XSUB(j)  (1280 + 64 * (j))
#define XB_XGEN(j)  (2304 + 64 * (j))
#define XB_TOP      3328
#define XB_TOPGEN   3392
#define XCD_BAR_WORDS 3456
#define XB_SPIN_CAP (1u << 18)

__device__ __forceinline__ unsigned xb_ld(unsigned* p)              { return __hip_atomic_load(p, __ATOMIC_RELAXED, __HIP_MEMORY_SCOPE_AGENT); }
__device__ __forceinline__ unsigned xb_add(unsigned* p, unsigned v) { return __hip_atomic_fetch_add(p, v, __ATOMIC_RELAXED, __HIP_MEMORY_SCOPE_AGENT); }
__device__ __forceinline__ unsigned xb_xcc_id() { return (unsigned)__builtin_amdgcn_s_getreg((3 << 11) | 20) & 0xFu; }
#define XB_SPIN(cond, bar) do { unsigned _sp = 0; while (cond) { __builtin_amdgcn_s_sleep(1); \
    if ((++_sp & 255u) == 0u) { if (xb_ld(&(bar)[XB_TMO])) break; if (_sp > XB_SPIN_CAP) { atomicAdd(&(bar)[XB_TMO], 1u); break; } } } } while (0)

struct XcdBarrier {
    unsigned* bar; unsigned x;
    volatile LAS unsigned* st;
};

__device__ __forceinline__ XcdBarrier xcd_barrier_post(unsigned* bar, volatile LAS unsigned* st) {
    XcdBarrier b; b.bar = bar; b.x = xb_xcc_id(); b.st = st;
    if (threadIdx.x == 0) (void)xb_add(&bar[XB_XCNT(b.x)], 1u);
    return b;
}
__device__ __forceinline__ void xcd_barrier_complete(unsigned* bar, unsigned x, unsigned& nloc, unsigned& nx) {
    const unsigned G = gridDim.x * gridDim.y * gridDim.z;
    unsigned sum, cnt, mine, sp = 0u;
    for (;;) {
        sum = 0u; cnt = 0u; mine = 0u;
#pragma unroll
        for (unsigned j = 0; j < 16; ++j) { const unsigned c = xb_ld(&bar[XB_XCNT(j)]); sum += c; cnt += (c > 0u) ? 1u : 0u; mine = (j == x) ? c : mine; }
        if (sum == G) break;
        __builtin_amdgcn_s_sleep(1);
        if ((++sp & 255u) == 0u) { if (xb_ld(&bar[XB_TMO])) break; if (sp > XB_SPIN_CAP) { atomicAdd(&bar[XB_TMO], 1u); break; } }
    }
    nloc = mine > 0u ? mine : 1u; nx = cnt > 0u ? cnt : 1u;
}

__device__ __forceinline__ void xcd_barrier(const XcdBarrier& b) {
    asm volatile("s_waitcnt vmcnt(0)" ::: "memory");
    __syncthreads();
    if (threadIdx.x == 0) {
        unsigned* bar = b.bar;
        __builtin_amdgcn_s_waitcnt(0);
        unsigned nloc = b.st[0], nx = b.st[1];
        if (nloc == 0u) { xcd_barrier_complete(bar, b.x, nloc, nx); b.st[0] = nloc; b.st[1] = nx; }
        const unsigned old = xb_add(&bar[XB_XSUB(b.x)], 1u);
        const unsigned gen = old / nloc;
        if (old + 1u == (gen + 1u) * nloc) {
            __builtin_amdgcn_fence(__ATOMIC_RELEASE, "agent");
            asm volatile("s_waitcnt vmcnt(0)" ::: "memory");
            const unsigned og = xb_add(&bar[XB_TOP], 1u);
            const unsigned tg = og / nx;
            if (og + 1u == (tg + 1u) * nx) xb_add(&bar[XB_TOPGEN], 1u);
            else XB_SPIN(xb_ld(&bar[XB_TOPGEN]) == tg, bar);
            __builtin_amdgcn_fence(__ATOMIC_ACQUIRE, "agent");
            xb_add(&bar[XB_XGEN(b.x)], 1u);
            asm volatile("s_waitcnt vmcnt(0)" ::: "memory");
        } else {
            XB_SPIN(xb_ld(&bar[XB_XGEN(b.x)]) == gen, bar);
            __builtin_amdgcn_fence(__ATOMIC_ACQUIRE, "agent");
            asm volatile("s_waitcnt vmcnt(0)" ::: "memory");
        }
    }
    __syncthreads();
}

struct EpiIn {
    static constexpr bool PERM = true, AFTER_DRAIN = false, HAS_MID = false;
    bf16* O; const float* ssqx; const float* sw; float* gsum;
    __device__ __forceinline__ void operator()(const f32x4 (&acc)[2][2][4][2], const pg8::Unit& u, int wr, int wc, int fr, int fq) const {
        int row0 = u.pm * 256 + wr * 64 + fr, cl = wc * 32 + 8 * fq;
        asm volatile("" : "+v"(row0), "+v"(cl));
        const int mv = u.pm < 32 ? 0 : 1 + ((u.pm - 32) >> 2);
        const int kind = u.pn < 8 ? 0 : u.pn < 12 ? 1 : u.pn < 20 ? 2 : u.pn < 24 ? 3 : 4;
        int nat[2], oc[2];
        if (u.pn < 12) { nat[0] = u.pn * 256; nat[1] = nat[0] + 128; oc[0] = nat[0]; oc[1] = nat[1]; }
        else if (u.pn < 20) { nat[0] = 3104 + (u.pn - 12) * 128; nat[1] = 5152 + (u.pn - 12) * 128; oc[0] = PC_U + (u.pn - 12) * 128; oc[1] = oc[0]; }
        else if (u.pn < 24) { nat[0] = 4128 + (u.pn - 20) * 256; nat[1] = nat[0] + 128; oc[0] = PC_V + (u.pn - 20) * 256; oc[1] = oc[0] + 128; }
        else { nat[0] = 6176 + (u.pn - 24) * 128; nat[1] = 7200 + (u.pn - 24) * 128; oc[0] = PC_GLM + (u.pn - 24) * 128; oc[1] = PC_GLG + (u.pn - 24) * 128; }
        f32x4 bv[2][2];
#pragma unroll
        for (int bj = 0; bj < 2; ++bj)
#pragma unroll
            for (int n = 0; n < 2; ++n) bv[bj][n] = *(const f32x4*)(sw + mv * DIN + nat[bj] + cl + 4 * n);
        float rs8[8];
#pragma unroll
        for (int i = 0; i < 8; ++i) rs8[i] = ssqx[row0 + (i >> 2) * 128 + (i & 3) * 16];
#pragma unroll
        for (int i = 0; i < 8; ++i) rs8[i] = rsqrtf(rs8[i] * (1.f / D) + EPS);
#pragma unroll
        for (int ai = 0; ai < 2; ++ai)
#pragma unroll
            for (int m = 0; m < 4; ++m) {
                const int r = row0 + ai * 128 + m * 16;
                const float rs = rs8[ai * 4 + m];
                float v[2][8];
#pragma unroll
                for (int bj = 0; bj < 2; ++bj)
#pragma unroll
                    for (int j = 0; j < 4; ++j) { v[bj][j] = acc[ai][bj][m][0][j] * rs + bv[bj][0][j]; v[bj][4 + j] = acc[ai][bj][m][1][j] * rs + bv[bj][1][j]; }
                if (kind == 2) {
#pragma unroll
                    for (int j = 0; j < 8; ++j) v[0][j] = gelu_f(v[0][j]) * silu_f(v[1][j]);
                    u32x4 w; w.x = pkbf(v[0][0], v[0][1]); w.y = pkbf(v[0][2], v[0][3]); w.z = pkbf(v[0][4], v[0][5]); w.w = pkbf(v[0][6], v[0][7]);
                    *(u32x4*)(O + (size_t)r * NPROJ + oc[0] + cl) = w;
                } else {
                    float s1 = 0.f, s2 = 0.f;
                    if (kind == 4) {
#pragma unroll
                        for (int j = 0; j < 8; ++j) { const float em = __expf(-v[0][j]), eg = __expf(-v[1][j]); v[1][j] = __builtin_amdgcn_rcpf(1.f + eg); v[0][j] = (1.f + eg) * __builtin_amdgcn_rcpf(1.f + em); }
                    }
#pragma unroll
                    for (int bj = 0; bj < 2; ++bj) {
                        if (kind == 1) {
#pragma unroll
                            for (int j = 0; j < 8; ++j) v[bj][j] = silu_f(v[bj][j]);
                        } else if (kind == 3) {
#pragma unroll
                            for (int j = 0; j < 8; ++j) { v[bj][j] = gelu_f(v[bj][j]); s1 += v[bj][j]; s2 += v[bj][j] * v[bj][j]; }
                        }
                        u32x4 w; w.x = pkbf(v[bj][0], v[bj][1]); w.y = pkbf(v[bj][2], v[bj][3]); w.z = pkbf(v[bj][4], v[bj][5]); w.w = pkbf(v[bj][6], v[bj][7]);
                        *(u32x4*)(O + (size_t)r * NPROJ + oc[bj] + cl) = w;
                    }
                    if (kind == 3) {
                        const int ln = fr + 16 * fq; s1 += shfl_x(s1, 16, ln); s1 += shfl_x(s1, 32, ln); s2 += shfl_x(s2, 16, ln); s2 += shfl_x(s2, 32, ln);
                        if (fq == 0) { atomicAdd(gsum + 2 * r, s1); atomicAdd(gsum + 2 * r + 1, s2); }
                    }
                }
            }
    }
};
struct EpiMerge {
    static constexpr bool PERM = true, AFTER_DRAIN = false, HAS_MID = true;
    bf16* O; const bf16* proj; const float* ssq;
    __device__ __forceinline__ void mid(f32x4 (&acc)[2][2][4][2], const pg8::Unit& u, int wr, int wc, int fr, int fq) const {
        int row0 = u.pm * 256 + wr * 64 + fr, col0 = u.pn * 256 + wc * 32 + 8 * fq;
        asm volatile("" : "+v"(row0), "+v"(col0));
        u32x4 g[8][2]; float rs8[8];
#pragma unroll
        for (int i = 0; i < 8; ++i) { const int r = row0 + (i >> 2) * 128 + (i & 3) * 16; rs8[i] = ssq[r];
#pragma unroll
            for (int bj = 0; bj < 2; ++bj) g[i][bj] = *(const u32x4*)(proj + (size_t)r * NPROJ + PC_GLM + col0 + bj * 128); }
#pragma unroll
        for (int i = 0; i < 8; ++i) { const int ai = i >> 2, m = i & 3; const float rs = rsqrtf(rs8[i] * (1.f / D) + EPS);
#pragma unroll
            for (int bj = 0; bj < 2; ++bj) { const u32x4 q = g[i][bj];
                acc[ai][bj][m][0][0] *= bf2f(q.x & 0xffffu) * rs; acc[ai][bj][m][0][1] *= bf2f(q.x >> 16) * rs; acc[ai][bj][m][0][2] *= bf2f(q.y & 0xffffu) * rs; acc[ai][bj][m][0][3] *= bf2f(q.y >> 16) * rs;
                acc[ai][bj][m][1][0] *= bf2f(q.z & 0xffffu) * rs; acc[ai][bj][m][1][1] *= bf2f(q.z >> 16) * rs; acc[ai][bj][m][1][2] *= bf2f(q.w & 0xffffu) * rs; acc[ai][bj][m][1][3] *= bf2f(q.w >> 16) * rs; } }
    }
    __device__ __forceinline__ void operator()(const f32x4 (&acc)[2][2][4][2], const pg8::Unit& u, int wr, int wc, int fr, int fq) const {
        int row0 = u.pm * 256 + wr * 64 + fr, col0 = u.pn * 256 + wc * 32 + 8 * fq;
        asm volatile("" : "+v"(row0), "+v"(col0));
        u32x4 g[8][2];
#pragma unroll
        for (int i = 0; i < 8; ++i) { const int r = row0 + (i >> 2) * 128 + (i & 3) * 16;
#pragma unroll
            for (int bj = 0; bj < 2; ++bj) g[i][bj] = *(const u32x4*)(proj + (size_t)r * NPROJ + PC_GLG + col0 + bj * 128); }
#pragma unroll
        for (int i = 0; i < 8; ++i) { const int ai = i >> 2, m = i & 3, r = row0 + ai * 128 + m * 16;
#pragma unroll
            for (int bj = 0; bj < 2; ++bj) { const u32x4 q = g[i][bj]; u32x4 w;
                w.x = pkbf(acc[ai][bj][m][0][0] * bf2f(q.x & 0xffffu), acc[ai][bj][m][0][1] * bf2f(q.x >> 16));
                w.y = pkbf(acc[ai][bj][m][0][2] * bf2f(q.y & 0xffffu), acc[ai][bj][m][0][3] * bf2f(q.y >> 16));
                w.z = pkbf(acc[ai][bj][m][1][0] * bf2f(q.z & 0xffffu), acc[ai][bj][m][1][1] * bf2f(q.z >> 16));
                w.w = pkbf(acc[ai][bj][m][1][2] * bf2f(q.w & 0xffffu), acc[ai][bj][m][1][3] * bf2f(q.w >> 16));
                *(u32x4*)(O + (size_t)r * D + col0 + bj * 128) = w; } }
    }
};
struct EpiOut {
    static constexpr bool PERM = true, AFTER_DRAIN = false, HAS_MID = false;
    const float* xp; const float* xs; const float* xold; float* xnew; bf16* hx; const float* mod; const float* gn; float* ssqn;
    __device__ __forceinline__ void operator()(const f32x4 (&acc)[2][2][4][2], const pg8::Unit& u, int wr, int wc, int fr, int fq) const {
        int row0 = u.pm * 256 + wr * 64 + fr, col0 = u.pn * 256 + wc * 32 + 8 * fq;
        asm volatile("" : "+v"(row0), "+v"(col0));
        const int mv = u.pm < 32 ? 0 : 1 + ((u.pm - 32) >> 2);
        const float* xo = xold ? xold : (u.pm < 32 ? xp : xs - (size_t)NCTX * D);
        const float* gate = mod + mv * 3072 + 2048 + col0;
        f32x4 ga[2][2];
#pragma unroll
        for (int bj = 0; bj < 2; ++bj)
#pragma unroll
            for (int n = 0; n < 2; ++n) ga[bj][n] = *(const f32x4*)(gate + bj * 128 + 4 * n);
#pragma unroll
        for (int ai = 0; ai < 2; ++ai) {
            f32x4 x[4][2][2];
#pragma unroll
            for (int m = 0; m < 4; ++m)
#pragma unroll
                for (int bj = 0; bj < 2; ++bj)
#pragma unroll
                    for (int n = 0; n < 2; ++n) x[m][bj][n] = *(const f32x4*)(xo + (size_t)(row0 + ai * 128 + m * 16) * D + col0 + bj * 128 + 4 * n);
#pragma unroll
            for (int m = 0; m < 4; ++m) {
                const int r = row0 + ai * 128 + m * 16;
                float q = 0.f;
#pragma unroll
                for (int bj = 0; bj < 2; ++bj) {
                    const size_t off = (size_t)r * D + col0 + bj * 128;
                    const f32x4 n0 = x[m][bj][0] + ga[bj][0] * acc[ai][bj][m][0], n1 = x[m][bj][1] + ga[bj][1] * acc[ai][bj][m][1];
                    *(f32x4*)(xnew + off) = n0; *(f32x4*)(xnew + off + 4) = n1;
                    q += (n0.x * n0.x + n0.y * n0.y) + (n0.z * n0.z + n0.w * n0.w) + (n1.x * n1.x + n1.y * n1.y) + (n1.z * n1.z + n1.w * n1.w);
                    if (gn) { const f32x4 h0 = n0 * *(const f32x4*)(gn + mv * 1024 + col0 + bj * 128), h1 = n1 * *(const f32x4*)(gn + mv * 1024 + col0 + bj * 128 + 4);
                        u32x4 w; w.x = pkbf(h0.x, h0.y); w.y = pkbf(h0.z, h0.w); w.z = pkbf(h1.x, h1.y); w.w = pkbf(h1.z, h1.w);
                        *(u32x4*)(hx + off) = w; }
                }
                { const int ln = fr + 16 * fq; q += shfl_x(q, 16, ln); q += shfl_x(q, 32, ln); }
                if (fq == 0) atomicAdd(ssqn + r, q);
            }
            asm volatile("" ::: "memory");
        }
    }
};

constexpr int CW_BAR = 4096;
constexpr int MISC_OFF = LDS_BYTES - 256;

__global__ void __launch_bounds__(512, 2) mega(Args args) {
    extern __shared__ __attribute__((aligned(16))) unsigned char lds[];
    Frame F;
    F.lds = (LAS unsigned char*)lds; F.tid = threadIdx.x; F.lane = F.tid & 63; F.wave = __builtin_amdgcn_readfirstlane(F.tid >> 6);
    F.G = gridDim.x; F.bid = blockIdx.x; F.in = args.in; F.out = args.out; F.ws = args.ws; F.z = 0;
    volatile LAS unsigned* MISC = (volatile LAS unsigned*)(F.lds + MISC_OFF);
    if (F.tid < 64) MISC[F.tid] = 0u;
    __syncthreads();
    (void)xcd_barrier_post((unsigned*)(F.ws + WS_CTL) + CW_BAR, MISC + 8);
#define GRID_BAR() do { Frame Fb = launder(F); XcdBarrier b_; b_.bar = (unsigned*)(Fb.ws + WS_CTL) + CW_BAR; b_.x = xb_xcc_id(); b_.st = (volatile LAS unsigned*)(Fb.lds + MISC_OFF) + 8; xcd_barrier(b_); } while (0)
    ph_mod(F); GRID_BAR();
    ph_cvt(F, 0, 0, F.G); ph_gn(F); ph_prep0(F); GRID_BAR();
    for (int layer = 0; layer < DEPTH; ++layer) {
        { Frame Fg = launder(F);
          pg8::Gemm g{(const bf16*)(Fg.ws + WS_HBUF), (const bf16*)(Fg.ws + WS_WIN) + (size_t)layer * NPROJ * 1024, NTOK, NPROJ, D};
          pg8::StaticOrder S; S.init(NTOK, NPROJ, Fg.G, Fg.bid);
          EpiIn E{(bf16*)(Fg.ws + WS_PROJ), (const float*)(Fg.ws + WS_CTL + CTL_SSQX) + (size_t)layer * NTOK, (const float*)(Fg.ws + WS_CTL + CTL_SW) + (size_t)layer * 3 * DIN,
                  (float*)(Fg.ws + WS_CTL + CTL_GSUM) + (size_t)layer * NTOK * 2};
          pg8::gemm_phase<EpiIn, pg8::StaticOrder, true, true>(Fg.lds, g, S, E, Fg.wave); }
        ph_dt(F, layer);
        GRID_BAR();
        ph_b0(F, layer); GRID_BAR();
        if (DUP_MASK & 1) { ph_b0(F, layer); GRID_BAR(); }
        ph_queue(F, layer, 0, layer, false); GRID_BAR();
        if (DUP_MASK & 2) { ph_queue(F, layer, 0, 8 + layer, false); GRID_BAR(); }
        ph_queue(F, layer, 1, 4 + layer, false); GRID_BAR();
        if (DUP_MASK & 4) { ph_queue(F, layer, 1, 12 + layer, true); GRID_BAR(); }
        { Frame Fg = launder(F);
          pg8::Gemm g{(const bf16*)(Fg.ws + WS_AMG), (const bf16*)(Fg.ws + WS_WMG) + (size_t)layer * 1024 * 2048, NTOK, D, 2048};
          pg8::StaticOrder S; S.init(NTOK, D, Fg.G, Fg.bid);
          EpiMerge E{(bf16*)(Fg.ws + WS_MRG), (const bf16*)(Fg.ws + WS_PROJ), (const float*)(Fg.ws + WS_CTL + CTL_SSQ) + (size_t)layer * NTOK};
          pg8::gemm_phase<EpiMerge, pg8::StaticOrder, true, true>(Fg.lds, g, S, E, Fg.wave); }
        if (layer + 1 < DEPTH) ph_cvt(F, layer + 1, 160, F.G - 160);
        GRID_BAR();
        { Frame Fg = launder(F);
          pg8::Gemm g{(const bf16*)(Fg.ws + WS_MRG), (const bf16*)(Fg.ws + WS_WO) + (size_t)layer * 1024 * 1024, NTOK, D, D};
          pg8::StaticOrder S; S.init(NTOK, D, Fg.G, Fg.bid);
          EpiOut E{Fg.in[IN_XP + Fg.z], Fg.in[IN_XS + Fg.z], layer == 0 ? nullptr : (const float*)(Fg.ws + WS_XBUF), (float*)(Fg.ws + WS_XBUF), (bf16*)(Fg.ws + WS_HBUF),
                   (const float*)(Fg.ws + WS_MOD) + (size_t)layer * 3 * 3072, layer + 1 < DEPTH ? (const float*)(Fg.ws + WS_GN) + (size_t)(layer + 1) * 3 * 1024 : nullptr,
                   (float*)(Fg.ws + WS_CTL + CTL_SSQX) + (size_t)(layer + 1) * NTOK};
          pg8::gemm_phase<EpiOut, pg8::StaticOrder, true, true>(Fg.lds, g, S, E, Fg.wave); }
        GRID_BAR();
    }
    ph_final(F);
}

extern "C" void kernel_launch(void* const* d_in, const int* in_sizes, int n_in, void* d_out, int out_size, void* d_ws, size_t ws_size, hipStream_t stream) {
    static int grid = 0;
    if (grid == 0) {
        if (n_in != 23 || ws_size < WS_END) { fprintf(stderr, "kernel_launch: need 23 inputs and %zu bytes of workspace; got %d, %zu\n", (size_t)WS_END, n_in, ws_size); grid = -1; return; }
        int dev = 0, cus = 0;
        if (hipGetDevice(&dev) != hipSuccess || hipDeviceGetAttribute(&cus, hipDeviceAttributeMultiprocessorCount, dev) != hipSuccess) { grid = -1; return; }
        if (hipFuncSetAttribute((const void*)mega, hipFuncAttributeMaxDynamicSharedMemorySize, LDS_BYTES) != hipSuccess) { fprintf(stderr, "kernel_launch: hipFuncSetAttribute failed\n"); grid = -1; return; }
        grid = cus;
    }
    if (grid < 0) return;
    if (hipMemsetAsync((char*)d_ws + WS_CTL, 0, CTL_BYTES, stream) != hipSuccess) return;
    Args a{};
    for (int i = 0; i < 23; ++i) a.in[i] = (const float*)d_in[i];
    a.out = (float*)d_out; a.ws = (unsigned char*)d_ws;
    hipLaunchKernelGGL(mega, dim3(grid), dim3(512), LDS_BYTES, stream, a);
}
```

```cpp
#define DUP_MASK 0
#include <hip/hip_runtime.h>
#include <cstdio>
#include <cstdint>
namespace pg8 {
#define PG8_LAS __attribute__((address_space(3)))
typedef unsigned short bf16_t;
typedef short bf16x8 __attribute__((ext_vector_type(8)));
typedef float f32x4 __attribute__((ext_vector_type(4)));
typedef unsigned u32x4 __attribute__((ext_vector_type(4)));
constexpr int BM = 256, BK = 64, HALF = 128, HTB = HALF * BK * 2  , STAGE_BYTES = 8 * HTB, NXCD = 8, WGM = 8;

__host__ __device__ __forceinline__ int lds_byte(int r, int c) { const int st = (r >> 4) * 2 + (c >> 5), rr = r & 15, cc = c & 31, ob = rr * 64 + cc * 2; return st * 1024 + (ob ^ (((ob >> 9) & 1) << 5)); }
__host__ __device__ __forceinline__ void stage_rc(int b, int& R, int& C) { const int st = b / 1024, sb = b % 1024, swz = sb ^ (((sb >> 9) & 1) << 5); R = (st >> 1) * 16 + swz / 64; C = (st & 1) * 32 + (swz % 64) / 2; }
__host__ __device__ __forceinline__ int perm32(int rho) { const int n = rho >> 4, i = rho & 15; return 8 * (i >> 2) + 4 * n + (i & 3); }

struct Unit { int pm, pn; };
struct Gemm { const bf16_t* A; const bf16_t* Bt; int M, N, K; };

struct StaticOrder {
    int nM, nN, nwg, G, c;
    __host__ __device__ void init(int M, int N, int G_, int c_) { nM = M / BM; nN = N / BM; nwg = nM * nN; G = G_; c = c_; }
    __host__ __device__ bool next(int i, Unit& u) const {
        const long L = (long)i * G + c; if (L >= nwg) return false;
        int wgid = (int)L; { const int q = nwg / NXCD, r = nwg % NXCD, xcd = wgid % NXCD, off = wgid / NXCD; wgid = (xcd < r ? xcd * (q + 1) : r * (q + 1) + (xcd - r) * q) + off; }
        const int nig = WGM * nN, gid = wgid / nig, fm = gid * WGM, gsz = (nM - fm) < WGM ? (nM - fm) : WGM;
        u.pm = fm + ((wgid % nig) % gsz); u.pn = (wgid % nig) / gsz; return true;
    }
    __device__ __forceinline__ void a_ready(const Unit&) const {}
    __device__ __forceinline__ void done(const Unit&) const {}
};

__device__ __forceinline__ unsigned cvt_pk_bf16(float lo, float hi) { unsigned r; asm volatile("v_cvt_pk_bf16_f32 %0, %1, %2" : "=v"(r) : "v"(lo), "v"(hi)); return r; }
typedef float f32x2 __attribute__((ext_vector_type(2)));
__device__ __forceinline__ f32x2 gelu_pk(f32x2 v) {
    const f32x2 av = __builtin_elementwise_abs(v), d = av * 0.2316418882f + 1.0f;
    f32x2 t; t.x = __builtin_amdgcn_rcpf(d.x); t.y = __builtin_amdgcn_rcpf(d.y);
    f32x2 q = t * 0.5307027145f + (-0.7265760135f); q = q * t + 0.7107068705f; q = q * t + (-0.142248368f); q = q * t + 0.127414796f; q = q * t;
    const f32x2 s = (v * v) * (-0.72134752044f);
    f32x2 e; e.x = __builtin_amdgcn_exp2f(s.x); e.y = __builtin_amdgcn_exp2f(s.y);
    const f32x2 m = v * (q * e), r = v - m;
    f32x2 o; o.x = v.x < 0.f ? m.x : r.x; o.y = v.y < 0.f ? m.y : r.y; return o;
}

template <int ACT  > struct EpiBf16 {
    static constexpr bool PERM = true, AFTER_DRAIN = false, HAS_MID = false; static_assert(ACT == 0 || ACT == 1, "EpiBf16: ACT is 0 (none) or 1 (gelu_pk)");
    bf16_t* O; int ldc; const float* bias; int split_cols; size_t split_stride; float scale0;
    __device__ __forceinline__ void operator()(const f32x4 (&acc)[2][2][4][2], const Unit& u, int wr, int wc, int fr, int fq) const {
        const int row0 = u.pm * BM + wr * 64 + fr; int colt = u.pn * BM; bf16_t* base = O;
        float sc = 1.f; if (split_cols) { const int t = colt / split_cols; base += (size_t)t * split_stride; colt -= t * split_cols; if (t == 0) sc = scale0; }
        const int col0 = colt + wc * 32 + 8 * fq, bcol0 = u.pn * BM + wc * 32 + 8 * fq;
        f32x4 bv[2][2];
#pragma unroll
        for (int bj = 0; bj < 2; ++bj)
#pragma unroll
            for (int n = 0; n < 2; ++n) bv[bj][n] = bias ? *(const f32x4*)(bias + bcol0 + bj * HALF + 4 * n) : (f32x4){0.f, 0.f, 0.f, 0.f};
#pragma unroll
        for (int ai = 0; ai < 2; ++ai)
#pragma unroll
            for (int m = 0; m < 4; ++m) { bf16_t* rowp = base + (size_t)(row0 + ai * HALF + m * 16) * ldc + col0;
#pragma unroll
                for (int bj = 0; bj < 2; ++bj) { f32x4 v0 = acc[ai][bj][m][0] + bv[bj][0], v1 = acc[ai][bj][m][1] + bv[bj][1];
                    if (ACT == 1) { f32x2 a = gelu_pk((f32x2){v0[0], v0[1]}), b = gelu_pk((f32x2){v0[2], v0[3]}), c = gelu_pk((f32x2){v1[0], v1[1]}), d = gelu_pk((f32x2){v1[2], v1[3]});
                        v0 = (f32x4){a.x, a.y, b.x, b.y}; v1 = (f32x4){c.x, c.y, d.x, d.y}; }
                    v0 = v0 * sc; v1 = v1 * sc; u32x4 w; w.x = cvt_pk_bf16(v0[0], v0[1]); w.y = cvt_pk_bf16(v0[2], v0[3]); w.z = cvt_pk_bf16(v1[0], v1[1]); w.w = cvt_pk_bf16(v1[2], v1[3]);
                    *(u32x4*)(rowp + bj * HALF) = w; } }
    }
};
struct EpiF32 {
    static constexpr bool PERM = false, AFTER_DRAIN = false, HAS_MID = false;
    float* C; int ldc; const float* bias;
    __device__ __forceinline__ void operator()(const f32x4 (&acc)[2][2][4][2], const Unit& u, int wr, int wc, int fr, int fq) const {
        const int row0 = u.pm * BM + wr * 64 + fr, col0 = u.pn * BM + wc * 32 + 4 * fq;
        f32x4 bv[2][2];
#pragma unroll
        for (int bj = 0; bj < 2; ++bj)
#pragma unroll
            for (int n = 0; n < 2; ++n) bv[bj][n] = bias ? *(const f32x4*)(bias + col0 + bj * HALF + n * 16) : (f32x4){0.f, 0.f, 0.f, 0.f};
#pragma unroll
        for (int ai = 0; ai < 2; ++ai)
#pragma unroll
            for (int m = 0; m < 4; ++m) { float* rowp = C + (size_t)(row0 + ai * HALF + m * 16) * ldc + col0;
#pragma unroll
                for (int bj = 0; bj < 2; ++bj)
#pragma unroll
                    for (int n = 0; n < 2; ++n) *(f32x4*)(rowp + bj * HALF + n * 16) = acc[ai][bj][m][n] + bv[bj][n]; }
    }
};
template <class Epi, class Sched, bool ALIGN_EPI = false, bool SP2 = false>
__device__ __forceinline__ void gemm_phase(PG8_LAS unsigned char* lds, const Gemm g, const Sched& S, const Epi& E, int wave_id) {
    int tid_ = wave_id * 64 + (int)__builtin_amdgcn_mbcnt_hi(~0u, __builtin_amdgcn_mbcnt_lo(~0u, 0u)); asm volatile("" : "+v"(tid_));
    const int tid = tid_, wid = __builtin_amdgcn_readfirstlane(tid >> 6), lane = tid & 63, wr = wid >> 2, wc = wid & 3, fr = lane & 15, fq = lane >> 4;
    const int K = g.K, nt = K / BK;
    unsigned voffA[2], voffB[2];
#pragma unroll
    for (int i = 0; i < 2; ++i) { int R, C; stage_rc(tid * 16 + i * 8192, R, C); const int Rb = Epi::PERM ? ((R & ~31) + perm32(R & 31)) : R;
        voffA[i] = (unsigned)(R * K + C) * 2u; voffB[i] = (unsigned)(Rb * K + C) * 2u; }
    const size_t kstep = (size_t)(BK * 2);
    const size_t hstep = (size_t)HALF * K * 2;
    const size_t tstep = 2 * hstep;
    const unsigned ldsw = (unsigned)wid * 1024u;
    const int aoff = lds_byte(wr * 64 + fr, fq * 8), boff = lds_byte(wc * 32 + fr, fq * 8);
#define PG8_SA(b, h) (((b) * 2 + (h)) * HTB)
#define PG8_SB(b, h) ((4 + (b) * 2 + (h)) * HTB)
#define PG8_STAGE(bufoff, gbase, voff) do { _Pragma("unroll") for (int _i = 0; _i < 2; ++_i) \
        __builtin_amdgcn_global_load_lds((const unsigned*)((const char*)(gbase) + (voff)[_i]), (PG8_LAS unsigned*)(lds + (bufoff) + ldsw + _i * 8192), 16, 0, 0); } while (0)
#define PG8_LDA(dst, b, h) do { _Pragma("unroll") for (int m = 0; m < 4; ++m) _Pragma("unroll") for (int k = 0; k < 2; ++k) dst[m][k] = *(const PG8_LAS bf16x8*)(lds + PG8_SA(b, h) + aoff + m * 2048 + k * 1024); } while (0)
#define PG8_LDB(dst, b, h) do { _Pragma("unroll") for (int n = 0; n < 2; ++n) _Pragma("unroll") for (int k = 0; k < 2; ++k) dst[n][k] = *(const PG8_LAS bf16x8*)(lds + PG8_SB(b, h) + boff + n * 2048 + k * 1024); } while (0)
#define PG8_MMA(ai, bj, At, Bt) do { __builtin_amdgcn_s_setprio(1); _Pragma("unroll") for (int m = 0; m < 4; ++m) _Pragma("unroll") for (int n = 0; n < 2; ++n) _Pragma("unroll") for (int k = 0; k < 2; ++k) \
        acc[ai][bj][m][n] = __builtin_amdgcn_mfma_f32_16x16x32_bf16(Bt[n][k], At[m][k], acc[ai][bj][m][n], 0, 0, 0); __builtin_amdgcn_s_setprio(0); } while (0)
#define PG8_WAIT_V(n) asm volatile("s_waitcnt vmcnt(" #n ")" ::: "memory")
#define PG8_WAIT_L(n) asm volatile("s_waitcnt lgkmcnt(" #n ")" ::: "memory")
#define PG8_BAR __builtin_amdgcn_s_barrier()
#define PG8_SCHED __builtin_amdgcn_sched_barrier(0)
    Unit cur, nxt; int ui = 0;
    if (!S.next(0, cur)) return;
    f32x4 acc[2][2][4][2];
#pragma unroll
    for (int a = 0; a < 2; ++a)
#pragma unroll
        for (int b = 0; b < 2; ++b)
#pragma unroll
            for (int m = 0; m < 4; ++m)
#pragma unroll
                for (int n = 0; n < 2; ++n) acc[a][b][m][n] = (f32x4){0.f, 0.f, 0.f, 0.f};
    bf16x8 At[4][2], B0[2][2], B1[2][2];
    const char* cA = (const char*)g.A + (size_t)cur.pm * tstep; const char* cB = (const char*)g.Bt + (size_t)cur.pn * tstep;
    S.a_ready(cur);
    if constexpr (SP2) {
        PG8_STAGE(PG8_SB(0, 0), cB, voffB); PG8_STAGE(PG8_SB(0, 1), cB + hstep, voffB); PG8_STAGE(PG8_SA(0, 0), cA, voffA); PG8_STAGE(PG8_SA(0, 1), cA + hstep, voffA);
        if (wr == 1) PG8_BAR;
        PG8_WAIT_V(2); PG8_BAR;
        PG8_STAGE(PG8_SB(1, 0), cB + kstep, voffB); PG8_STAGE(PG8_SA(1, 0), cA + kstep, voffA); PG8_STAGE(PG8_SB(1, 1), cB + hstep + kstep, voffB);
        PG8_WAIT_V(6); PG8_BAR;
    } else {
        PG8_STAGE(PG8_SB(0, 0), cB, voffB); PG8_STAGE(PG8_SA(0, 0), cA, voffA); PG8_STAGE(PG8_SB(0, 1), cB + hstep, voffB); PG8_STAGE(PG8_SA(0, 1), cA + hstep, voffA);
        if (wr == 1) PG8_BAR;
        PG8_WAIT_V(4); PG8_BAR;
        PG8_STAGE(PG8_SB(1, 0), cB + kstep, voffB); PG8_STAGE(PG8_SA(1, 0), cA + kstep, voffA); PG8_STAGE(PG8_SB(1, 1), cB + hstep + kstep, voffB);
        PG8_WAIT_V(6); PG8_BAR;
    }
    for (;;) {
        const bool has_next = S.next(ui + 1, nxt);
        const char* nA = has_next ? (const char*)g.A + (size_t)nxt.pm * tstep : cA; const char* nB = has_next ? (const char*)g.Bt + (size_t)nxt.pn * tstep : cB;
        for (int t = 0; t < nt; t += 2) {
            const bool last = (t == nt - 2);
            const char* a1 = cA + (size_t)(t + 1) * kstep;
            const char* a2 = last ? nA : cA + (size_t)(t + 2) * kstep; const char* b2 = last ? nB : cB + (size_t)(t + 2) * kstep;
            const char* a3 = a2 + kstep; const char* b3 = b2 + kstep;
            if (last && has_next) S.a_ready(nxt);
            if constexpr (Epi::HAS_MID) { if (t == nt / 2) E.mid(acc, cur, wr, wc, fr, fq); }
            if constexpr (SP2) {
            PG8_LDB(B0, 0, 0); PG8_LDB(B1, 0, 1); PG8_SCHED; PG8_LDA(At, 0, 0); PG8_STAGE(PG8_SA(1, 1), a1 + hstep, voffA);
            PG8_WAIT_V(8); PG8_WAIT_L(0); PG8_BAR; PG8_MMA(0, 0, At, B0); PG8_MMA(0, 1, At, B1); PG8_BAR; PG8_SCHED;
            PG8_LDA(At, 0, 1); PG8_STAGE(PG8_SB(0, 0), b2, voffB); PG8_STAGE(PG8_SB(0, 1), b2 + hstep, voffB); PG8_STAGE(PG8_SA(0, 0), a2, voffA);
            PG8_WAIT_V(8); PG8_WAIT_L(0); PG8_BAR; PG8_MMA(1, 0, At, B0); PG8_MMA(1, 1, At, B1); PG8_BAR; PG8_SCHED;
            PG8_LDB(B0, 1, 0); PG8_LDB(B1, 1, 1); PG8_SCHED; PG8_LDA(At, 1, 0); PG8_STAGE(PG8_SA(0, 1), a2 + hstep, voffA);
            PG8_WAIT_V(8); PG8_WAIT_L(0); PG8_BAR; PG8_MMA(0, 0, At, B0); PG8_MMA(0, 1, At, B1); PG8_BAR; PG8_SCHED;
            PG8_LDA(At, 1, 1); PG8_STAGE(PG8_SB(1, 0), b3, voffB); PG8_STAGE(PG8_SB(1, 1), b3 + hstep, voffB); PG8_STAGE(PG8_SA(1, 0), a3, voffA);
            PG8_WAIT_V(8); PG8_WAIT_L(0); PG8_BAR; PG8_MMA(1, 0, At, B0); PG8_MMA(1, 1, At, B1); PG8_BAR; PG8_SCHED;
            } else {
            PG8_LDB(B0, 0, 0); PG8_SCHED; PG8_LDA(At, 0, 0); PG8_STAGE(PG8_SA(1, 1), a1 + hstep, voffA);
            PG8_WAIT_L(8); PG8_BAR; PG8_WAIT_L(0); PG8_MMA(0, 0, At, B0); PG8_BAR; PG8_SCHED;
            PG8_LDB(B1, 0, 1); PG8_STAGE(PG8_SB(0, 0), b2, voffB);
            PG8_BAR; PG8_WAIT_L(0); PG8_MMA(0, 1, At, B1); PG8_BAR;
            PG8_LDA(At, 0, 1); PG8_STAGE(PG8_SA(0, 0), a2, voffA);
            PG8_BAR; PG8_WAIT_L(0); PG8_MMA(1, 0, At, B0); PG8_BAR; PG8_SCHED;
            PG8_STAGE(PG8_SB(0, 1), b2 + hstep, voffB);
            PG8_WAIT_V(6); PG8_BAR; PG8_MMA(1, 1, At, B1); PG8_BAR;
            PG8_LDB(B0, 1, 0); PG8_SCHED; PG8_LDA(At, 1, 0); PG8_STAGE(PG8_SA(0, 1), a2 + hstep, voffA);
            PG8_WAIT_L(8); PG8_BAR; PG8_WAIT_L(0); PG8_MMA(0, 0, At, B0); PG8_BAR; PG8_SCHED;
            PG8_LDB(B1, 1, 1); PG8_STAGE(PG8_SB(1, 0), b3, voffB);
            PG8_BAR; PG8_WAIT_L(0); PG8_MMA(0, 1, At, B1); PG8_BAR;
            PG8_LDA(At, 1, 1); PG8_STAGE(PG8_SA(1, 0), a3, voffA);
            PG8_BAR; PG8_WAIT_L(0); PG8_MMA(1, 0, At, B0); PG8_BAR; PG8_SCHED;
            PG8_STAGE(PG8_SB(1, 1), b3 + hstep, voffB);
            PG8_WAIT_V(6); PG8_BAR; PG8_MMA(1, 1, At, B1); PG8_BAR;
            }
        }
        if constexpr (ALIGN_EPI) { if (wr == 0) PG8_BAR; }
        if constexpr (!Epi::AFTER_DRAIN) { E(acc, cur, wr, wc, fr, fq); S.done(cur); }
        if (!has_next) break;
#pragma unroll
        for (int a = 0; a < 2; ++a)
#pragma unroll
            for (int b = 0; b < 2; ++b)
#pragma unroll
                for (int m = 0; m < 4; ++m)
#pragma unroll
                    for (int n = 0; n < 2; ++n) acc[a][b][m][n] = (f32x4){0.f, 0.f, 0.f, 0.f};
        cur = nxt; cA = nA; cB = nB; ++ui;
        if constexpr (ALIGN_EPI) { if (wr == 1) PG8_BAR; }
    }
    PG8_WAIT_V(0);
    if constexpr (!ALIGN_EPI) { if (wr == 0) PG8_BAR; }
    PG8_BAR;
    if constexpr (Epi::AFTER_DRAIN) { E.fused(acc, cur, wr, wc, fr, fq, lds, wid, lane); S.done(cur); }
#undef PG8_SA
#undef PG8_SB
#undef PG8_STAGE
#undef PG8_LDA
#undef PG8_LDB
#undef PG8_MMA
#undef PG8_WAIT_V
#undef PG8_WAIT_L
#undef PG8_BAR
#undef PG8_SCHED
}
}

#define DEV __device__ __forceinline__
#define LAS __attribute__((address_space(3)))
typedef unsigned short bf16;
typedef float f32x4 __attribute__((ext_vector_type(4)));
typedef unsigned u32x4 __attribute__((ext_vector_type(4)));
typedef unsigned u32x2 __attribute__((ext_vector_type(2)));

constexpr int D = 1024, NTOK = 10240, NCTX = 8192, DEPTH = 4, NH = 16, HP = 64, NGRP = 4, NST = 128, DIN = 8224;
constexpr int NPROJ = 8192;
constexpr int NCHUNK = 80;
constexpr float EPS = 1e-6f;
constexpr int PC_XBC = 0, PC_ZM = 2048, PC_U = 3072, PC_V = 4096, PC_ZG = 5120, PC_GLM = 6144, PC_GLG = 7168;

constexpr size_t MiB = 1u << 20;
constexpr size_t WS_CTL = 0, CTL_BYTES = 2 * MiB;
constexpr size_t CTL_SSQ = 64 * 1024;
constexpr size_t CTL_SSQX = 256 * 1024;
constexpr size_t CTL_GSUM = 512 * 1024;
constexpr size_t CTL_SW = 1 * MiB;
constexpr size_t WS_MOD = 2 * MiB;
constexpr size_t WS_GN = WS_MOD + 256 * 1024;
constexpr size_t WS_WDT = WS_GN + 192 * 1024;
constexpr size_t WS_WSPB = 3 * MiB;
constexpr size_t WS_DTRAW = 4 * MiB;
constexpr size_t WS_WIN = 6 * MiB;
constexpr size_t WS_WMG = WS_WIN + 64 * MiB;
constexpr size_t WS_WO = WS_WMG + 16 * MiB;
constexpr size_t WS_HBUF = WS_WO + 8 * MiB;
constexpr size_t WS_AMG = WS_HBUF + 20 * MiB;
constexpr size_t WS_PROJ = WS_AMG + 40 * MiB;
constexpr size_t WS_XBUF = WS_PROJ + 160 * MiB;
constexpr size_t WS_MRG = WS_XBUF + 40 * MiB;
constexpr size_t WS_XBCS = WS_MRG + 20 * MiB;
constexpr size_t WS_SINB = WS_XBCS + 40 * MiB;
constexpr size_t WS_TB = WS_SINB + 40 * MiB;
constexpr int TBW = 1536;
constexpr size_t WS_END = WS_TB + 8 * MiB;

#ifndef DUP_MASK
#define DUP_MASK 0
#endif
constexpr size_t CTL_DUMMY = 1536 * 1024;
constexpr int LDS_BYTES = 155648;

DEV float bf2f(unsigned v) { return __uint_as_float(v << 16); }
DEV unsigned f2bf(float f) { unsigned u = __float_as_uint(f); return (u + 0x7fffu + ((u >> 16) & 1u)) >> 16; }
DEV unsigned pk2(float lo, float hi) { return f2bf(lo) | (f2bf(hi) << 16); }
DEV float sigmoid_f(float x) { return __builtin_amdgcn_rcpf(1.f + __expf(-x)); }
DEV float silu_f(float x) { return x * __builtin_amdgcn_rcpf(1.f + __expf(-x)); }
DEV float gelu_f(float x) { return x * sigmoid_f(1.5957691216f * (x + 0.044715f * x * x * x)); }
DEV float softplus_f(float x) { const float e = __expf(x); const float sm = e * (1.f - e * (0.5f - e * 0.33333333f)); return x > 20.f ? x : (e < 0.03f ? sm : __logf(1.f + e)); }
DEV float shfl_idx(float v, int src_lane) { return __int_as_float(__builtin_amdgcn_ds_bpermute(src_lane << 2, __float_as_int(v))); }
DEV float shfl_x(float v, int o, int lane) { return shfl_idx(v, lane ^ o); }
DEV float wave_sum(float v, int lane) {
#pragma unroll
    for (int o = 1; o < 64; o <<= 1) v += shfl_x(v, o, lane);
    return v;
}

struct Args { const float* in[23]; float* out; unsigned char* ws; int step_lo, step_hi; };

struct Frame {
    LAS unsigned char* lds;
    int tid, lane, wave, G, bid, z;
    const float* const* in;
    float* out; unsigned char* ws;
};
DEV Frame launder(const Frame& F0) {
    Frame F = F0;
    F.z = 0; asm volatile("" : "+s"(F.z), "+s"(F.out), "+s"(F.ws), "+s"(F.G), "+s"(F.bid), "+s"(F.wave));
    F.tid = F.wave * 64 + (int)__builtin_amdgcn_mbcnt_hi(~0u, __builtin_amdgcn_mbcnt_lo(~0u, 0u));
    asm volatile("" : "+v"(F.tid));
    F.lane = F.tid & 63;
    return F;
}
#define IN_XP 0
#define IN_XS 1
#define IN_STATE 2
#define IN_C 3
#define IN_CCTX 4
#define IN_WADA 5
#define IN_BADA 6
#define IN_NORMW 7
#define IN_WIN 8
#define IN_CONVW 9
#define IN_CONVB 10
#define IN_DTBIAS 11
#define IN_ALOG 12
#define IN_DSKIP 13
#define IN_SSMNW 14
#define IN_WOUTM 15
#define IN_LNW 16
#define IN_LNB 17
#define IN_WSP 18
#define IN_BSP 19
#define IN_WOUTG 20
#define IN_WOUT 21
#define IN_FNW 22

DEV int scan_to_row(int sr, int layer) {
    if (sr < NCTX || !(layer & 1)) return sr;
    const int lb = (sr - NCTX) >> 10, q = (sr - NCTX) & 1023;
    return NCTX + lb * 1024 + (q & 15) * 64 + (q >> 4);
}

DEV void ph_mod(const Frame& F0) {
    Frame F = launder(F0);
    LAS float* sc = (LAS float*)F.lds;
    LAS float* part = sc + 3 * 1024;
    for (int i = F.tid; i < 3 * 1024; i += 512) { const int v = i >> 10, k = i & 1023; const float c = v == 0 ? F.in[IN_CCTX + F.z][k] : F.in[IN_C + F.z][(v - 1) * 1024 + k]; sc[i] = silu_f(c); }
    __syncthreads();
    float* mod = (float*)(F.ws + WS_MOD);
    for (int it = F.bid; it < DEPTH * 96; it += F.G) {
        const int l = it / 96, jl = F.tid & 31, j = (it % 96) * 32 + jl, kq = F.tid >> 5;
        const float* w = F.in[IN_WADA + F.z] + (size_t)l * 1024 * 3072 + (size_t)(kq * 64) * 3072 + j;
        float wv[64];
#pragma unroll
        for (int k = 0; k < 64; ++k) wv[k] = w[(size_t)k * 3072];
        float a0 = 0.f, a1 = 0.f, a2 = 0.f;
#pragma unroll
        for (int k = 0; k < 64; ++k) { a0 += sc[kq * 64 + k] * wv[k]; a1 += sc[1024 + kq * 64 + k] * wv[k]; a2 += sc[2048 + kq * 64 + k] * wv[k]; }
        __syncthreads();
        part[(kq * 3 + 0) * 32 + jl] = a0; part[(kq * 3 + 1) * 32 + jl] = a1; part[(kq * 3 + 2) * 32 + jl] = a2;
        __syncthreads();
        if (F.tid < 96) { const int v = F.tid >> 5, jj = F.tid & 31, col = (it % 96) * 32 + jj; float t = F.in[IN_BADA + F.z][l * 3072 + col];
#pragma unroll
            for (int q = 0; q < 16; ++q) t += part[(q * 3 + v) * 32 + jj];
            mod[(l * 3 + v) * 3072 + col] = t; }
    }
}

DEV void cvt_item(const float* W, int ldw, int k0, int n0, bf16* WT, int ldt, int k0d, int drow0, LAS float* scr, int lane, const LAS float* shift3, float* sw3) {
    float wv_[32];
#pragma unroll
    for (int i = 0; i < 32; ++i) wv_[i] = W[(size_t)(k0 + 2 * i + (lane >> 5)) * ldw + n0 + (lane & 31)];
#pragma unroll
    for (int i = 0; i < 32; ++i) scr[(2 * i + (lane >> 5)) * 33 + (lane & 31)] = wv_[i];
    asm volatile("s_waitcnt lgkmcnt(0)" ::: "memory");
    const int c = lane & 7;
#pragma unroll
    for (int j = 0; j < 4; ++j) { const int n = (lane >> 3) + 8 * j; const LAS float* s = scr + (8 * c) * 33 + n;
        u32x4 o; o.x = pk2(s[0 * 33], s[1 * 33]); o.y = pk2(s[2 * 33], s[3 * 33]); o.z = pk2(s[4 * 33], s[5 * 33]); o.w = pk2(s[6 * 33], s[7 * 33]);
        *(u32x4*)(WT + (size_t)(drow0 + n) * ldt + k0d + 8 * c) = o; }
    if (shift3) {
        const int n = lane & 31, kh = (lane >> 5) * 32;
        float a0 = 0.f, a1 = 0.f, a2 = 0.f;
#pragma unroll 8
        for (int kk = 0; kk < 32; ++kk) { const float wv = scr[(kh + kk) * 33 + n]; a0 += shift3[k0 + kh + kk] * wv; a1 += shift3[1024 + k0 + kh + kk] * wv; a2 += shift3[2048 + k0 + kh + kk] * wv; }
        a0 += shfl_x(a0, 32, lane); a1 += shfl_x(a1, 32, lane); a2 += shfl_x(a2, 32, lane);
        if (lane < 32) { atomicAdd(sw3 + n0 + n, a0); atomicAdd(sw3 + DIN + n0 + n, a1); atomicAdd(sw3 + 2 * DIN + n0 + n, a2); }
    }
    asm volatile("s_waitcnt lgkmcnt(0)" ::: "memory");
}
DEV void ph_cvt(const Frame& F0, int l, int wg0, int nwg) {
    Frame F = launder(F0);
    asm volatile("" : "+s"(l));
    if (F.bid < wg0) return;
    LAS float* scr = (LAS float*)(F.lds + F.wave * 16384);
    LAS float* shl = (LAS float*)(F.lds + 8 * 16384);
    for (int i = F.tid; i < 3 * 1024; i += 512) shl[i] = ((const float*)(F.ws + WS_MOD))[(size_t)l * 3 * 3072 + (i >> 10) * 3072 + (i & 1023)];
    __syncthreads();
    const int gw = (F.bid - wg0) * 8 + F.wave, NGW = nwg * 8;
    constexpr int I_IN = 16 * 257, I_O = 16 * 32, PER_L = I_IN + 3 * I_O;
    for (int it = gw; it < PER_L; it += NGW) {
        int r = it;
        if (r < I_IN) { const int kb = r / 257, nb = r % 257;
            const LAS float* shift3 = shl;
            float* sw3 = (float*)(F.ws + WS_CTL + CTL_SW) + (size_t)l * 3 * DIN;
            if (nb == 96) cvt_item(F.in[IN_WIN + F.z] + (size_t)l * 1024 * DIN, DIN, 64 * kb, 3072, (bf16*)(F.ws + WS_WDT) + (size_t)l * 32 * 1024, 1024, 64 * kb, 0, scr, F.lane, shift3, sw3);
            else { const int c = 32 * nb;
                int drow;
                if (c < 3072) drow = c;
                else if (c < 4128) { const int cc = c - 3104; drow = (12 + (cc >> 7)) * 256 + (cc & 127); }
                else if (c < 5152) drow = 5120 + (c - 4128);
                else if (c < 6176) { const int cc = c - 5152; drow = (12 + (cc >> 7)) * 256 + 128 + (cc & 127); }
                else if (c < 7200) { const int cc = c - 6176; drow = (24 + (cc >> 7)) * 256 + (cc & 127); }
                else { const int cc = c - 7200; drow = (24 + (cc >> 7)) * 256 + 128 + (cc & 127); }
                cvt_item(F.in[IN_WIN + F.z] + (size_t)l * 1024 * DIN, DIN, 64 * kb, c, (bf16*)(F.ws + WS_WIN) + (size_t)l * NPROJ * 1024, 1024, 64 * kb, drow, scr, F.lane, shift3, sw3); }
            continue; }
        r -= I_IN;
        const int which = r / I_O; r %= I_O; const int kb = r >> 5, nb = r & 31;
        const float* W = (which == 0 ? F.in[IN_WOUTM + F.z] : which == 1 ? F.in[IN_WOUTG + F.z] : F.in[IN_WOUT + F.z]) + (size_t)l * 1024 * 1024;
        if (which < 2) cvt_item(W, 1024, 64 * kb, 32 * nb, (bf16*)(F.ws + WS_WMG) + (size_t)l * 1024 * 2048, 2048, which * 1024 + 64 * kb, 32 * nb, scr, F.lane, (const LAS float*)nullptr, nullptr);
        else cvt_item(W, 1024, 64 * kb, 32 * nb, (bf16*)(F.ws + WS_WO) + (size_t)l * 1024 * 1024, 1024, 64 * kb, 32 * nb, scr, F.lane, (const LAS float*)nullptr, nullptr);
    }
}
DEV void ph_gn(const Frame& F0) {
    Frame F = launder(F0);
    float* gn = (float*)(F.ws + WS_GN);
    for (int i = F.bid * 512 + F.tid; i < DEPTH * 3 * 1024; i += F.G * 512) { const int c = i & 1023, lv = i >> 10, l = lv / 3;
        gn[i] = F.in[IN_NORMW + F.z][l * 1024 + c] * (1.f + ((const float*)(F.ws + WS_MOD))[lv * 3072 + 1024 + c]); }
    const f32x4* wsp = (const f32x4*)F.in[IN_WSP + F.z]; u32x2* wb = (u32x2*)(F.ws + WS_WSPB);
    for (int i = F.bid * 512 + F.tid; i < DEPTH * 8 * 128 * 128 / 4; i += F.G * 512) { const f32x4 w = wsp[i]; u32x2 o; o.x = pk2(w.x, w.y); o.y = pk2(w.z, w.w); wb[i] = o; }
}

DEV void ph_prep0(const Frame& F0) {
    Frame F = launder(F0);
    const int gw = F.bid * 8 + F.wave, NGW = F.G * 8;
    const float* nw = F.in[IN_NORMW + F.z];
    float* ssqx = (float*)(F.ws + WS_CTL + CTL_SSQX);
    for (int row = gw; row < NTOK; row += NGW) {
        const int mv = row < NCTX ? 0 : 1 + ((row - NCTX) >> 10);
        const float* md = (const float*)(F.ws + WS_MOD) + mv * 3072;
        const f32x4* xr = (const f32x4*)(row < NCTX ? F.in[IN_XP + F.z] + (size_t)row * D : F.in[IN_XS + F.z] + (size_t)(row - NCTX) * D) + F.lane;
        f32x4 v[4]; float s = 0.f;
#pragma unroll
        for (int j = 0; j < 4; ++j) { v[j] = xr[64 * j]; s += (v[j].x * v[j].x + v[j].y * v[j].y) + (v[j].z * v[j].z + v[j].w * v[j].w); }
        s = wave_sum(s, F.lane);
        if (F.lane == 0) ssqx[row] = s;
        unsigned long long* o8 = (unsigned long long*)((bf16*)(F.ws + WS_HBUF) + (size_t)row * D) + F.lane;
#pragma unroll
        for (int j = 0; j < 4; ++j) { const int c0 = 4 * (F.lane + 64 * j);
            const f32x4 w4 = *(const f32x4*)(nw + c0), sc = *(const f32x4*)(md + 1024 + c0);
            v[j] = v[j] * w4 * (sc + 1.f);
            o8[64 * j] = (unsigned long long)pk2(v[j].x, v[j].y) | ((unsigned long long)pk2(v[j].z, v[j].w) << 32); }
    }
}

DEV void ph_final(const Frame& F0) {
    Frame F = launder(F0);
    const int gw = F.bid * 8 + F.wave, NGW = F.G * 8;
    const float* nw = F.in[IN_FNW + F.z];
    const float* ssqx = (const float*)(F.ws + WS_CTL + CTL_SSQX) + 4 * NTOK;
    for (int row = gw; row < NTOK; row += NGW) {
        const f32x4* xr = (const f32x4*)((const float*)(F.ws + WS_XBUF) + (size_t)row * D) + F.lane;
        const float rstd = rsqrtf(ssqx[row] * (1.f / D) + EPS);
        f32x4* o = (f32x4*)(F.out + (size_t)row * D) + F.lane;
#pragma unroll
        for (int j = 0; j < 4; ++j) o[64 * j] = xr[64 * j] * rstd * *(const f32x4*)(nw + 4 * (F.lane + 64 * j));
    }
}

typedef short bf16x8 __attribute__((ext_vector_type(8)));
typedef short s16x4 __attribute__((ext_vector_type(4)));
typedef float f32x16 __attribute__((ext_vector_type(16)));
typedef float f32x2 __attribute__((ext_vector_type(2)));
typedef __bf16 bf16x2_t __attribute__((ext_vector_type(2)));
#define MFMA32(a, b, c) __builtin_amdgcn_mfma_f32_32x32x16_bf16((a), (b), (c), 0, 0, 0)
DEV unsigned pkbf(float a, float b) { const f32x2 v = {a, b}; return __builtin_bit_cast(unsigned, __builtin_convertvector(v, bf16x2_t)); }
DEV bf16x8 pack8(float a0, float a1, float a2, float a3, float a4, float a5, float a6, float a7) {
    u32x4 p; p.x = pkbf(a0, a1); p.y = pkbf(a2, a3); p.z = pkbf(a4, a5); p.w = pkbf(a6, a7); return __builtin_bit_cast(bf16x8, p); }
DEV int crow(int r, int hh) { return (r & 3) + 8 * (r >> 2) + 4 * hh; }

struct ChunkGeo { int seq_row0, pos0, L; bool cm; };
DEV ChunkGeo chunk_geo(int ck, int layer) {
    ChunkGeo g;
    if (ck < 64) { g.seq_row0 = (ck >> 1) * 256; g.pos0 = (ck & 1) * 128; g.L = 256; g.cm = false; }
    else { const int lb = (ck - 64) >> 3; g.seq_row0 = NCTX + lb * 1024; g.pos0 = ((ck - 64) & 7) * 128; g.L = 1024; g.cm = (layer & 1) != 0; }
    return g;
}
DEV int geo_row(const ChunkGeo& g, int Q) { return g.seq_row0 + (g.cm ? (Q & 15) * 64 + (Q >> 4) : Q); }

DEV void chunk_tables2(Frame& F, int layer, const ChunkGeo& geo, int h, LAS float* tb) {
    if (F.wave < 2) {
        const int dir = F.wave;
        const float a = -__expf(F.in[IN_ALOG + F.z][layer * 32 + dir * 16 + h]);
        const float bias = F.in[IN_DTBIAS + F.z][layer * 32 + dir * 16 + h];
        const float* dtr = (const float*)(F.ws + WS_DTRAW);
        const int q0 = 2 * F.lane;
        const float d0 = softplus_f(dtr[(size_t)geo_row(geo, geo.pos0 + q0) * 32 + dir * 16 + h] + bias);
        const float d1 = softplus_f(dtr[(size_t)geo_row(geo, geo.pos0 + q0 + 1) * 32 + dir * 16 + h] + bias);
        const float a0 = d0 * a, a1 = d1 * a;
        float sc = a0 + a1, c0, c1, tot;
        if (dir == 0) {
#pragma unroll
            for (int o = 1; o < 64; o <<= 1) { const float t = shfl_idx(sc, (F.lane - o) & 63); if (F.lane >= o) sc += t; }
            c1 = sc; c0 = sc - a1; tot = shfl_idx(c1, 63);
        } else {
#pragma unroll
            for (int o = 1; o < 64; o <<= 1) { const float t = shfl_idx(sc, (F.lane + o) & 63); if (F.lane + o < 64) sc += t; }
            c0 = sc; c1 = sc - a0; tot = shfl_idx(c0, 0);
        }
        LAS float* t = tb + dir * 128 + q0;
        t[0] = c0; t[1] = c1; t[256] = d0; t[257] = d1; t[512] = __expf(c0); t[513] = __expf(c1);
        t[768] = d0 * __expf(tot - c0); t[769] = d1 * __expf(tot - c1);
    }
    __syncthreads();
}

template <int NC, int MODE>
DEV void stage_conv(Frame& F, int layer, const ChunkGeo& geo, int col0, LAS unsigned char* img0, LAS unsigned char* img1, int pitch, const LAS float* tb, bf16* gdst = nullptr) {
    constexpr int CG = NC / 8, NT = CG * 32;
    if (F.tid < NT) {
        const int cg = F.tid % CG, tg = F.tid / CG, ch0 = col0 + cg * 8, q0 = tg * 4;
        const bf16* proj = (const bf16*)(F.ws + WS_PROJ);
        float x[8][8];
#pragma unroll
        for (int i = 0; i < 8; ++i) {
            const int Q = geo.pos0 + q0 - 2 + i;
            u32x4 raw = {0u, 0u, 0u, 0u};
            if (Q >= 0 && Q < geo.L) raw = *(const u32x4*)(proj + (size_t)geo_row(geo, Q) * NPROJ + PC_XBC + ch0);
            x[i][0] = bf2f(raw.x & 0xffffu); x[i][1] = bf2f(raw.x >> 16); x[i][2] = bf2f(raw.y & 0xffffu); x[i][3] = bf2f(raw.y >> 16);
            x[i][4] = bf2f(raw.z & 0xffffu); x[i][5] = bf2f(raw.z >> 16); x[i][6] = bf2f(raw.w & 0xffffu); x[i][7] = bf2f(raw.w >> 16);
        }
        const float* cw = F.in[IN_CONVW + F.z] + layer * 5 * 2048 + ch0; const float* cb = F.in[IN_CONVB + F.z] + layer * 2048 + ch0;
        float acc[4][8];
        { const f32x4 b0 = *(const f32x4*)cb, b1 = *(const f32x4*)(cb + 4);
#pragma unroll
          for (int t = 0; t < 4; ++t) { acc[t][0] = b0.x; acc[t][1] = b0.y; acc[t][2] = b0.z; acc[t][3] = b0.w; acc[t][4] = b1.x; acc[t][5] = b1.y; acc[t][6] = b1.z; acc[t][7] = b1.w; } }
#pragma unroll
        for (int k = 0; k < 5; ++k) {
            const f32x4 w0 = *(const f32x4*)(cw + k * 2048), w1 = *(const f32x4*)(cw + k * 2048 + 4);
            const float w[8] = {w0.x, w0.y, w0.z, w0.w, w1.x, w1.y, w1.z, w1.w};
#pragma unroll
            for (int t = 0; t < 4; ++t)
#pragma unroll
                for (int c = 0; c < 8; ++c) acc[t][c] += w[c] * x[t + k][c];
        }
#pragma unroll
        for (int t = 0; t < 4; ++t) {
            float v[8];
#pragma unroll
            for (int c = 0; c < 8; ++c) v[c] = silu_f(acc[t][c]);
            const int s = q0 + t;
            if (MODE == 0) {
                u32x4 o; o.x = pkbf(v[0], v[1]); o.y = pkbf(v[2], v[3]); o.z = pkbf(v[4], v[5]); o.w = pkbf(v[6], v[7]);
                *(LAS u32x4*)(img0 + s * pitch + cg * 16) = o;
            } else if (MODE == 2) {
                u32x4 o; o.x = pkbf(v[0], v[1]); o.y = pkbf(v[2], v[3]); o.z = pkbf(v[4], v[5]); o.w = pkbf(v[6], v[7]);
                *(u32x4*)(gdst + (size_t)s * 2048 + cg * 8) = o;
            } else {
                const float sf = tb[768 + s], sb = tb[896 + s];
                u32x4 o; o.x = pkbf(v[0] * sf, v[1] * sf); o.y = pkbf(v[2] * sf, v[3] * sf); o.z = pkbf(v[4] * sf, v[5] * sf); o.w = pkbf(v[6] * sf, v[7] * sf);
                *(LAS u32x4*)(img0 + s * pitch + cg * 16) = o;
                o.x = pkbf(v[0] * sb, v[1] * sb); o.y = pkbf(v[2] * sb, v[3] * sb); o.z = pkbf(v[4] * sb, v[5] * sb); o.w = pkbf(v[6] * sb, v[7] * sb);
                *(LAS u32x4*)(img1 + s * pitch + cg * 16) = o;
            }
        }
    }
}

DEV bf16x8 tr2(const LAS unsigned char* img, int pitch, int row0, int row1, int col0, int lane) {
    const int i = lane & 15, blk = (lane >> 4) & 1;
    const int off = (i >> 2) * pitch + (col0 + 16 * blk + 4 * (i & 3)) * 2;
    const s16x4 lo = __builtin_amdgcn_ds_read_tr16_b64_v4i16((LAS s16x4*)(img + row0 * pitch + off));
    const s16x4 hi = __builtin_amdgcn_ds_read_tr16_b64_v4i16((LAS s16x4*)(img + row1 * pitch + off));
    return __builtin_shufflevector(lo, hi, 0, 1, 2, 3, 4, 5, 6, 7);
}

DEV void conv_unit(Frame& F, int layer, int ck, int j16) {
    const ChunkGeo geo = chunk_geo(ck, layer);
    if (F.wave < 2) {
        const int dir = F.wave & 1, h = j16;
        const float a = -__expf(F.in[IN_ALOG + F.z][layer * 32 + dir * 16 + h]);
        const float bias = F.in[IN_DTBIAS + F.z][layer * 32 + dir * 16 + h];
        const float* dtr = (const float*)(F.ws + WS_DTRAW);
        const int q0 = 2 * F.lane;
        const float d0 = softplus_f(dtr[(size_t)geo_row(geo, geo.pos0 + q0) * 32 + dir * 16 + h] + bias);
        const float d1 = softplus_f(dtr[(size_t)geo_row(geo, geo.pos0 + q0 + 1) * 32 + dir * 16 + h] + bias);
        const float a0 = d0 * a, a1 = d1 * a;
        float sc = a0 + a1, c0, c1, tot;
        if (dir == 0) {
#pragma unroll
            for (int o = 1; o < 64; o <<= 1) { const float t = shfl_idx(sc, (F.lane - o) & 63); if (F.lane >= o) sc += t; }
            c1 = sc; c0 = sc - a1; tot = shfl_idx(c1, 63);
        } else {
#pragma unroll
            for (int o = 1; o < 64; o <<= 1) { const float t = shfl_idx(sc, (F.lane + o) & 63); if (F.lane + o < 64) sc += t; }
            c0 = sc; c1 = sc - a0; tot = shfl_idx(c0, 0);
        }
        float* tbase = (float*)(F.ws + WS_TB) + (size_t)(ck * 16 + h) * TBW;
        *(f32x2*)(tbase + q0 * 4 + dir * 2) = (f32x2){c0, d0}; *(f32x2*)(tbase + (q0 + 1) * 4 + dir * 2) = (f32x2){c1, d1};
        float* t = tbase + dir * 128 + q0;
        *(f32x2*)(t + 512) = (f32x2){__expf(c0), __expf(c1)};
        *(f32x2*)(t + 768) = (f32x2){d0 * __expf(tot - c0), d1 * __expf(tot - c1)};
        const float cbs = shfl_idx(c0, F.lane & ~15), cbe = shfl_idx(c1, F.lane | 15);
        if (dir == 0) { *(f32x2*)(t + 1024) = (f32x2){d0 * __expf(cbe - c0), d1 * __expf(cbe - c1)}; *(f32x2*)(t + 1280) = (f32x2){__expf(c0 - cbs), __expf(c1 - cbs)}; }
        else          { *(f32x2*)(t + 1024) = (f32x2){d0 * __expf(cbs - c0), d1 * __expf(cbs - c1)}; *(f32x2*)(t + 1280) = (f32x2){__expf(c0 - cbe), __expf(c1 - cbe)}; }
    }
    bf16* dst = (bf16*)(F.ws + WS_XBCS) + (size_t)ck * 128 * 2048;
    stage_conv<128, 2>(F, layer, geo, j16 * 128, nullptr, nullptr, 0, nullptr, dst + j16 * 128);
}
DEV void ph_b0(const Frame& F0, int layer) {
    Frame F = launder(F0);
    asm volatile("" : "+s"(layer));
    for (int it = F.bid; it < NCHUNK * 16; it += F.G) { Frame Fi = launder(F); conv_unit(Fi, layer, it >> 4, it & 15); }
}

struct S1Regs { u32x4 bq[4], xq[2]; float wf[2], wb[2], atF, atB; };
DEV void s1_load(Frame& F, int ck, int h, S1Regs& R) {
    const bf16* xc = (const bf16*)(F.ws + WS_XBCS) + (size_t)ck * 128 * 2048;
    const float* T = (const float*)(F.ws + WS_TB) + (size_t)(ck * 16 + h) * TBW;
    { const int ch = F.tid & 15, r0 = F.tid >> 4;
#pragma unroll
      for (int p = 0; p < 4; ++p) R.bq[p] = *(const u32x4*)(xc + (size_t)(r0 + 32 * p) * 2048 + 1024 + (h >> 2) * 128 + ch * 8); }
    { const int ch = F.tid & 7, r0 = F.tid >> 3;
#pragma unroll
      for (int p = 0; p < 2; ++p) { const int row = r0 + 64 * p; R.xq[p] = *(const u32x4*)(xc + (size_t)row * 2048 + h * 64 + ch * 8); R.wf[p] = T[768 + row]; R.wb[p] = T[896 + row]; } }
    R.atF = T[127 * 4]; R.atB = T[2];
}
DEV void s1_store(Frame& F, const S1Regs& R, LAS unsigned char* Bi, LAS unsigned char* XF, LAS unsigned char* XB) {
    { const int ch = F.tid & 15, r0 = F.tid >> 4;
#pragma unroll
      for (int p = 0; p < 4; ++p) *(LAS u32x4*)(Bi + (r0 + 32 * p) * 320 + ch * 16) = R.bq[p]; }
    { const int ch = F.tid & 7, r0 = F.tid >> 3;
#pragma unroll
      for (int p = 0; p < 2; ++p) { const int row = r0 + 64 * p; const u32x4 r = R.xq[p]; const float wf = R.wf[p], wb = R.wb[p];
          const float v[8] = {bf2f(r.x & 0xffffu), bf2f(r.x >> 16), bf2f(r.y & 0xffffu), bf2f(r.y >> 16), bf2f(r.z & 0xffffu), bf2f(r.z >> 16), bf2f(r.w & 0xffffu), bf2f(r.w >> 16)};
          u32x4 o; o.x = pkbf(v[0] * wf, v[1] * wf); o.y = pkbf(v[2] * wf, v[3] * wf); o.z = pkbf(v[4] * wf, v[5] * wf); o.w = pkbf(v[6] * wf, v[7] * wf);
          *(LAS u32x4*)(XF + row * 192 + ch * 16) = o;
          o.x = pkbf(v[0] * wb, v[1] * wb); o.y = pkbf(v[2] * wb, v[3] * wb); o.z = pkbf(v[4] * wb, v[5] * wb); o.w = pkbf(v[6] * wb, v[7] * wb);
          *(LAS u32x4*)(XB + row * 192 + ch * 16) = o; } }
}
DEV void sin_store(Frame& F, const f32x16& S, int ck, int h, int dir, int wpi, int wni) {
    bf16* o = (bf16*)(F.ws + WS_SINB) + ((size_t)(ck * 16 + h) * 2 + dir) * 8192 + (32 * wpi) * 128 + 32 * wni + (F.lane & 31);
    const int hh = F.lane >> 5;
#pragma unroll
    for (int r = 0; r < 16; r += 2) { const unsigned w = pkbf(S[r], S[r + 1]); o[crow(r, hh) * 128] = (bf16)(w & 0xffffu); o[crow(r + 1, hh) * 128] = (bf16)(w >> 16); }
}
DEV void s1_ctx_unit(Frame& F, int layer, int seq, int h) {
    LAS unsigned char* Bi = F.lds + 4096; LAS unsigned char* XF = Bi + 128 * 320; LAS unsigned char* XB = XF + 128 * 192;
    const int hh = F.lane >> 5, wpi = F.wave >> 2, wni = F.wave & 3;
    f32x16 sf[2], sb[2]; float aF[2], aB[2];
    S1Regs R;
    s1_load(F, 2 * seq, h, R);
#pragma unroll
    for (int c = 0; c < 2; ++c) {
        __syncthreads();
        s1_store(F, R, Bi, XF, XB);
        aF[c] = R.atF; aB[c] = R.atB;
        __syncthreads();
        if (c == 0) s1_load(F, 2 * seq + 1, h, R);
#pragma unroll
        for (int r = 0; r < 16; ++r) { sf[c][r] = 0.f; sb[c][r] = 0.f; }
#pragma unroll
        for (int ks = 0; ks < 8; ++ks) {
            const int k0 = 16 * ks + 8 * hh;
            const bf16x8 b = tr2(Bi, 320, k0, k0 + 4, 32 * wni, F.lane);
            const bf16x8 xf = tr2(XF, 192, k0, k0 + 4, 32 * wpi, F.lane);
            const bf16x8 xb = tr2(XB, 192, k0, k0 + 4, 32 * wpi, F.lane);
            sf[c] = MFMA32(xf, b, sf[c]); sb[c] = MFMA32(xb, b, sb[c]);
        }
    }
    sin_store(F, sf[0], 2 * seq + 1, h, 0, wpi, wni);
    sin_store(F, sb[1], 2 * seq, h, 1, wpi, wni);
    const float eF = __expf(aF[1]), eB = __expf(aB[0]);
    float* o = F.out + (size_t)10485760 + ((size_t)((seq * 4 + layer) * 2) * 16 + h) * 8192 + (32 * wpi) * 128 + 32 * wni + (F.lane & 31);
#pragma unroll
    for (int r = 0; r < 16; ++r) { const int p = crow(r, hh); o[p * 128] = eF * sf[0][r] + sf[1][r]; o[(size_t)16 * 8192 + p * 128] = eB * sb[1][r] + sb[0][r]; }
}
DEV void s1_lat_unit(Frame& F, int layer, int lb, int h, int dir) {
    LAS unsigned char* Bi = F.lds + 4096; LAS unsigned char* XF = Bi + 128 * 320; LAS unsigned char* XB = XF + 128 * 192;
    const int hh = F.lane >> 5, wpi = F.wave >> 2, wni = F.wave & 3;
    const LAS unsigned char* XA = dir ? XB : XF;
    S1Regs R;
    s1_load(F, 64 + 8 * lb + (dir ? 7 : 0), h, R);
    f32x16 S;
    { const float* s0 = F.in[IN_STATE + F.z] + ((size_t)((lb * 4 + layer) * 2 + dir) * 16 + h) * 8192 + (32 * wpi) * 128 + 32 * wni + (F.lane & 31);
#pragma unroll
      for (int r = 0; r < 16; ++r) S[r] = s0[crow(r, hh) * 128]; }
#pragma unroll 1
    for (int i = 0; i < 8; ++i) {
        const int ck = 64 + 8 * lb + (dir ? 7 - i : i);
        sin_store(F, S, ck, h, dir, wpi, wni);
        if (i == 7) break;
        __syncthreads();
        s1_store(F, R, Bi, XF, XB);
        const float e = __expf(dir ? R.atB : R.atF);
        __syncthreads();
        if (i < 6) s1_load(F, 64 + 8 * lb + (dir ? 6 - i : i + 1), h, R);
        f32x16 st;
#pragma unroll
        for (int r = 0; r < 16; ++r) st[r] = 0.f;
#pragma unroll
        for (int ks = 0; ks < 8; ++ks) {
            const int k0 = 16 * ks + 8 * hh;
            const bf16x8 b = tr2(Bi, 320, k0, k0 + 4, 32 * wni, F.lane);
            const bf16x8 xa = tr2(XA, 192, k0, k0 + 4, 32 * wpi, F.lane);
            st = MFMA32(xa, b, st);
        }
#pragma unroll
        for (int r = 0; r < 16; ++r) S[r] = e * S[r] + st[r];
    }
}

template <int NC>
DEV void stage_copy(Frame& F, const bf16* src, LAS unsigned char* img, int pitch) {
    constexpr int CPR = NC / 8, RPP = 512 / CPR;
    const int ch = F.tid % CPR, r0 = F.tid / CPR;
#pragma unroll
    for (int p = 0; p < 128 / RPP; ++p) { const int row = r0 + p * RPP; *(LAS u32x4*)(img + row * pitch + ch * 16) = *(const u32x4*)(src + (size_t)row * 2048 + ch * 8); }
}

struct S2Head { u32x4 xq[2], sq[4]; };
DEV void s2_head_load(Frame& F, const ChunkGeo& geo, int ck, int h, S2Head& H) {
    const bool nzf = ck >= 64 || (ck & 1) == 1, nzb = ck >= 64 || (ck & 1) == 0;
    const bf16* xc = (const bf16*)(F.ws + WS_XBCS) + (size_t)ck * 128 * 2048;
    { const int ch = F.tid & 7, r0 = F.tid >> 3;
#pragma unroll
      for (int p = 0; p < 2; ++p) H.xq[p] = *(const u32x4*)(xc + (size_t)(r0 + 64 * p) * 2048 + h * 64 + ch * 8); }
    { const bf16* S = (const bf16*)(F.ws + WS_SINB) + (size_t)(ck * 16 + h) * 2 * 8192;
      const int ch = F.tid & 15, r0 = F.tid >> 4;
#pragma unroll
      for (int p = 0; p < 4; ++p) { H.sq[p] = (u32x4){0u, 0u, 0u, 0u}; if (p < 2 ? nzf : nzb) H.sq[p] = *(const u32x4*)(S + (size_t)(r0 + 32 * p) * 128 + ch * 8); } }
}
DEV void s2_head_store(Frame& F, const S2Head& H, LAS unsigned char* Xi, LAS unsigned char* Si) {
    { const int ch = F.tid & 7, r0 = F.tid >> 3;
#pragma unroll
      for (int p = 0; p < 2; ++p) *(LAS u32x4*)(Xi + (r0 + 64 * p) * 192 + ch * 16) = H.xq[p]; }
    { const int ch = F.tid & 15, r0 = F.tid >> 4;
#pragma unroll
      for (int p = 0; p < 4; ++p) *(LAS u32x4*)(Si + (r0 + 32 * p) * 272 + ch * 16) = H.sq[p]; }
}
DEV void s2_unit(Frame& F, int layer, int ck, int g, int hp, bool dummy) {
    LAS float* tb0 = (LAS float*)F.lds;
    LAS unsigned char* Ci = F.lds + 12288;
    LAS unsigned char* Bi = Ci + 128 * 272;
    LAS unsigned char* Xi = Bi + 128 * 272;
    LAS unsigned char* Si = Xi + 128 * 192;
    LAS unsigned char* stg = Ci;
    bf16* AM = (bf16*)(F.ws + WS_AMG);
    float* SSQ = dummy ? (float*)(F.ws + WS_CTL + CTL_DUMMY) : (float*)(F.ws + WS_CTL + CTL_SSQ) + layer * NTOK;
    const int hh = F.lane >> 5, li = F.wave & 3, sh = F.wave >> 2, l31 = F.lane & 31, l = 32 * li + l31;
    const ChunkGeo geo = chunk_geo(ck, layer);
    const bool has_in = ck >= 64 || (ck & 1) == (sh ^ 1);
    S2Head H;
    {
        const bf16* xc = (const bf16*)(F.ws + WS_XBCS) + (size_t)ck * 128 * 2048;
        u32x4 cq[4], bq[4];
        { const int ch = F.tid & 15, r0 = F.tid >> 4;
#pragma unroll
          for (int p = 0; p < 4; ++p) { cq[p] = *(const u32x4*)(xc + (size_t)(r0 + 32 * p) * 2048 + 1536 + g * 128 + ch * 8); bq[p] = *(const u32x4*)(xc + (size_t)(r0 + 32 * p) * 2048 + 1024 + g * 128 + ch * 8); } }
        const u32x4* tsrc = (const u32x4*)((const float*)(F.ws + WS_TB) + (size_t)(ck * 16 + 4 * g + 2 * hp) * TBW);
        const u32x4 tq = tsrc[F.tid]; u32x4 tq2 = {0u, 0u, 0u, 0u}; if (F.tid < 256) tq2 = tsrc[512 + F.tid];
        s2_head_load(F, geo, ck, 4 * g + 2 * hp, H);
        { const int ch = F.tid & 15, r0 = F.tid >> 4;
#pragma unroll
          for (int p = 0; p < 4; ++p) { *(LAS u32x4*)(Ci + (r0 + 32 * p) * 272 + ch * 16) = cq[p]; *(LAS u32x4*)(Bi + (r0 + 32 * p) * 272 + ch * 16) = bq[p]; } }
        *(LAS u32x4*)(tb0 + F.tid * 4) = tq; if (F.tid < 256) *(LAS u32x4*)(tb0 + 2048 + F.tid * 4) = tq2;
        s2_head_store(F, H, Xi, Si);
    }
    __syncthreads();
    bf16x8 cf[8];
#pragma unroll
    for (int ks = 0; ks < 8; ++ks) cf[ks] = *(const LAS bf16x8*)(Ci + l * 272 + (16 * ks + 8 * hh) * 2);
    f32x16 gt[2];
#pragma unroll
    for (int sj = 0; sj < 2; ++sj) {
#pragma unroll
        for (int r = 0; r < 16; ++r) gt[sj][r] = 0.f;
#pragma unroll
        for (int ks = 0; ks < 8; ++ks) { const bf16x8 a = *(const LAS bf16x8*)(Bi + (32 * (2 * sh + sj) + l31) * 272 + (16 * ks + 8 * hh) * 2); gt[sj] = MFMA32(a, cf[ks], gt[sj]); }
    }
#pragma unroll 1
    for (int j = 0; j < 2; ++j) {
        const int h = 4 * g + 2 * hp + j;
        const LAS float* tb = tb0 + TBW * j;
        u32x2 zq[4];
#pragma unroll
        for (int v = 0; v < 4; ++v) zq[v] = *(const u32x2*)((const bf16*)(F.ws + WS_PROJ) + (size_t)geo_row(geo, geo.pos0 + F.wave * 16 + 4 * v + (F.lane >> 4)) * NPROJ + PC_ZM + h * 64 + 4 * (F.lane & 15));
        if (j == 0) s2_head_load(F, geo, ck, h + 1, H);
        const float dsk = F.in[IN_DSKIP + F.z][layer * 16 + h];
        const float acFl = tb[4 * l], acBl = tb[4 * l + 2];
        f32x16 accd[2];
#pragma unroll
        for (int r = 0; r < 16; ++r) { accd[0][r] = 0.f; accd[1][r] = 0.f; }
        if (has_in) {
#pragma unroll
            for (int pi = 0; pi < 2; ++pi) {
#pragma unroll
                for (int ks = 0; ks < 8; ++ks) { const bf16x8 sb = *(const LAS bf16x8*)(Si + sh * (64 * 272) + (32 * pi + l31) * 272 + (16 * ks + 8 * hh) * 2); accd[pi] = MFMA32(cf[ks], sb, accd[pi]); }
#pragma unroll
                for (int r = 0; r < 16; ++r) accd[pi][r] *= tb[512 + sh * 128 + 32 * li + crow(r, hh)];
            }
        }
#pragma unroll
        for (int sj = 0; sj < 2; ++sj) {
            const int si = 2 * sh + sj;
            float m[16];
            if (si != li) {
                const int dofs = si < li ? 0 : 128;
                const float f2 = si < li ? __expf(tb[4 * (32 * li)] - tb[4 * (32 * si + 31)]) : __expf(tb[4 * (32 * li + 31) + 2] - tb[4 * (32 * si) + 2]);
                const float c = tb[1280 + dofs + l] * f2;
#pragma unroll
                for (int q4 = 0; q4 < 4; ++q4) { const f32x4 gs = *(const LAS f32x4*)(tb + 1024 + dofs + 32 * si + 8 * q4 + 4 * hh);
                    m[4 * q4] = gt[sj][4 * q4] * (c * gs.x); m[4 * q4 + 1] = gt[sj][4 * q4 + 1] * (c * gs.y); m[4 * q4 + 2] = gt[sj][4 * q4 + 2] * (c * gs.z); m[4 * q4 + 3] = gt[sj][4 * q4 + 3] * (c * gs.w); }
            } else {
#pragma unroll
                for (int r = 0; r < 16; ++r) {
                    const int s = 32 * si + crow(r, hh);
                    const f32x4 ts = *(const LAS f32x4*)(tb + 4 * s);
                    const float wf = __expf(fminf(acFl - ts.x, 0.f)) * ts.y, wb = __expf(fminf(acBl - ts.z, 0.f)) * ts.w;
                    const float w = l > s ? wf : (l < s ? wb : ts.y + ts.w);
                    m[r] = gt[sj][r] * w + (l == s ? dsk : 0.f);
                }
            }
#pragma unroll
            for (int t = 0; t < 2; ++t) {
                const bf16x8 ma = pack8(m[8 * t], m[8 * t + 1], m[8 * t + 2], m[8 * t + 3], m[8 * t + 4], m[8 * t + 5], m[8 * t + 6], m[8 * t + 7]);
                const int r0 = 32 * si + 16 * t + 4 * hh;
#pragma unroll
                for (int pi = 0; pi < 2; ++pi) { const bf16x8 xb = tr2(Xi, 192, r0, r0 + 8, 32 * pi, F.lane); accd[pi] = MFMA32(ma, xb, accd[pi]); }
            }
        }
        __syncthreads();
#pragma unroll
        for (int pi = 0; pi < 2; ++pi)
#pragma unroll
            for (int r = 0; r < 16; ++r) *(LAS float*)(stg + sh * (128 * 272) + (32 * li + crow(r, hh)) * 272 + (32 * pi + l31) * 4) = accd[pi][r];
        if (j == 0) s2_head_store(F, H, Xi, Si);
        __syncthreads();
        const int c4 = F.lane & 15;
        const f32x4 nw = *(const f32x4*)(F.in[IN_SSMNW + F.z] + layer * D + h * 64 + 4 * c4);
#pragma unroll
        for (int v = 0; v < 4; ++v) {
            const int lr = F.wave * 16 + 4 * v + (F.lane >> 4);
            const f32x4 y0 = *(const LAS f32x4*)(stg + lr * 272 + c4 * 16), y1 = *(const LAS f32x4*)(stg + 128 * 272 + lr * 272 + c4 * 16);
            const int row = geo_row(geo, geo.pos0 + lr);
            const u32x2 zr = zq[v];
            f32x4 y = y0 + y1;
            y.x *= bf2f(zr.x & 0xffffu); y.y *= bf2f(zr.x >> 16); y.z *= bf2f(zr.y & 0xffffu); y.w *= bf2f(zr.y >> 16);
            float q = (y.x * y.x + y.y * y.y) + (y.z * y.z + y.w * y.w);
            q += shfl_x(q, 1, F.lane); q += shfl_x(q, 2, F.lane); q += shfl_x(q, 4, F.lane); q += shfl_x(q, 8, F.lane);
            if (c4 == 0) atomicAdd(SSQ + row, q);
            y = y * nw;
            u32x2 o; o.x = pkbf(y.x, y.y); o.y = pkbf(y.z, y.w);
            *(u32x2*)(AM + (size_t)row * 2048 + h * 64 + 4 * c4) = o;
        }
        if (j == 0) __syncthreads();
    }
}

DEV void gmlp_unit(Frame& F, int layer, int vb) {
    LAS unsigned char* Vi = F.lds;
    LAS unsigned char* stg = F.lds + 128 * 320;
    LAS unsigned char* Wi = stg + 128 * 528;
    const bf16* proj = (const bf16*)(F.ws + WS_PROJ);
    const float* gsum = (const float*)(F.ws + WS_CTL + CTL_GSUM) + (size_t)layer * NTOK * 2;
    bf16* ag = (bf16*)(F.ws + WS_AMG) + 1024;
    const int hh = F.lane >> 5, ti = F.wave >> 1, cj = F.wave & 1, l31 = F.lane & 31;
    {
        const int ck = vb >> 3, g = vb & 7;
        u32x2 uq[8];
#pragma unroll
        for (int v = 0; v < 8; ++v) { const size_t ro = (size_t)(ck * 128 + F.wave * 16 + 2 * v + hh) * NPROJ + g * 128 + 4 * l31; uq[v] = *(const u32x2*)(proj + ro + PC_U); }
        {
            const bf16* wsrc = (const bf16*)(F.ws + WS_WSPB) + (size_t)(layer * 8 + g) * 128 * 128;
            const int ch = F.tid & 15, r0 = F.tid >> 4;
            u32x4 wq[4];
#pragma unroll
            for (int p = 0; p < 4; ++p) wq[p] = *(const u32x4*)(wsrc + (size_t)(r0 + 32 * p) * 128 + ch * 8);
#pragma unroll
            for (int p = 0; p < 4; ++p) *(LAS u32x4*)(Wi + (r0 + 32 * p) * 272 + ch * 16) = wq[p];
        }
        {
            const int s = F.tid >> 2, c0 = (F.tid & 3) * 32, row = ck * 128 + s;
            const float mu = gsum[row * 2] * (1.f / D), rstd = rsqrtf(fmaxf(gsum[row * 2 + 1] * (1.f / D) - mu * mu, 0.f) + EPS);
            const float* lnw = F.in[IN_LNW + F.z] + layer * D + g * 128 + c0; const float* lnb = F.in[IN_LNB + F.z] + layer * D + g * 128 + c0;
#pragma unroll
            for (int j = 0; j < 4; ++j) {
                const u32x4 r = *(const u32x4*)(proj + (size_t)row * NPROJ + PC_V + g * 128 + c0 + 8 * j);
                const f32x4 w0 = *(const f32x4*)(lnw + 8 * j), w1 = *(const f32x4*)(lnw + 8 * j + 4), b0 = *(const f32x4*)(lnb + 8 * j), b1 = *(const f32x4*)(lnb + 8 * j + 4);
                float v[8] = {bf2f(r.x & 0xffffu), bf2f(r.x >> 16), bf2f(r.y & 0xffffu), bf2f(r.y >> 16), bf2f(r.z & 0xffffu), bf2f(r.z >> 16), bf2f(r.w & 0xffffu), bf2f(r.w >> 16)};
                const float ww[8] = {w0.x, w0.y, w0.z, w0.w, w1.x, w1.y, w1.z, w1.w}, bb[8] = {b0.x, b0.y, b0.z, b0.w, b1.x, b1.y, b1.z, b1.w};
#pragma unroll
                for (int c = 0; c < 8; ++c) v[c] = (v[c] - mu) * rstd * ww[c] + bb[c];
                u32x4 o; o.x = pkbf(v[0], v[1]); o.y = pkbf(v[2], v[3]); o.z = pkbf(v[4], v[5]); o.w = pkbf(v[6], v[7]);
                *(LAS u32x4*)(Vi + s * 320 + (c0 + 8 * j) * 2) = o;
            }
        }
        __syncthreads();
        f32x16 acc[2];
#pragma unroll
        for (int r = 0; r < 16; ++r) { acc[0][r] = 0.f; acc[1][r] = 0.f; }
#pragma unroll
        for (int ks = 0; ks < 8; ++ks) {
            const int k0 = 16 * ks + 8 * hh;
            const bf16x8 a = *(const LAS bf16x8*)(Wi + (32 * ti + l31) * 272 + k0 * 2);
#pragma unroll
            for (int c = 0; c < 2; ++c) { const bf16x8 b = tr2(Vi, 320, k0, k0 + 4, 64 * cj + 32 * c, F.lane); acc[c] = MFMA32(a, b, acc[c]); }
        }
#pragma unroll
        for (int c = 0; c < 2; ++c)
#pragma unroll
            for (int r = 0; r < 16; ++r) *(LAS float*)(stg + (32 * ti + crow(r, hh)) * 528 + (64 * cj + 32 * c + l31) * 4) = acc[c][r];
        __syncthreads();
        const float* bsp = F.in[IN_BSP + F.z] + (layer * 8 + g) * 128;
#pragma unroll
        for (int v = 0; v < 8; ++v) {
            const int t = F.wave * 16 + 2 * v + hh, row = ck * 128 + t;
            const f32x4 sv = *(const LAS f32x4*)(stg + t * 528 + l31 * 16) + bsp[t];
            const u32x2 ur = uq[v];
            u32x2 o;
            o.x = pkbf(bf2f(ur.x & 0xffffu) * sv.x, bf2f(ur.x >> 16) * sv.y);
            o.y = pkbf(bf2f(ur.y & 0xffffu) * sv.z, bf2f(ur.y >> 16) * sv.w);
            *(u32x2*)(ag + (size_t)row * 2048 + g * 128 + 4 * l31) = o;
        }
    }
}

constexpr int CW_QUEUE = 8192;
DEV void ph_queue(const Frame& F0, int layer, int which, int qidx, bool dummy) {
    Frame F = launder(F0);
    asm volatile("" : "+s"(layer));
    unsigned* head = (unsigned*)(F.ws + WS_CTL) + CW_QUEUE + 64 * qidx;
    volatile LAS unsigned* slot = (volatile LAS unsigned*)(F.lds + LDS_BYTES - 256) + 16;
    const int N = which == 0 ? 64 + 512 : 640 + 640;
    __syncthreads();
    if (F.tid == 0) *slot = atomicAdd(head, 1u);
    __syncthreads();
    int it = (int)*slot;
    while (it < N) {
        unsigned nxt = 0u;
        Frame Fi = launder(F);
        if (Fi.tid == 0) nxt = atomicAdd((unsigned*)(Fi.ws + WS_CTL) + CW_QUEUE + 64 * qidx, 1u);
        if (which == 0) {
            if (it < 64) s1_lat_unit(Fi, layer, it >> 5, (it >> 1) & 15, it & 1);
            else s1_ctx_unit(Fi, layer, (it - 64) >> 4, (it - 64) & 15);
        } else {
            if (it < 640) s2_unit(Fi, layer, it >> 3, (it >> 1) & 3, it & 1, dummy);
            else gmlp_unit(Fi, layer, it - 640);
        }
        __syncthreads();
        if (nxt != 0u) *slot = nxt;
        __syncthreads();
        it = (int)*slot;
    }
}

DEV void ph_dt(const Frame& F0, int layer) {
    Frame F = launder(F0);
    asm volatile("" : "+s"(layer));
    LAS unsigned char* Ai = F.lds;
    LAS unsigned char* Wi = F.lds + 40 * 2064;
    LAS float* red = (LAS float*)F.lds;
    const int hh = F.lane >> 5, l31 = F.lane & 31;
    unsigned* head = (unsigned*)(F.ws + WS_CTL) + CW_QUEUE + 64 * (16 + layer);
    volatile LAS unsigned* slot = (volatile LAS unsigned*)(F.lds + LDS_BYTES - 256) + 16;
    for (;;) {
        __syncthreads();
        if (F.tid == 0) *slot = atomicAdd(head, 1u);
        __syncthreads();
        const int u = (int)*slot;
        if (u >= NTOK / 40) break;
        {   const bf16* A = (const bf16*)(F.ws + WS_HBUF) + (size_t)u * 40 * D;
            const bf16* W = (const bf16*)(F.ws + WS_WDT) + (size_t)layer * 32 * 1024;
            u32x4 aq[10], wq[8];
#pragma unroll
            for (int j = 0; j < 10; ++j) { const int c = F.tid + 512 * j; aq[j] = *(const u32x4*)(A + (size_t)(c >> 7) * D + (c & 127) * 8); }
#pragma unroll
            for (int j = 0; j < 8; ++j) { const int c = F.tid + 512 * j; wq[j] = *(const u32x4*)(W + (size_t)(c >> 7) * 1024 + (c & 127) * 8); }
#pragma unroll
            for (int j = 0; j < 10; ++j) { const int c = F.tid + 512 * j; *(LAS u32x4*)(Ai + (c >> 7) * 2064 + (c & 127) * 16) = aq[j]; }
#pragma unroll
            for (int j = 0; j < 8; ++j) { const int c = F.tid + 512 * j; *(LAS u32x4*)(Wi + (c >> 7) * 2064 + (c & 127) * 16) = wq[j]; }
        }
        __syncthreads();
        f32x16 acc[2];
#pragma unroll
        for (int r = 0; r < 16; ++r) { acc[0][r] = 0.f; acc[1][r] = 0.f; }
#pragma unroll
        for (int ks = 0; ks < 8; ++ks) {
            const int kb = (128 * F.wave + 16 * ks + 8 * hh) * 2;
            const bf16x8 b = *(const LAS bf16x8*)(Wi + l31 * 2064 + kb);
            const bf16x8 a0 = *(const LAS bf16x8*)(Ai + l31 * 2064 + kb), a1 = *(const LAS bf16x8*)(Ai + (32 + l31) * 2064 + kb);
            acc[0] = MFMA32(a0, b, acc[0]); acc[1] = MFMA32(a1, b, acc[1]);
        }
        __syncthreads();
#pragma unroll
        for (int t = 0; t < 2; ++t)
#pragma unroll
            for (int r = 0; r < 16; ++r) red[((F.wave * 2 + t) * 32 + crow(r, hh)) * 32 + l31] = acc[t][r];
        __syncthreads();
        for (int o = F.tid; o < 40 * 32; o += 512) {
            const int r = o >> 5, j = o & 31, t = r >> 5, rr = r & 31;
            float v = 0.f;
#pragma unroll
            for (int w = 0; w < 8; ++w) v += red[((w * 2 + t) * 32 + rr) * 32 + j];
            const int row = u * 40 + r;
            const float rs = rsqrtf(((const float*)(F.ws + WS_CTL + CTL_SSQX))[(size_t)layer * NTOK + row] * (1.f / D) + EPS);
            const float swv = ((const float*)(F.ws + WS_CTL + CTL_SW))[(size_t)(layer * 3 + (row < NCTX ? 0 : 1 + ((row - NCTX) >> 10))) * DIN + 3072 + j];
            ((float*)(F.ws + WS_DTRAW))[(size_t)row * 32 + j] = v * rs + swv;
        }
    }
}

#define XB_TMO      128
#define XB_XCNT(j)  (256  + 64 * (j))
#define XB_XSUB(j)  (1280 + 64 * (j))
#define XB_XGEN(j)  (2304 + 64 * (j))
#define XB_TOP      3328
#define XB_TOPGEN   3392
#define XCD_BAR_WORDS 3456
#define XB_SPIN_CAP (1u << 18)

__device__ __forceinline__ unsigned xb_ld(unsigned* p)              { return __hip_atomic_load(p, __ATOMIC_RELAXED, __HIP_MEMORY_SCOPE_AGENT); }
__device__ __forceinline__ unsigned xb_add(unsigned* p, unsigned v) { return __hip_atomic_fetch_add(p, v, __ATOMIC_RELAXED, __HIP_MEMORY_SCOPE_AGENT); }
__device__ __forceinline__ unsigned xb_xcc_id() { return (unsigned)__builtin_amdgcn_s_getreg((3 << 11) | 20) & 0xFu; }
#define XB_SPIN(cond, bar) do { unsigned _sp = 0; while (cond) { __builtin_amdgcn_s_sleep(1); \
    if ((++_sp & 255u) == 0u) { if (xb_ld(&(bar)[XB_TMO])) break; if (_sp > XB_SPIN_CAP) { atomicAdd(&(bar)[XB_TMO], 1u); break; } } } } while (0)

struct XcdBarrier {
    unsigned* bar; unsigned x;
    volatile LAS unsigned* st;
};

__device__ __forceinline__ XcdBarrier xcd_barrier_post(unsigned* bar, volatile LAS unsigned* st) {
    XcdBarrier b; b.bar = bar; b.x = xb_xcc_id(); b.st = st;
    if (threadIdx.x == 0) (void)xb_add(&bar[XB_XCNT(b.x)], 1u);
    return b;
}
__device__ __forceinline__ void xcd_barrier_complete(unsigned* bar, unsigned x, unsigned& nloc, unsigned& nx) {
    const unsigned G = gridDim.x * gridDim.y * gridDim.z;
    unsigned sum, cnt, mine, sp = 0u;
    for (;;) {
        sum = 0u; cnt = 0u; mine = 0u;
#pragma unroll
        for (unsigned j = 0; j < 16; ++j) { const unsigned c = xb_ld(&bar[XB_XCNT(j)]); sum += c; cnt += (c > 0u) ? 1u : 0u; mine = (j == x) ? c : mine; }
        if (sum == G) break;
        __builtin_amdgcn_s_sleep(1);
        if ((++sp & 255u) == 0u) { if (xb_ld(&bar[XB_TMO])) break; if (sp > XB_SPIN_CAP) { atomicAdd(&bar[XB_TMO], 1u); break; } }
    }
    nloc = mine > 0u ? mine : 1u; nx = cnt > 0u ? cnt : 1u;
}

__device__ __forceinline__ void xcd_barrier(const XcdBarrier& b) {
    asm volatile("s_waitcnt vmcnt(0)" ::: "memory");
    __syncthreads();
    if (threadIdx.x == 0) {
        unsigned* bar = b.bar;
        __builtin_amdgcn_s_waitcnt(0);
        unsigned nloc = b.st[0], nx = b.st[1];
        if (nloc == 0u) { xcd_barrier_complete(bar, b.x, nloc, nx); b.st[0] = nloc; b.st[1] = nx; }
        const unsigned old = xb_add(&bar[XB_XSUB(b.x)], 1u);
        const unsigned gen = old / nloc;
        if (old + 1u == (gen + 1u) * nloc) {
            __builtin_amdgcn_fence(__ATOMIC_RELEASE, "agent");
            asm volatile("s_waitcnt vmcnt(0)" ::: "memory");
            const unsigned og = xb_add(&bar[XB_TOP], 1u);
            const unsigned tg = og / nx;
            if (og + 1u == (tg + 1u) * nx) xb_add(&bar[XB_TOPGEN], 1u);
            else XB_SPIN(xb_ld(&bar[XB_TOPGEN]) == tg, bar);
            __builtin_amdgcn_fence(__ATOMIC_ACQUIRE, "agent");
            xb_add(&bar[XB_XGEN(b.x)], 1u);
            asm volatile("s_waitcnt vmcnt(0)" ::: "memory");
        } else {
            XB_SPIN(xb_ld(&bar[XB_XGEN(b.x)]) == gen, bar);
            __builtin_amdgcn_fence(__ATOMIC_ACQUIRE, "agent");
            asm volatile("s_waitcnt vmcnt(0)" ::: "memory");
        }
    }
    __syncthreads();
}

struct EpiIn {
    static constexpr bool PERM = true, AFTER_DRAIN = false, HAS_MID = false;
    bf16* O; const float* ssqx; const float* sw; float* gsum;
    __device__ __forceinline__ void operator()(const f32x4 (&acc)[2][2][4][2], const pg8::Unit& u, int wr, int wc, int fr, int fq) const {
        int row0 = u.pm * 256 + wr * 64 + fr, cl = wc * 32 + 8 * fq;
        asm volatile("" : "+v"(row0), "+v"(cl));
        const int mv = u.pm < 32 ? 0 : 1 + ((u.pm - 32) >> 2);
        const int kind = u.pn < 8 ? 0 : u.pn < 12 ? 1 : u.pn < 20 ? 2 : u.pn < 24 ? 3 : 4;
        int nat[2], oc[2];
        if (u.pn < 12) { nat[0] = u.pn * 256; nat[1] = nat[0] + 128; oc[0] = nat[0]; oc[1] = nat[1]; }
        else if (u.pn < 20) { nat[0] = 3104 + (u.pn - 12) * 128; nat[1] = 5152 + (u.pn - 12) * 128; oc[0] = PC_U + (u.pn - 12) * 128; oc[1] = oc[0]; }
        else if (u.pn < 24) { nat[0] = 4128 + (u.pn - 20) * 256; nat[1] = nat[0] + 128; oc[0] = PC_V + (u.pn - 20) * 256; oc[1] = oc[0] + 128; }
        else { nat[0] = 6176 + (u.pn - 24) * 128; nat[1] = 7200 + (u.pn - 24) * 128; oc[0] = PC_GLM + (u.pn - 24) * 128; oc[1] = PC_GLG + (u.pn - 24) * 128; }
        f32x4 bv[2][2];
#pragma unroll
        for (int bj = 0; bj < 2; ++bj)
#pragma unroll
            for (int n = 0; n < 2; ++n) bv[bj][n] = *(const f32x4*)(sw + mv * DIN + nat[bj] + cl + 4 * n);
        float rs8[8];
#pragma unroll
        for (int i = 0; i < 8; ++i) rs8[i] = ssqx[row0 + (i >> 2) * 128 + (i & 3) * 16];
#pragma unroll
        for (int i = 0; i < 8; ++i) rs8[i] = rsqrtf(rs8[i] * (1.f / D) + EPS);
#pragma unroll
        for (int ai = 0; ai < 2; ++ai)
#pragma unroll
            for (int m = 0; m < 4; ++m) {
                const int r = row0 + ai * 128 + m * 16;
                const float rs = rs8[ai * 4 + m];
                float v[2][8];
#pragma unroll
                for (int bj = 0; bj < 2; ++bj)
#pragma unroll
                    for (int j = 0; j < 4; ++j) { v[bj][j] = acc[ai][bj][m][0][j] * rs + bv[bj][0][j]; v[bj][4 + j] = acc[ai][bj][m][1][j] * rs + bv[bj][1][j]; }
                if (kind == 2) {
#pragma unroll
                    for (int j = 0; j < 8; ++j) v[0][j] = gelu_f(v[0][j]) * silu_f(v[1][j]);
                    u32x4 w; w.x = pkbf(v[0][0], v[0][1]); w.y = pkbf(v[0][2], v[0][3]); w.z = pkbf(v[0][4], v[0][5]); w.w = pkbf(v[0][6], v[0][7]);
                    *(u32x4*)(O + (size_t)r * NPROJ + oc[0] + cl) = w;
                } else {
                    float s1 = 0.f, s2 = 0.f;
                    if (kind == 4) {
#pragma unroll
                        for (int j = 0; j < 8; ++j) { const float em = __expf(-v[0][j]), eg = __expf(-v[1][j]); v[1][j] = __builtin_amdgcn_rcpf(1.f + eg); v[0][j] = (1.f + eg) * __builtin_amdgcn_rcpf(1.f + em); }
                    }
#pragma unroll
                    for (int bj = 0; bj < 2; ++bj) {
                        if (kind == 1) {
#pragma unroll
                            for (int j = 0; j < 8; ++j) v[bj][j] = silu_f(v[bj][j]);
                        } else if (kind == 3) {
#pragma unroll
                            for (int j = 0; j < 8; ++j) { v[bj][j] = gelu_f(v[bj][j]); s1 += v[bj][j]; s2 += v[bj][j] * v[bj][j]; }
                        }
                        u32x4 w; w.x = pkbf(v[bj][0], v[bj][1]); w.y = pkbf(v[bj][2], v[bj][3]); w.z = pkbf(v[bj][4], v[bj][5]); w.w = pkbf(v[bj][6], v[bj][7]);
                        *(u32x4*)(O + (size_t)r * NPROJ + oc[bj] + cl) = w;
                    }
                    if (kind == 3) {
                        const int ln = fr + 16 * fq; s1 += shfl_x(s1, 16, ln); s1 += shfl_x(s1, 32, ln); s2 += shfl_x(s2, 16, ln); s2 += shfl_x(s2, 32, ln);
                        if (fq == 0) { atomicAdd(gsum + 2 * r, s1); atomicAdd(gsum + 2 * r + 1, s2); }
                    }
                }
            }
    }
};
struct EpiMerge {
    static constexpr bool PERM = true, AFTER_DRAIN = false, HAS_MID = true;
    bf16* O; const bf16* proj; const float* ssq;
    __device__ __forceinline__ void mid(f32x4 (&acc)[2][2][4][2], const pg8::Unit& u, int wr, int wc, int fr, int fq) const {
        int row0 = u.pm * 256 + wr * 64 + fr, col0 = u.pn * 256 + wc * 32 + 8 * fq;
        asm volatile("" : "+v"(row0), "+v"(col0));
        u32x4 g[8][2]; float rs8[8];
#pragma unroll
        for (int i = 0; i < 8; ++i) { const int r = row0 + (i >> 2) * 128 + (i & 3) * 16; rs8[i] = ssq[r];
#pragma unroll
            for (int bj = 0; bj < 2; ++bj) g[i][bj] = *(const u32x4*)(proj + (size_t)r * NPROJ + PC_GLM + col0 + bj * 128); }
#pragma unroll
        for (int i = 0; i < 8; ++i) { const int ai = i >> 2, m = i & 3; const float rs = rsqrtf(rs8[i] * (1.f / D) + EPS);
#pragma unroll
            for (int bj = 0; bj < 2; ++bj) { const u32x4 q = g[i][bj];
                acc[ai][bj][m][0][0] *= bf2f(q.x & 0xffffu) * rs; acc[ai][bj][m][0][1] *= bf2f(q.x >> 16) * rs; acc[ai][bj][m][0][2] *= bf2f(q.y & 0xffffu) * rs; acc[ai][bj][m][0][3] *= bf2f(q.y >> 16) * rs;
                acc[ai][bj][m][1][0] *= bf2f(q.z & 0xffffu) * rs; acc[ai][bj][m][1][1] *= bf2f(q.z >> 16) * rs; acc[ai][bj][m][1][2] *= bf2f(q.w & 0xffffu) * rs; acc[ai][bj][m][1][3] *= bf2f(q.w >> 16) * rs; } }
    }
    __device__ __forceinline__ void operator()(const f32x4 (&acc)[2][2][4][2], const pg8::Unit& u, int wr, int wc, int fr, int fq) const {
        int row0 = u.pm * 256 + wr * 64 + fr, col0 = u.pn * 256 + wc * 32 + 8 * fq;
        asm volatile("" : "+v"(row0), "+v"(col0));
        u32x4 g[8][2];
#pragma unroll
        for (int i = 0; i < 8; ++i) { const int r = row0 + (i >> 2) * 128 + (i & 3) * 16;
#pragma unroll
            for (int bj = 0; bj < 2; ++bj) g[i][bj] = *(const u32x4*)(proj + (size_t)r * NPROJ + PC_GLG + col0 + bj * 128); }
#pragma unroll
        for (int i = 0; i < 8; ++i) { const int ai = i >> 2, m = i & 3, r = row0 + ai * 128 + m * 16;
#pragma unroll
            for (int bj = 0; bj < 2; ++bj) { const u32x4 q = g[i][bj]; u32x4 w;
                w.x = pkbf(acc[ai][bj][m][0][0] * bf2f(q.x & 0xffffu), acc[ai][bj][m][0][1] * bf2f(q.x >> 16));
                w.y = pkbf(acc[ai][bj][m][0][2] * bf2f(q.y & 0xffffu), acc[ai][bj][m][0][3] * bf2f(q.y >> 16));
                w.z = pkbf(acc[ai][bj][m][1][0] * bf2f(q.z & 0xffffu), acc[ai][bj][m][1][1] * bf2f(q.z >> 16));
                w.w = pkbf(acc[ai][bj][m][1][2] * bf2f(q.w & 0xffffu), acc[ai][bj][m][1][3] * bf2f(q.w >> 16));
                *(u32x4*)(O + (size_t)r * D + col0 + bj * 128) = w; } }
    }
};
struct EpiOut {
    static constexpr bool PERM = true, AFTER_DRAIN = false, HAS_MID = false;
    const float* xp; const float* xs; const float* xold; float* xnew; bf16* hx; const float* mod; const float* gn; float* ssqn;
    __device__ __forceinline__ void operator()(const f32x4 (&acc)[2][2][4][2], const pg8::Unit& u, int wr, int wc, int fr, int fq) const {
        int row0 = u.pm * 256 + wr * 64 + fr, col0 = u.pn * 256 + wc * 32 + 8 * fq;
        asm volatile("" : "+v"(row0), "+v"(col0));
        const int mv = u.pm < 32 ? 0 : 1 + ((u.pm - 32) >> 2);
        const float* xo = xold ? xold : (u.pm < 32 ? xp : xs - (size_t)NCTX * D);
        const float* gate = mod + mv * 3072 + 2048 + col0;
        f32x4 ga[2][2];
#pragma unroll
        for (int bj = 0; bj < 2; ++bj)
#pragma unroll
            for (int n = 0; n < 2; ++n) ga[bj][n] = *(const f32x4*)(gate + bj * 128 + 4 * n);
#pragma unroll
        for (int ai = 0; ai < 2; ++ai) {
            f32x4 x[4][2][2];
#pragma unroll
            for (int m = 0; m < 4; ++m)
#pragma unroll
                for (int bj = 0; bj < 2; ++bj)
#pragma unroll
                    for (int n = 0; n < 2; ++n) x[m][bj][n] = *(const f32x4*)(xo + (size_t)(row0 + ai * 128 + m * 16) * D + col0 + bj * 128 + 4 * n);
#pragma unroll
            for (int m = 0; m < 4; ++m) {
                const int r = row0 + ai * 128 + m * 16;
                float q = 0.f;
#pragma unroll
                for (int bj = 0; bj < 2; ++bj) {
                    const size_t off = (size_t)r * D + col0 + bj * 128;
                    const f32x4 n0 = x[m][bj][0] + ga[bj][0] * acc[ai][bj][m][0], n1 = x[m][bj][1] + ga[bj][1] * acc[ai][bj][m][1];
                    *(f32x4*)(xnew + off) = n0; *(f32x4*)(xnew + off + 4) = n1;
                    q += (n0.x * n0.x + n0.y * n0.y) + (n0.z * n0.z + n0.w * n0.w) + (n1.x * n1.x + n1.y * n1.y) + (n1.z * n1.z + n1.w * n1.w);
                    if (gn) { const f32x4 h0 = n0 * *(const f32x4*)(gn + mv * 1024 + col0 + bj * 128), h1 = n1 * *(const f32x4*)(gn + mv * 1024 + col0 + bj * 128 + 4);
                        u32x4 w; w.x = pkbf(h0.x, h0.y); w.y = pkbf(h0.z, h0.w); w.z = pkbf(h1.x, h1.y); w.w = pkbf(h1.z, h1.w);
                        *(u32x4*)(hx + off) = w; }
                }
                { const int ln = fr + 16 * fq; q += shfl_x(q, 16, ln); q += shfl_x(q, 32, ln); }
                if (fq == 0) atomicAdd(ssqn + r, q);
            }
            asm volatile("" ::: "memory");
        }
    }
};

constexpr int CW_BAR = 4096;
constexpr int MISC_OFF = LDS_BYTES - 256;

__global__ void __launch_bounds__(512, 2) mega(Args args) {
    extern __shared__ __attribute__((aligned(16))) unsigned char lds[];
    Frame F;
    F.lds = (LAS unsigned char*)lds; F.tid = threadIdx.x; F.lane = F.tid & 63; F.wave = __builtin_amdgcn_readfirstlane(F.tid >> 6);
    F.G = gridDim.x; F.bid = blockIdx.x; F.in = args.in; F.out = args.out; F.ws = args.ws; F.z = 0;
    volatile LAS unsigned* MISC = (volatile LAS unsigned*)(F.lds + MISC_OFF);
    if (F.tid < 64) MISC[F.tid] = 0u;
    __syncthreads();
    (void)xcd_barrier_post((unsigned*)(F.ws + WS_CTL) + CW_BAR, MISC + 8);
#define GRID_BAR() do { Frame Fb = launder(F); XcdBarrier b_; b_.bar = (unsigned*)(Fb.ws + WS_CTL) + CW_BAR; b_.x = xb_xcc_id(); b_.st = (volatile LAS unsigned*)(Fb.lds + MISC_OFF) + 8; xcd_barrier(b_); } while (0)
    ph_mod(F); GRID_BAR();
    ph_cvt(F, 0, 0, F.G); ph_gn(F); ph_prep0(F); GRID_BAR();
    for (int layer = 0; layer < DEPTH; ++layer) {
        { Frame Fg = launder(F);
          pg8::Gemm g{(const bf16*)(Fg.ws + WS_HBUF), (const bf16*)(Fg.ws + WS_WIN) + (size_t)layer * NPROJ * 1024, NTOK, NPROJ, D};
          pg8::StaticOrder S; S.init(NTOK, NPROJ, Fg.G, Fg.bid);
          EpiIn E{(bf16*)(Fg.ws + WS_PROJ), (const float*)(Fg.ws + WS_CTL + CTL_SSQX) + (size_t)layer * NTOK, (const float*)(Fg.ws + WS_CTL + CTL_SW) + (size_t)layer * 3 * DIN,
                  (float*)(Fg.ws + WS_CTL + CTL_GSUM) + (size_t)layer * NTOK * 2};
          pg8::gemm_phase<EpiIn, pg8::StaticOrder, true, true>(Fg.lds, g, S, E, Fg.wave); }
        ph_dt(F, layer);
        GRID_BAR();
        ph_b0(F, layer); GRID_BAR();
        if (DUP_MASK & 1) { ph_b0(F, layer); GRID_BAR(); }
        ph_queue(F, layer, 0, layer, false); GRID_BAR();
        if (DUP_MASK & 2) { ph_queue(F, layer, 0, 8 + layer, false); GRID_BAR(); }
        ph_queue(F, layer, 1, 4 + layer, false); GRID_BAR();
        if (DUP_MASK & 4) { ph_queue(F, layer, 1, 12 + layer, true); GRID_BAR(); }
        { Frame Fg = launder(F);
          pg8::Gemm g{(const bf16*)(Fg.ws + WS_AMG), (const bf16*)(Fg.ws + WS_WMG) + (size_t)layer * 1024 * 2048, NTOK, D, 2048};
          pg8::StaticOrder S; S.init(NTOK, D, Fg.G, Fg.bid);
          EpiMerge E{(bf16*)(Fg.ws + WS_MRG), (const bf16*)(Fg.ws + WS_PROJ), (const float*)(Fg.ws + WS_CTL + CTL_SSQ) + (size_t)layer * NTOK};
          pg8::gemm_phase<EpiMerge, pg8::StaticOrder, true, true>(Fg.lds, g, S, E, Fg.wave); }
        if (layer + 1 < DEPTH) ph_cvt(F, layer + 1, 160, F.G - 160);
        GRID_BAR();
        { Frame Fg = launder(F);
          pg8::Gemm g{(const bf16*)(Fg.ws + WS_MRG), (const bf16*)(Fg.ws + WS_WO) + (size_t)layer * 1024 * 1024, NTOK, D, D};
          pg8::StaticOrder S; S.init(NTOK, D, Fg.G, Fg.bid);
          EpiOut E{Fg.in[IN_XP + Fg.z], Fg.in[IN_XS + Fg.z], layer == 0 ? nullptr : (const float*)(Fg.ws + WS_XBUF), (float*)(Fg.ws + WS_XBUF), (bf16*)(Fg.ws + WS_HBUF),
                   (const float*)(Fg.ws + WS_MOD) + (size_t)layer * 3 * 3072, layer + 1 < DEPTH ? (const float*)(Fg.ws + WS_GN) + (size_t)(layer + 1) * 3 * 1024 : nullptr,
                   (float*)(Fg.ws + WS_CTL + CTL_SSQX) + (size_t)(layer + 1) * NTOK};
          pg8::gemm_phase<EpiOut, pg8::StaticOrder, true, true>(Fg.lds, g, S, E, Fg.wave); }
        GRID_BAR();
    }
    ph_final(F);
}

extern "C" void kernel_launch(void* const* d_in, const int* in_sizes, int n_in, void* d_out, int out_size, void* d_ws, size_t ws_size, hipStream_t stream) {
    static int grid = 0;
    if (grid == 0) {
        if (n_in != 23 || ws_size < WS_END) { fprintf(stderr, "kernel_launch: need 23 inputs and %zu bytes of workspace; got %d, %zu\n", (size_t)WS_END, n_in, ws_size); grid = -1; return; }
        int dev = 0, cus = 0;
        if (hipGetDevice(&dev) != hipSuccess || hipDeviceGetAttribute(&cus, hipDeviceAttributeMultiprocessorCount, dev) != hipSuccess) { grid = -1; return; }
        if (hipFuncSetAttribute((const void*)mega, hipFuncAttributeMaxDynamicSharedMemorySize, LDS_BYTES) != hipSuccess) { fprintf(stderr, "kernel_launch: hipFuncSetAttribute failed\n"); grid = -1; return; }
        grid = cus;
    }
    if (grid < 0) return;
    if (hipMemsetAsync((char*)d_ws + WS_CTL, 0, CTL_BYTES, stream) != hipSuccess) return;
    Args a{};
    for (int i = 0; i < 23; ++i) a.in[i] = (const float*)d_in[i];
    a.out = (float*)d_out; a.ws = (unsigned char*)d_ws;
    hipLaunchKernelGGL(mega, dim3(grid), dim3(512), LDS_BYTES, stream, a);
}
```

```cpp
#define DUP_MASK 0
#include <hip/hip_runtime.h>
#include <cstdio>
#include <cstdint>
namespace pg8 {
#define PG8_LAS __attribute__((address_space(3)))
typedef unsigned short bf16_t;
typedef short bf16x8 __attribute__((ext_vector_type(8)));
typedef float f32x4 __attribute__((ext_vector_type(4)));
typedef unsigned u32x4 __attribute__((ext_vector_type(4)));
constexpr int BM = 256, BK = 64, HALF = 128, HTB = HALF * BK * 2  , STAGE_BYTES = 8 * HTB, NXCD = 8, WGM = 8;

__host__ __device__ __forceinline__ int lds_byte(int r, int c) { const int st = (r >> 4) * 2 + (c >> 5), rr = r & 15, cc = c & 31, ob = rr * 64 + cc * 2; return st * 1024 + (ob ^ (((ob >> 9) & 1) << 5)); }
__host__ __device__ __forceinline__ void stage_rc(int b, int& R, int& C) { const int st = b / 1024, sb = b % 1024, swz = sb ^ (((sb >> 9) & 1) << 5); R = (st >> 1) * 16 + swz / 64; C = (st & 1) * 32 + (swz % 64) / 2; }
__host__ __device__ __forceinline__ int perm32(int rho) { const int n = rho >> 4, i = rho & 15; return 8 * (i >> 2) + 4 * n + (i & 3); }

struct Unit { int pm, pn; };
struct Gemm { const bf16_t* A; const bf16_t* Bt; int M, N, K; };

struct StaticOrder {
    int nM, nN, nwg, G, c;
    __host__ __device__ void init(int M, int N, int G_, int c_) { nM = M / BM; nN = N / BM; nwg = nM * nN; G = G_; c = c_; }
    __host__ __device__ bool next(int i, Unit& u) const {
        const long L = (long)i * G + c; if (L >= nwg) return false;
        int wgid = (int)L; { const int q = nwg / NXCD, r = nwg % NXCD, xcd = wgid % NXCD, off = wgid / NXCD; wgid = (xcd < r ? xcd * (q + 1) : r * (q + 1) + (xcd - r) * q) + off; }
        const int nig = WGM * nN, gid = wgid / nig, fm = gid * WGM, gsz = (nM - fm) < WGM ? (nM - fm) : WGM;
        u.pm = fm + ((wgid % nig) % gsz); u.pn = (wgid % nig) / gsz; return true;
    }
    __device__ __forceinline__ void a_ready(const Unit&) const {}
    __device__ __forceinline__ void done(const Unit&) const {}
};

__device__ __forceinline__ unsigned cvt_pk_bf16(float lo, float hi) { unsigned r; asm volatile("v_cvt_pk_bf16_f32 %0, %1, %2" : "=v"(r) : "v"(lo), "v"(hi)); return r; }
typedef float f32x2 __attribute__((ext_vector_type(2)));
__device__ __forceinline__ f32x2 gelu_pk(f32x2 v) {
    const f32x2 av = __builtin_elementwise_abs(v), d = av * 0.2316418882f + 1.0f;
    f32x2 t; t.x = __builtin_amdgcn_rcpf(d.x); t.y = __builtin_amdgcn_rcpf(d.y);
    f32x2 q = t * 0.5307027145f + (-0.7265760135f); q = q * t + 0.7107068705f; q = q * t + (-0.142248368f); q = q * t + 0.127414796f; q = q * t;
    const f32x2 s = (v * v) * (-0.72134752044f);
    f32x2 e; e.x = __builtin_amdgcn_exp2f(s.x); e.y = __builtin_amdgcn_exp2f(s.y);
    const f32x2 m = v * (q * e), r = v - m;
    f32x2 o; o.x = v.x < 0.f ? m.x : r.x; o.y = v.y < 0.f ? m.y : r.y; return o;
}

template <int ACT  > struct EpiBf16 {
    static constexpr bool PERM = true, AFTER_DRAIN = false, HAS_MID = false; static_assert(ACT == 0 || ACT == 1, "EpiBf16: ACT is 0 (none) or 1 (gelu_pk)");
    bf16_t* O; int ldc; const float* bias; int split_cols; size_t split_stride; float scale0;
    __device__ __forceinline__ void operator()(const f32x4 (&acc)[2][2][4][2], const Unit& u, int wr, int wc, int fr, int fq) const {
        const int row0 = u.pm * BM + wr * 64 + fr; int colt = u.pn * BM; bf16_t* base = O;
        float sc = 1.f; if (split_cols) { const int t = colt / split_cols; base += (size_t)t * split_stride; colt -= t * split_cols; if (t == 0) sc = scale0; }
        const int col0 = colt + wc * 32 + 8 * fq, bcol0 = u.pn * BM + wc * 32 + 8 * fq;
        f32x4 bv[2][2];
#pragma unroll
        for (int bj = 0; bj < 2; ++bj)
#pragma unroll
            for (int n = 0; n < 2; ++n) bv[bj][n] = bias ? *(const f32x4*)(bias + bcol0 + bj * HALF + 4 * n) : (f32x4){0.f, 0.f, 0.f, 0.f};
#pragma unroll
        for (int ai = 0; ai < 2; ++ai)
#pragma unroll
            for (int m = 0; m < 4; ++m) { bf16_t* rowp = base + (size_t)(row0 + ai * HALF + m * 16) * ldc + col0;
#pragma unroll
                for (int bj = 0; bj < 2; ++bj) { f32x4 v0 = acc[ai][bj][m][0] + bv[bj][0], v1 = acc[ai][bj][m][1] + bv[bj][1];
                    if (ACT == 1) { f32x2 a = gelu_pk((f32x2){v0[0], v0[1]}), b = gelu_pk((f32x2){v0[2], v0[3]}), c = gelu_pk((f32x2){v1[0], v1[1]}), d = gelu_pk((f32x2){v1[2], v1[3]});
                        v0 = (f32x4){a.x, a.y, b.x, b.y}; v1 = (f32x4){c.x, c.y, d.x, d.y}; }
                    v0 = v0 * sc; v1 = v1 * sc; u32x4 w; w.x = cvt_pk_bf16(v0[0], v0[1]); w.y = cvt_pk_bf16(v0[2], v0[3]); w.z = cvt_pk_bf16(v1[0], v1[1]); w.w = cvt_pk_bf16(v1[2], v1[3]);
                    *(u32x4*)(rowp + bj * HALF) = w; } }
    }
};
struct EpiF32 {
    static constexpr bool PERM = false, AFTER_DRAIN = false, HAS_MID = false;
    float* C; int ldc; const float* bias;
    __device__ __forceinline__ void operator()(const f32x4 (&acc)[2][2][4][2], const Unit& u, int wr, int wc, int fr, int fq) const {
        const int row0 = u.pm * BM + wr * 64 + fr, col0 = u.pn * BM + wc * 32 + 4 * fq;
        f32x4 bv[2][2];
#pragma unroll
        for (int bj = 0; bj < 2; ++bj)
#pragma unroll
            for (int n = 0; n < 2; ++n) bv[bj][n] = bias ? *(const f32x4*)(bias + col0 + bj * HALF + n * 16) : (f32x4){0.f, 0.f, 0.f, 0.f};
#pragma unroll
        for (int ai = 0; ai < 2; ++ai)
#pragma unroll
            for (int m = 0; m < 4; ++m) { float* rowp = C + (size_t)(row0 + ai * HALF + m * 16) * ldc + col0;
#pragma unroll
                for (int bj = 0; bj < 2; ++bj)
#pragma unroll
                    for (int n = 0; n < 2; ++n) *(f32x4*)(rowp + bj * HALF + n * 16) = acc[ai][bj][m][n] + bv[bj][n]; }
    }
};
template <class Epi, class Sched, bool ALIGN_EPI = false, bool SP2 = false>
__device__ __forceinline__ void gemm_phase(PG8_LAS unsigned char* lds, const Gemm g, const Sched& S, const Epi& E, int wave_id) {
    int tid_ = wave_id * 64 + (int)__builtin_amdgcn_mbcnt_hi(~0u, __builtin_amdgcn_mbcnt_lo(~0u, 0u)); asm volatile("" : "+v"(tid_));
    const int tid = tid_, wid = __builtin_amdgcn_readfirstlane(tid >> 6), lane = tid & 63, wr = wid >> 2, wc = wid & 3, fr = lane & 15, fq = lane >> 4;
    const int K = g.K, nt = K / BK;
    unsigned voffA[2], voffB[2];
#pragma unroll
    for (int i = 0; i < 2; ++i) { int R, C; stage_rc(tid * 16 + i * 8192, R, C); const int Rb = Epi::PERM ? ((R & ~31) + perm32(R & 31)) : R;
        voffA[i] = (unsigned)(R * K + C) * 2u; voffB[i] = (unsigned)(Rb * K + C) * 2u; }
    const size_t kstep = (size_t)(BK * 2);
    const size_t hstep = (size_t)HALF * K * 2;
    const size_t tstep = 2 * hstep;
    const unsigned ldsw = (unsigned)wid * 1024u;
    const int aoff = lds_byte(wr * 64 + fr, fq * 8), boff = lds_byte(wc * 32 + fr, fq * 8);
#define PG8_SA(b, h) (((b) * 2 + (h)) * HTB)
#define PG8_SB(b, h) ((4 + (b) * 2 + (h)) * HTB)
#define PG8_STAGE(bufoff, gbase, voff) do { _Pragma("unroll") for (int _i = 0; _i < 2; ++_i) \
        __builtin_amdgcn_global_load_lds((const unsigned*)((const char*)(gbase) + (voff)[_i]), (PG8_LAS unsigned*)(lds + (bufoff) + ldsw + _i * 8192), 16, 0, 0); } while (0)
#define PG8_LDA(dst, b, h) do { _Pragma("unroll") for (int m = 0; m < 4; ++m) _Pragma("unroll") for (int k = 0; k < 2; ++k) dst[m][k] = *(const PG8_LAS bf16x8*)(lds + PG8_SA(b, h) + aoff + m * 2048 + k * 1024); } while (0)
#define PG8_LDB(dst, b, h) do { _Pragma("unroll") for (int n = 0; n < 2; ++n) _Pragma("unroll") for (int k = 0; k < 2; ++k) dst[n][k] = *(const PG8_LAS bf16x8*)(lds + PG8_SB(b, h) + boff + n * 2048 + k * 1024); } while (0)
#define PG8_MMA(ai, bj, At, Bt) do { __builtin_amdgcn_s_setprio(1); _Pragma("unroll") for (int m = 0; m < 4; ++m) _Pragma("unroll") for (int n = 0; n < 2; ++n) _Pragma("unroll") for (int k = 0; k < 2; ++k) \
        acc[ai][bj][m][n] = __builtin_amdgcn_mfma_f32_16x16x32_bf16(Bt[n][k], At[m][k], acc[ai][bj][m][n], 0, 0, 0); __builtin_amdgcn_s_setprio(0); } while (0)
#define PG8_WAIT_V(n) asm volatile("s_waitcnt vmcnt(" #n ")" ::: "memory")
#define PG8_WAIT_L(n) asm volatile("s_waitcnt lgkmcnt(" #n ")" ::: "memory")
#define PG8_BAR __builtin_amdgcn_s_barrier()
#define PG8_SCHED __builtin_amdgcn_sched_barrier(0)
    Unit cur, nxt; int ui = 0;
    if (!S.next(0, cur)) return;
    f32x4 acc[2][2][4][2];
#pragma unroll
    for (int a = 0; a < 2; ++a)
#pragma unroll
        for (int b = 0; b < 2; ++b)
#pragma unroll
            for (int m = 0; m < 4; ++m)
#pragma unroll
                for (int n = 0; n < 2; ++n) acc[a][b][m][n] = (f32x4){0.f, 0.f, 0.f, 0.f};
    bf16x8 At[4][2], B0[2][2], B1[2][2];
    const char* cA = (const char*)g.A + (size_t)cur.pm * tstep; const char* cB = (const char*)g.Bt + (size_t)cur.pn * tstep;
    S.a_ready(cur);
    if constexpr (SP2) {
        PG8_STAGE(PG8_SB(0, 0), cB, voffB); PG8_STAGE(PG8_SB(0, 1), cB + hstep, voffB); PG8_STAGE(PG8_SA(0, 0), cA, voffA); PG8_STAGE(PG8_SA(0, 1), cA + hstep, voffA);
        if (wr == 1) PG8_BAR;
        PG8_WAIT_V(2); PG8_BAR;
        PG8_STAGE(PG8_SB(1, 0), cB + kstep, voffB); PG8_STAGE(PG8_SA(1, 0), cA + kstep, voffA); PG8_STAGE(PG8_SB(1, 1), cB + hstep + kstep, voffB);
        PG8_WAIT_V(6); PG8_BAR;
    } else {
        PG8_STAGE(PG8_SB(0, 0), cB, voffB); PG8_STAGE(PG8_SA(0, 0), cA, voffA); PG8_STAGE(PG8_SB(0, 1), cB + hstep, voffB); PG8_STAGE(PG8_SA(0, 1), cA + hstep, voffA);
        if (wr == 1) PG8_BAR;
        PG8_WAIT_V(4); PG8_BAR;
        PG8_STAGE(PG8_SB(1, 0), cB + kstep, voffB); PG8_STAGE(PG8_SA(1, 0), cA + kstep, voffA); PG8_STAGE(PG8_SB(1, 1), cB + hstep + kstep, voffB);
        PG8_WAIT_V(6); PG8_BAR;
    }
    for (;;) {
        const bool has_next = S.next(ui + 1, nxt);
        const char* nA = has_next ? (const char*)g.A + (size_t)nxt.pm * tstep : cA; const char* nB = has_next ? (const char*)g.Bt + (size_t)nxt.pn * tstep : cB;
        for (int t = 0; t < nt; t += 2) {
            const bool last = (t == nt - 2);
            const char* a1 = cA + (size_t)(t + 1) * kstep;
            const char* a2 = last ? nA : cA + (size_t)(t + 2) * kstep; const char* b2 = last ? nB : cB + (size_t)(t + 2) * kstep;
            const char* a3 = a2 + kstep; const char* b3 = b2 + kstep;
            if (last && has_next) S.a_ready(nxt);
            if constexpr (Epi::HAS_MID) { if (t == nt / 2) E.mid(acc, cur, wr, wc, fr, fq); }
            if constexpr (SP2) {
            PG8_LDB(B0, 0, 0); PG8_LDB(B1, 0, 1); PG8_SCHED; PG8_LDA(At, 0, 0); PG8_STAGE(PG8_SA(1, 1), a1 + hstep, voffA);
            PG8_WAIT_V(8); PG8_WAIT_L(0); PG8_BAR; PG8_MMA(0, 0, At, B0); PG8_MMA(0, 1, At, B1); PG8_BAR; PG8_SCHED;
            PG8_LDA(At, 0, 1); PG8_STAGE(PG8_SB(0, 0), b2, voffB); PG8_STAGE(PG8_SB(0, 1), b2 + hstep, voffB); PG8_STAGE(PG8_SA(0, 0), a2, voffA);
            PG8_WAIT_V(8); PG8_WAIT_L(0); PG8_BAR; PG8_MMA(1, 0, At, B0); PG8_MMA(1, 1, At, B1); PG8_BAR; PG8_SCHED;
            PG8_LDB(B0, 1, 0); PG8_LDB(B1, 1, 1); PG8_SCHED; PG8_LDA(At, 1, 0); PG8_STAGE(PG8_SA(0, 1), a2 + hstep, voffA);
            PG8_WAIT_V(8); PG8_WAIT_L(0); PG8_BAR; PG8_MMA(0, 0, At, B0); PG8_MMA(0, 1, At, B1); PG8_BAR; PG8_SCHED;
            PG8_LDA(At, 1, 1); PG8_STAGE(PG8_SB(1, 0), b3, voffB); PG8_STAGE(PG8_SB(1, 1), b3 + hstep, voffB); PG8_STAGE(PG8_SA(1, 0), a3, voffA);
            PG8_WAIT_V(8); PG8_WAIT_L(0); PG8_BAR; PG8_MMA(1, 0, At, B0); PG8_MMA(1, 1, At, B1); PG8_BAR; PG8_SCHED;
            } else {
            PG8_LDB(B0, 0, 0); PG8_SCHED; PG8_LDA(At, 0, 0); PG8_STAGE(PG8_SA(1, 1), a1 + hstep, voffA);
            PG8_WAIT_L(8); PG8_BAR; PG8_WAIT_L(0); PG8_MMA(0, 0, At, B0); PG8_BAR; PG8_SCHED;
            PG8_LDB(B1, 0, 1); PG8_STAGE(PG8_SB(0, 0), b2, voffB);
            PG8_BAR; PG8_WAIT_L(0); PG8_MMA(0, 1, At, B1); PG8_BAR;
            PG8_LDA(At, 0, 1); PG8_STAGE(PG8_SA(0, 0), a2, voffA);
            PG8_BAR; PG8_WAIT_L(0); PG8_MMA(1, 0, At, B0); PG8_BAR; PG8_SCHED;
            PG8_STAGE(PG8_SB(0, 1), b2 + hstep, voffB);
            PG8_WAIT_V(6); PG8_BAR; PG8_MMA(1, 1, At, B1); PG8_BAR;
            PG8_LDB(B0, 1, 0); PG8_SCHED; PG8_LDA(At, 1, 0); PG8_STAGE(PG8_SA(0, 1), a2 + hstep, voffA);
            PG8_WAIT_L(8); PG8_BAR; PG8_WAIT_L(0); PG8_MMA(0, 0, At, B0); PG8_BAR; PG8_SCHED;
            PG8_LDB(B1, 1, 1); PG8_STAGE(PG8_SB(1, 0), b3, voffB);
            PG8_BAR; PG8_WAIT_L(0); PG8_MMA(0, 1, At, B1); PG8_BAR;
            PG8_LDA(At, 1, 1); PG8_STAGE(PG8_SA(1, 0), a3, voffA);
            PG8_BAR; PG8_WAIT_L(0); PG8_MMA(1, 0, At, B0); PG8_BAR; PG8_SCHED;
            PG8_STAGE(PG8_SB(1, 1), b3 + hstep, voffB);
            PG8_WAIT_V(6); PG8_BAR; PG8_MMA(1, 1, At, B1); PG8_BAR;
            }
        }
        if constexpr (ALIGN_EPI) { if (wr == 0) PG8_BAR; }
        if constexpr (!Epi::AFTER_DRAIN) { E(acc, cur, wr, wc, fr, fq); S.done(cur); }
        if (!has_next) break;
#pragma unroll
        for (int a = 0; a < 2; ++a)
#pragma unroll
            for (int b = 0; b < 2; ++b)
#pragma unroll
                for (int m = 0; m < 4; ++m)
#pragma unroll
                    for (int n = 0; n < 2; ++n) acc[a][b][m][n] = (f32x4){0.f, 0.f, 0.f, 0.f};
        cur = nxt; cA = nA; cB = nB; ++ui;
        if constexpr (ALIGN_EPI) { if (wr == 1) PG8_BAR; }
    }
    PG8_WAIT_V(0);
    if constexpr (!ALIGN_EPI) { if (wr == 0) PG8_BAR; }
    PG8_BAR;
    if constexpr (Epi::AFTER_DRAIN) { E.fused(acc, cur, wr, wc, fr, fq, lds, wid, lane); S.done(cur); }
#undef PG8_SA
#undef PG8_SB
#undef PG8_STAGE
#undef PG8_LDA
#undef PG8_LDB
#undef PG8_MMA
#undef PG8_WAIT_V
#undef PG8_WAIT_L
#undef PG8_BAR
#undef PG8_SCHED
}
}

#define DEV __device__ __forceinline__
#define LAS __attribute__((address_space(3)))
typedef unsigned short bf16;
typedef float f32x4 __attribute__((ext_vector_type(4)));
typedef unsigned u32x4 __attribute__((ext_vector_type(4)));
typedef unsigned u32x2 __attribute__((ext_vector_type(2)));

constexpr int D = 1024, NTOK = 10240, NCTX = 8192, DEPTH = 4, NH = 16, HP = 64, NGRP = 4, NST = 128, DIN = 8224;
constexpr int NPROJ = 8192;
constexpr int NCHUNK = 80;
constexpr float EPS = 1e-6f;
constexpr int PC_XBC = 0, PC_ZM = 2048, PC_U = 3072, PC_V = 4096, PC_ZG = 5120, PC_GLM = 6144, PC_GLG = 7168;

constexpr size_t MiB = 1u << 20;
constexpr size_t WS_CTL = 0, CTL_BYTES = 2 * MiB;
constexpr size_t CTL_SSQ = 64 * 1024;
constexpr size_t CTL_SSQX = 256 * 1024;
constexpr size_t CTL_GSUM = 512 * 1024;
constexpr size_t CTL_SW = 1 * MiB;
constexpr size_t WS_MOD = 2 * MiB;
constexpr size_t WS_GN = WS_MOD + 256 * 1024;
constexpr size_t WS_WDT = WS_GN + 192 * 1024;
constexpr size_t WS_WSPB = 3 * MiB;
constexpr size_t WS_WSPR = WS_GN + 64 * 1024;
constexpr size_t WS_DTRAW = 4 * MiB;
constexpr size_t WS_WIN = 6 * MiB;
constexpr size_t WS_WMG = WS_WIN + 64 * MiB;
constexpr size_t WS_WO = WS_WMG + 16 * MiB;
constexpr size_t WS_HBUF = WS_WO + 8 * MiB;
constexpr size_t WS_AMG = WS_HBUF + 20 * MiB;
constexpr size_t WS_PROJ = WS_AMG + 40 * MiB;
constexpr size_t WS_XBUF = WS_PROJ + 160 * MiB;
constexpr size_t WS_MRG = WS_XBUF + 40 * MiB;
constexpr size_t WS_XBCS = WS_MRG + 20 * MiB;
constexpr size_t WS_SINB = WS_XBCS + 40 * MiB;
constexpr size_t WS_TB = WS_SINB + 40 * MiB;
constexpr int TBW = 1536;
constexpr size_t WS_END = WS_TB + 8 * MiB;

#ifndef DUP_MASK
#define DUP_MASK 0
#endif
constexpr size_t CTL_DUMMY = 1536 * 1024;
constexpr int LDS_BYTES = 155648;

DEV float bf2f(unsigned v) { return __uint_as_float(v << 16); }
DEV unsigned f2bf(float f) { unsigned u = __float_as_uint(f); return (u + 0x7fffu + ((u >> 16) & 1u)) >> 16; }
DEV unsigned pk2(float lo, float hi) { return f2bf(lo) | (f2bf(hi) << 16); }
DEV float sigmoid_f(float x) { return __builtin_amdgcn_rcpf(1.f + __expf(-x)); }
DEV float silu_f(float x) { return x * __builtin_amdgcn_rcpf(1.f + __expf(-x)); }
DEV float gelu_f(float x) { return x * sigmoid_f(1.5957691216f * (x + 0.044715f * x * x * x)); }
DEV float softplus_f(float x) { const float e = __expf(x); const float sm = e * (1.f - e * (0.5f - e * 0.33333333f)); return x > 20.f ? x : (e < 0.03f ? sm : __logf(1.f + e)); }
DEV float shfl_idx(float v, int src_lane) { return __int_as_float(__builtin_amdgcn_ds_bpermute(src_lane << 2, __float_as_int(v))); }
DEV float shfl_x(float v, int o, int lane) { return shfl_idx(v, lane ^ o); }
DEV float wave_sum(float v, int lane) {
#pragma unroll
    for (int o = 1; o < 64; o <<= 1) v += shfl_x(v, o, lane);
    return v;
}

struct Args { const float* in[23]; float* out; unsigned char* ws; int step_lo, step_hi; };

struct Frame {
    LAS unsigned char* lds;
    int tid, lane, wave, G, bid, z;
    const float* const* in;
    float* out; unsigned char* ws;
};
DEV Frame launder(const Frame& F0) {
    Frame F = F0;
    F.z = 0; asm volatile("" : "+s"(F.z), "+s"(F.out), "+s"(F.ws), "+s"(F.G), "+s"(F.bid), "+s"(F.wave));
    F.tid = F.wave * 64 + (int)__builtin_amdgcn_mbcnt_hi(~0u, __builtin_amdgcn_mbcnt_lo(~0u, 0u));
    asm volatile("" : "+v"(F.tid));
    F.lane = F.tid & 63;
    return F;
}
#define IN_XP 0
#define IN_XS 1
#define IN_STATE 2
#define IN_C 3
#define IN_CCTX 4
#define IN_WADA 5
#define IN_BADA 6
#define IN_NORMW 7
#define IN_WIN 8
#define IN_CONVW 9
#define IN_CONVB 10
#define IN_DTBIAS 11
#define IN_ALOG 12
#define IN_DSKIP 13
#define IN_SSMNW 14
#define IN_WOUTM 15
#define IN_LNW 16
#define IN_LNB 17
#define IN_WSP 18
#define IN_BSP 19
#define IN_WOUTG 20
#define IN_WOUT 21
#define IN_FNW 22

DEV int scan_to_row(int sr, int layer) {
    if (sr < NCTX || !(layer & 1)) return sr;
    const int lb = (sr - NCTX) >> 10, q = (sr - NCTX) & 1023;
    return NCTX + lb * 1024 + (q & 15) * 64 + (q >> 4);
}

DEV void ph_mod(const Frame& F0) {
    Frame F = launder(F0);
    LAS float* sc = (LAS float*)F.lds;
    LAS float* part = sc + 3 * 1024;
    for (int i = F.tid; i < 3 * 1024; i += 512) { const int v = i >> 10, k = i & 1023; const float c = v == 0 ? F.in[IN_CCTX + F.z][k] : F.in[IN_C + F.z][(v - 1) * 1024 + k]; sc[i] = silu_f(c); }
    __syncthreads();
    float* mod = (float*)(F.ws + WS_MOD);
    for (int it = F.bid; it < DEPTH * 96; it += F.G) {
        const int l = it / 96, jl = F.tid & 31, j = (it % 96) * 32 + jl, kq = F.tid >> 5;
        const float* w = F.in[IN_WADA + F.z] + (size_t)l * 1024 * 3072 + (size_t)(kq * 64) * 3072 + j;
        float wv[64];
#pragma unroll
        for (int k = 0; k < 64; ++k) wv[k] = w[(size_t)k * 3072];
        float a0 = 0.f, a1 = 0.f, a2 = 0.f;
#pragma unroll
        for (int k = 0; k < 64; ++k) { a0 += sc[kq * 64 + k] * wv[k]; a1 += sc[1024 + kq * 64 + k] * wv[k]; a2 += sc[2048 + kq * 64 + k] * wv[k]; }
        __syncthreads();
        part[(kq * 3 + 0) * 32 + jl] = a0; part[(kq * 3 + 1) * 32 + jl] = a1; part[(kq * 3 + 2) * 32 + jl] = a2;
        __syncthreads();
        if (F.tid < 96) { const int v = F.tid >> 5, jj = F.tid & 31, col = (it % 96) * 32 + jj; float t = F.in[IN_BADA + F.z][l * 3072 + col];
#pragma unroll
            for (int q = 0; q < 16; ++q) t += part[(q * 3 + v) * 32 + jj];
            mod[(l * 3 + v) * 3072 + col] = t; }
    }
}

DEV void cvt_item(const float* W, int ldw, int k0, int n0, bf16* WT, int ldt, int k0d, int drow0, LAS float* scr, int lane, const LAS float* shift3, float* sw3) {
    float wv_[32];
#pragma unroll
    for (int i = 0; i < 32; ++i) wv_[i] = W[(size_t)(k0 + 2 * i + (lane >> 5)) * ldw + n0 + (lane & 31)];
#pragma unroll
    for (int i = 0; i < 32; ++i) scr[(2 * i + (lane >> 5)) * 33 + (lane & 31)] = wv_[i];
    asm volatile("s_waitcnt lgkmcnt(0)" ::: "memory");
    const int c = lane & 7;
#pragma unroll
    for (int j = 0; j < 4; ++j) { const int n = (lane >> 3) + 8 * j; const LAS float* s = scr + (8 * c) * 33 + n;
        u32x4 o; o.x = pk2(s[0 * 33], s[1 * 33]); o.y = pk2(s[2 * 33], s[3 * 33]); o.z = pk2(s[4 * 33], s[5 * 33]); o.w = pk2(s[6 * 33], s[7 * 33]);
        *(u32x4*)(WT + (size_t)(drow0 + n) * ldt + k0d + 8 * c) = o; }
    if (shift3) {
        const int n = lane & 31, kh = (lane >> 5) * 32;
        float a0 = 0.f, a1 = 0.f, a2 = 0.f;
#pragma unroll 8
        for (int kk = 0; kk < 32; ++kk) { const float wv = scr[(kh + kk) * 33 + n]; a0 += shift3[k0 + kh + kk] * wv; a1 += shift3[1024 + k0 + kh + kk] * wv; a2 += shift3[2048 + k0 + kh + kk] * wv; }
        a0 += shfl_x(a0, 32, lane); a1 += shfl_x(a1, 32, lane); a2 += shfl_x(a2, 32, lane);
        if (lane < 32) { atomicAdd(sw3 + n0 + n, a0); atomicAdd(sw3 + DIN + n0 + n, a1); atomicAdd(sw3 + 2 * DIN + n0 + n, a2); }
    }
    asm volatile("s_waitcnt lgkmcnt(0)" ::: "memory");
}
DEV void ph_cvt(const Frame& F0, int l, int wg0, int nwg) {
    Frame F = launder(F0);
    asm volatile("" : "+s"(l));
    if (F.bid < wg0) return;
    LAS float* scr = (LAS float*)(F.lds + F.wave * 16384);
    LAS float* shl = (LAS float*)(F.lds + 8 * 16384);
    for (int i = F.tid; i < 3 * 1024; i += 512) shl[i] = ((const float*)(F.ws + WS_MOD))[(size_t)l * 3 * 3072 + (i >> 10) * 3072 + (i & 1023)];
    __syncthreads();
    const int gw = (F.bid - wg0) * 8 + F.wave, NGW = nwg * 8;
    constexpr int I_IN = 16 * 257, I_O = 16 * 32, PER_L = I_IN + 3 * I_O;
    for (int it = gw; it < PER_L; it += NGW) {
        int r = it;
        if (r < I_IN) { const int kb = r / 257, nb = r % 257;
            const LAS float* shift3 = shl;
            float* sw3 = (float*)(F.ws + WS_CTL + CTL_SW) + (size_t)l * 3 * DIN;
            if (nb == 96) cvt_item(F.in[IN_WIN + F.z] + (size_t)l * 1024 * DIN, DIN, 64 * kb, 3072, (bf16*)(F.ws + WS_WDT) + (size_t)l * 32 * 1024, 1024, 64 * kb, 0, scr, F.lane, shift3, sw3);
            else { const int c = 32 * nb;
                int drow;
                if (c < 3072) drow = c;
                else if (c < 4128) { const int cc = c - 3104; drow = (12 + (cc >> 7)) * 256 + (cc & 127); }
                else if (c < 5152) drow = 5120 + (c - 4128);
                else if (c < 6176) { const int cc = c - 5152; drow = (12 + (cc >> 7)) * 256 + 128 + (cc & 127); }
                else if (c < 7200) { const int cc = c - 6176; drow = (24 + (cc >> 7)) * 256 + (cc & 127); }
                else { const int cc = c - 7200; drow = (24 + (cc >> 7)) * 256 + 128 + (cc & 127); }
                cvt_item(F.in[IN_WIN + F.z] + (size_t)l * 1024 * DIN, DIN, 64 * kb, c, (bf16*)(F.ws + WS_WIN) + (size_t)l * NPROJ * 1024, 1024, 64 * kb, drow, scr, F.lane, shift3, sw3); }
            continue; }
        r -= I_IN;
        const int which = r / I_O; r %= I_O; const int kb = r >> 5, nb = r & 31;
        const float* W = (which == 0 ? F.in[IN_WOUTM + F.z] : which == 1 ? F.in[IN_WOUTG + F.z] : F.in[IN_WOUT + F.z]) + (size_t)l * 1024 * 1024;
        if (which < 2) cvt_item(W, 1024, 64 * kb, 32 * nb, (bf16*)(F.ws + WS_WMG) + (size_t)l * 1024 * 2048, 2048, which * 1024 + 64 * kb, 32 * nb, scr, F.lane, (const LAS float*)nullptr, nullptr);
        else cvt_item(W, 1024, 64 * kb, 32 * nb, (bf16*)(F.ws + WS_WO) + (size_t)l * 1024 * 1024, 1024, 64 * kb, 32 * nb, scr, F.lane, (const LAS float*)nullptr, nullptr);
    }
}
DEV void ph_gn(const Frame& F0) {
    Frame F = launder(F0);
    float* gn = (float*)(F.ws + WS_GN);
    for (int i = F.bid * 512 + F.tid; i < DEPTH * 3 * 1024; i += F.G * 512) { const int c = i & 1023, lv = i >> 10, l = lv / 3;
        gn[i] = F.in[IN_NORMW + F.z][l * 1024 + c] * (1.f + ((const float*)(F.ws + WS_MOD))[lv * 3072 + 1024 + c]); }
    const f32x4* wsp = (const f32x4*)F.in[IN_WSP + F.z]; u32x2* wb = (u32x2*)(F.ws + WS_WSPB);
    for (int i = F.bid * 512 + F.tid; i < DEPTH * 8 * 128 * 128 / 4; i += F.G * 512) { const f32x4 w = wsp[i]; u32x2 o; o.x = pk2(w.x, w.y); o.y = pk2(w.z, w.w); wb[i] = o; }
    float* wr = (float*)(F.ws + WS_WSPR);
    for (int row = F.bid * 8 + F.wave; row < DEPTH * 8 * 128; row += F.G * 8) {
        const float* r = F.in[IN_WSP + F.z] + (size_t)row * 128;
        float t = bf2f(f2bf(r[F.lane])) + bf2f(f2bf(r[64 + F.lane]));
        t = wave_sum(t, F.lane);
        if (F.lane == 0) wr[row] = t;
    }
}

DEV void ph_prep0(const Frame& F0) {
    Frame F = launder(F0);
    const int gw = F.bid * 8 + F.wave, NGW = F.G * 8;
    const float* nw = F.in[IN_NORMW + F.z];
    float* ssqx = (float*)(F.ws + WS_CTL + CTL_SSQX);
    for (int row = gw; row < NTOK; row += NGW) {
        const int mv = row < NCTX ? 0 : 1 + ((row - NCTX) >> 10);
        const float* md = (const float*)(F.ws + WS_MOD) + mv * 3072;
        const f32x4* xr = (const f32x4*)(row < NCTX ? F.in[IN_XP + F.z] + (size_t)row * D : F.in[IN_XS + F.z] + (size_t)(row - NCTX) * D) + F.lane;
        f32x4 v[4]; float s = 0.f;
#pragma unroll
        for (int j = 0; j < 4; ++j) { v[j] = xr[64 * j]; s += (v[j].x * v[j].x + v[j].y * v[j].y) + (v[j].z * v[j].z + v[j].w * v[j].w); }
        s = wave_sum(s, F.lane);
        if (F.lane == 0) ssqx[row] = s;
        unsigned long long* o8 = (unsigned long long*)((bf16*)(F.ws + WS_HBUF) + (size_t)row * D) + F.lane;
#pragma unroll
        for (int j = 0; j < 4; ++j) { const int c0 = 4 * (F.lane + 64 * j);
            const f32x4 w4 = *(const f32x4*)(nw + c0), sc = *(const f32x4*)(md + 1024 + c0);
            v[j] = v[j] * w4 * (sc + 1.f);
            o8[64 * j] = (unsigned long long)pk2(v[j].x, v[j].y) | ((unsigned long long)pk2(v[j].z, v[j].w) << 32); }
    }
}

DEV void ph_final(const Frame& F0) {
    Frame F = launder(F0);
    const int gw = F.bid * 8 + F.wave, NGW = F.G * 8;
    const float* nw = F.in[IN_FNW + F.z];
    const float* ssqx = (const float*)(F.ws + WS_CTL + CTL_SSQX) + 4 * NTOK;
    for (int row = gw; row < NTOK; row += NGW) {
        const f32x4* xr = (const f32x4*)((const float*)(F.ws + WS_XBUF) + (size_t)row * D) + F.lane;
        const float rstd = rsqrtf(ssqx[row] * (1.f / D) + EPS);
        f32x4* o = (f32x4*)(F.out + (size_t)row * D) + F.lane;
#pragma unroll
        for (int j = 0; j < 4; ++j) o[64 * j] = xr[64 * j] * rstd * *(const f32x4*)(nw + 4 * (F.lane + 64 * j));
    }
}

typedef short bf16x8 __attribute__((ext_vector_type(8)));
typedef short s16x4 __attribute__((ext_vector_type(4)));
typedef float f32x16 __attribute__((ext_vector_type(16)));
typedef float f32x2 __attribute__((ext_vector_type(2)));
typedef __bf16 bf16x2_t __attribute__((ext_vector_type(2)));
#define MFMA32(a, b, c) __builtin_amdgcn_mfma_f32_32x32x16_bf16((a), (b), (c), 0, 0, 0)
DEV unsigned pkbf(float a, float b) { const f32x2 v = {a, b}; return __builtin_bit_cast(unsigned, __builtin_convertvector(v, bf16x2_t)); }
DEV bf16x8 pack8(float a0, float a1, float a2, float a3, float a4, float a5, float a6, float a7) {
    u32x4 p; p.x = pkbf(a0, a1); p.y = pkbf(a2, a3); p.z = pkbf(a4, a5); p.w = pkbf(a6, a7); return __builtin_bit_cast(bf16x8, p); }
DEV int crow(int r, int hh) { return (r & 3) + 8 * (r >> 2) + 4 * hh; }

struct ChunkGeo { int seq_row0, pos0, L; bool cm; };
DEV ChunkGeo chunk_geo(int ck, int layer) {
    ChunkGeo g;
    if (ck < 64) { g.seq_row0 = (ck >> 1) * 256; g.pos0 = (ck & 1) * 128; g.L = 256; g.cm = false; }
    else { const int lb = (ck - 64) >> 3; g.seq_row0 = NCTX + lb * 1024; g.pos0 = ((ck - 64) & 7) * 128; g.L = 1024; g.cm = (layer & 1) != 0; }
    return g;
}
DEV int geo_row(const ChunkGeo& g, int Q) { return g.seq_row0 + (g.cm ? (Q & 15) * 64 + (Q >> 4) : Q); }

DEV void chunk_tables2(Frame& F, int layer, const ChunkGeo& geo, int h, LAS float* tb) {
    if (F.wave < 2) {
        const int dir = F.wave;
        const float a = -__expf(F.in[IN_ALOG + F.z][layer * 32 + dir * 16 + h]);
        const float bias = F.in[IN_DTBIAS + F.z][layer * 32 + dir * 16 + h];
        const float* dtr = (const float*)(F.ws + WS_DTRAW);
        const int q0 = 2 * F.lane;
        const float d0 = softplus_f(dtr[(size_t)geo_row(geo, geo.pos0 + q0) * 32 + dir * 16 + h] + bias);
        const float d1 = softplus_f(dtr[(size_t)geo_row(geo, geo.pos0 + q0 + 1) * 32 + dir * 16 + h] + bias);
        const float a0 = d0 * a, a1 = d1 * a;
        float sc = a0 + a1, c0, c1, tot;
        if (dir == 0) {
#pragma unroll
            for (int o = 1; o < 64; o <<= 1) { const float t = shfl_idx(sc, (F.lane - o) & 63); if (F.lane >= o) sc += t; }
            c1 = sc; c0 = sc - a1; tot = shfl_idx(c1, 63);
        } else {
#pragma unroll
            for (int o = 1; o < 64; o <<= 1) { const float t = shfl_idx(sc, (F.lane + o) & 63); if (F.lane + o < 64) sc += t; }
            c0 = sc; c1 = sc - a0; tot = shfl_idx(c0, 0);
        }
        LAS float* t = tb + dir * 128 + q0;
        t[0] = c0; t[1] = c1; t[256] = d0; t[257] = d1; t[512] = __expf(c0); t[513] = __expf(c1);
        t[768] = d0 * __expf(tot - c0); t[769] = d1 * __expf(tot - c1);
    }
    __syncthreads();
}

template <int NC, int MODE>
DEV void stage_conv(Frame& F, int layer, const ChunkGeo& geo, int col0, LAS unsigned char* img0, LAS unsigned char* img1, int pitch, const LAS float* tb, bf16* gdst = nullptr) {
    constexpr int CG = NC / 8, NT = CG * 32;
    if (F.tid < NT) {
        const int cg = F.tid % CG, tg = F.tid / CG, ch0 = col0 + cg * 8, q0 = tg * 4;
        const bf16* proj = (const bf16*)(F.ws + WS_PROJ);
        float x[8][8];
#pragma unroll
        for (int i = 0; i < 8; ++i) {
            const int Q = geo.pos0 + q0 - 2 + i;
            u32x4 raw = {0u, 0u, 0u, 0u};
            if (Q >= 0 && Q < geo.L) raw = *(const u32x4*)(proj + (size_t)geo_row(geo, Q) * NPROJ + PC_XBC + ch0);
            x[i][0] = bf2f(raw.x & 0xffffu); x[i][1] = bf2f(raw.x >> 16); x[i][2] = bf2f(raw.y & 0xffffu); x[i][3] = bf2f(raw.y >> 16);
            x[i][4] = bf2f(raw.z & 0xffffu); x[i][5] = bf2f(raw.z >> 16); x[i][6] = bf2f(raw.w & 0xffffu); x[i][7] = bf2f(raw.w >> 16);
        }
        const float* cw = F.in[IN_CONVW + F.z] + layer * 5 * 2048 + ch0; const float* cb = F.in[IN_CONVB + F.z] + layer * 2048 + ch0;
        float acc[4][8];
        { const f32x4 b0 = *(const f32x4*)cb, b1 = *(const f32x4*)(cb + 4);
#pragma unroll
          for (int t = 0; t < 4; ++t) { acc[t][0] = b0.x; acc[t][1] = b0.y; acc[t][2] = b0.z; acc[t][3] = b0.w; acc[t][4] = b1.x; acc[t][5] = b1.y; acc[t][6] = b1.z; acc[t][7] = b1.w; } }
#pragma unroll
        for (int k = 0; k < 5; ++k) {
            const f32x4 w0 = *(const f32x4*)(cw + k * 2048), w1 = *(const f32x4*)(cw + k * 2048 + 4);
            const float w[8] = {w0.x, w0.y, w0.z, w0.w, w1.x, w1.y, w1.z, w1.w};
#pragma unroll
            for (int t = 0; t < 4; ++t)
#pragma unroll
                for (int c = 0; c < 8; ++c) acc[t][c] += w[c] * x[t + k][c];
        }
#pragma unroll
        for (int t = 0; t < 4; ++t) {
            float v[8];
#pragma unroll
            for (int c = 0; c < 8; ++c) v[c] = silu_f(acc[t][c]);
            const int s = q0 + t;
            if (MODE == 0) {
                u32x4 o; o.x = pkbf(v[0], v[1]); o.y = pkbf(v[2], v[3]); o.z = pkbf(v[4], v[5]); o.w = pkbf(v[6], v[7]);
                *(LAS u32x4*)(img0 + s * pitch + cg * 16) = o;
            } else if (MODE == 2) {
                u32x4 o; o.x = pkbf(v[0], v[1]); o.y = pkbf(v[2], v[3]); o.z = pkbf(v[4], v[5]); o.w = pkbf(v[6], v[7]);
                *(u32x4*)(gdst + (size_t)s * 2048 + cg * 8) = o;
            } else {
                const float sf = tb[768 + s], sb = tb[896 + s];
                u32x4 o; o.x = pkbf(v[0] * sf, v[1] * sf); o.y = pkbf(v[2] * sf, v[3] * sf); o.z = pkbf(v[4] * sf, v[5] * sf); o.w = pkbf(v[6] * sf, v[7] * sf);
                *(LAS u32x4*)(img0 + s * pitch + cg * 16) = o;
                o.x = pkbf(v[0] * sb, v[1] * sb); o.y = pkbf(v[2] * sb, v[3] * sb); o.z = pkbf(v[4] * sb, v[5] * sb); o.w = pkbf(v[6] * sb, v[7] * sb);
                *(LAS u32x4*)(img1 + s * pitch + cg * 16) = o;
            }
        }
    }
}

DEV bf16x8 tr2(const LAS unsigned char* img, int pitch, int row0, int row1, int col0, int lane) {
    const int i = lane & 15, blk = (lane >> 4) & 1;
    const int off = (i >> 2) * pitch + (col0 + 16 * blk + 4 * (i & 3)) * 2;
    const s16x4 lo = __builtin_amdgcn_ds_read_tr16_b64_v4i16((LAS s16x4*)(img + row0 * pitch + off));
    const s16x4 hi = __builtin_amdgcn_ds_read_tr16_b64_v4i16((LAS s16x4*)(img + row1 * pitch + off));
    return __builtin_shufflevector(lo, hi, 0, 1, 2, 3, 4, 5, 6, 7);
}

DEV void conv_tables(Frame& F, int layer, int ck, int j16) {
    const ChunkGeo geo = chunk_geo(ck, layer);
    if (F.wave < 2) {
        const int dir = F.wave & 1, h = j16;
        const float a = -__expf(F.in[IN_ALOG + F.z][layer * 32 + dir * 16 + h]);
        const float bias = F.in[IN_DTBIAS + F.z][layer * 32 + dir * 16 + h];
        const float* dtr = (const float*)(F.ws + WS_DTRAW);
        const int q0 = 2 * F.lane;
        const float d0 = softplus_f(dtr[(size_t)geo_row(geo, geo.pos0 + q0) * 32 + dir * 16 + h] + bias);
        const float d1 = softplus_f(dtr[(size_t)geo_row(geo, geo.pos0 + q0 + 1) * 32 + dir * 16 + h] + bias);
        const float a0 = d0 * a, a1 = d1 * a;
        float sc = a0 + a1, c0, c1, tot;
        if (dir == 0) {
#pragma unroll
            for (int o = 1; o < 64; o <<= 1) { const float t = shfl_idx(sc, (F.lane - o) & 63); if (F.lane >= o) sc += t; }
            c1 = sc; c0 = sc - a1; tot = shfl_idx(c1, 63);
        } else {
#pragma unroll
            for (int o = 1; o < 64; o <<= 1) { const float t = shfl_idx(sc, (F.lane + o) & 63); if (F.lane + o < 64) sc += t; }
            c0 = sc; c1 = sc - a0; tot = shfl_idx(c0, 0);
        }
        float* tbase = (float*)(F.ws + WS_TB) + (size_t)(ck * 16 + h) * TBW;
        *(f32x2*)(tbase + q0 * 4 + dir * 2) = (f32x2){c0, d0}; *(f32x2*)(tbase + (q0 + 1) * 4 + dir * 2) = (f32x2){c1, d1};
        float* t = tbase + dir * 128 + q0;
        *(f32x2*)(t + 512) = (f32x2){__expf(c0), __expf(c1)};
        *(f32x2*)(t + 768) = (f32x2){d0 * __expf(tot - c0), d1 * __expf(tot - c1)};
        const float cbs = shfl_idx(c0, F.lane & ~15), cbe = shfl_idx(c1, F.lane | 15);
        if (dir == 0) { *(f32x2*)(t + 1024) = (f32x2){d0 * __expf(cbe - c0), d1 * __expf(cbe - c1)}; *(f32x2*)(t + 1280) = (f32x2){__expf(c0 - cbs), __expf(c1 - cbs)}; }
        else          { *(f32x2*)(t + 1024) = (f32x2){d0 * __expf(cbs - c0), d1 * __expf(cbs - c1)}; *(f32x2*)(t + 1280) = (f32x2){__expf(c0 - cbe), __expf(c1 - cbe)}; }
    }
}
DEV void conv_rows_load(Frame& F, const ChunkGeo& geo, int col0, u32x4 (&raw)[8]) {
    const int cg = F.tid & 15, tg = F.tid >> 4, ch0 = col0 + cg * 8, q0 = tg * 4;
    const bf16* proj = (const bf16*)(F.ws + WS_PROJ);
#pragma unroll
    for (int i = 0; i < 8; ++i) { const int Q = geo.pos0 + q0 - 2 + i; raw[i] = (u32x4){0u, 0u, 0u, 0u};
        if (Q >= 0 && Q < geo.L) raw[i] = *(const u32x4*)(proj + (size_t)geo_row(geo, Q) * NPROJ + PC_XBC + ch0); }
}
DEV void conv_rows_compute(Frame& F, int layer, int col0, const u32x4 (&raw)[8], bf16* gdst) {
    const int cg = F.tid & 15, tg = F.tid >> 4, ch0 = col0 + cg * 8, q0 = tg * 4;
    float x[8][8];
#pragma unroll
    for (int i = 0; i < 8; ++i) { const u32x4 r = raw[i];
        x[i][0] = bf2f(r.x & 0xffffu); x[i][1] = bf2f(r.x >> 16); x[i][2] = bf2f(r.y & 0xffffu); x[i][3] = bf2f(r.y >> 16);
        x[i][4] = bf2f(r.z & 0xffffu); x[i][5] = bf2f(r.z >> 16); x[i][6] = bf2f(r.w & 0xffffu); x[i][7] = bf2f(r.w >> 16); }
    const float* cw = F.in[IN_CONVW + F.z] + layer * 5 * 2048 + ch0; const float* cb = F.in[IN_CONVB + F.z] + layer * 2048 + ch0;
    float acc[4][8];
    { const f32x4 b0 = *(const f32x4*)cb, b1 = *(const f32x4*)(cb + 4);
#pragma unroll
      for (int t = 0; t < 4; ++t) { acc[t][0] = b0.x; acc[t][1] = b0.y; acc[t][2] = b0.z; acc[t][3] = b0.w; acc[t][4] = b1.x; acc[t][5] = b1.y; acc[t][6] = b1.z; acc[t][7] = b1.w; } }
#pragma unroll
    for (int k = 0; k < 5; ++k) {
        const f32x4 w0 = *(const f32x4*)(cw + k * 2048), w1 = *(const f32x4*)(cw + k * 2048 + 4);
        const float w[8] = {w0.x, w0.y, w0.z, w0.w, w1.x, w1.y, w1.z, w1.w};
#pragma unroll
        for (int t = 0; t < 4; ++t)
#pragma unroll
            for (int c = 0; c < 8; ++c) acc[t][c] += w[c] * x[t + k][c];
    }
#pragma unroll
    for (int t = 0; t < 4; ++t) {
        float v[8];
#pragma unroll
        for (int c = 0; c < 8; ++c) v[c] = silu_f(acc[t][c]);
        u32x4 o; o.x = pkbf(v[0], v[1]); o.y = pkbf(v[2], v[3]); o.z = pkbf(v[4], v[5]); o.w = pkbf(v[6], v[7]);
        *(u32x4*)(gdst + (size_t)(q0 + t) * 2048 + cg * 8) = o;
    }
}
DEV void ph_b0(const Frame& F0, int layer) {
    Frame F = launder(F0);
    asm volatile("" : "+s"(layer));
    int it = F.bid;
    u32x4 raw[8];
    if (it < NCHUNK * 16) { const ChunkGeo g0 = chunk_geo(it >> 4, layer); conv_rows_load(F, g0, (it & 15) * 128, raw); }
    while (it < NCHUNK * 16) {
        Frame Fi = launder(F);
        const int itn = it + Fi.G;
        u32x4 nraw[8];
        if (itn < NCHUNK * 16) { const ChunkGeo gn = chunk_geo(itn >> 4, layer); conv_rows_load(Fi, gn, (itn & 15) * 128, nraw); }
        conv_tables(Fi, layer, it >> 4, it & 15);
        conv_rows_compute(Fi, layer, (it & 15) * 128, raw, (bf16*)(Fi.ws + WS_XBCS) + (size_t)(it >> 4) * 128 * 2048 + (it & 15) * 128);
#pragma unroll
        for (int i = 0; i < 8; ++i) raw[i] = nraw[i];
        it = itn;
    }
}

struct S1Regs { u32x4 bq[4], xq[2]; float wf[2], wb[2], atF, atB; };
DEV void s1_load(Frame& F, int ck, int h, S1Regs& R) {
    const bf16* xc = (const bf16*)(F.ws + WS_XBCS) + (size_t)ck * 128 * 2048;
    const float* T = (const float*)(F.ws + WS_TB) + (size_t)(ck * 16 + h) * TBW;
    { const int ch = F.tid & 15, r0 = F.tid >> 4;
#pragma unroll
      for (int p = 0; p < 4; ++p) R.bq[p] = *(const u32x4*)(xc + (size_t)(r0 + 32 * p) * 2048 + 1024 + (h >> 2) * 128 + ch * 8); }
    { const int ch = F.tid & 7, r0 = F.tid >> 3;
#pragma unroll
      for (int p = 0; p < 2; ++p) { const int row = r0 + 64 * p; R.xq[p] = *(const u32x4*)(xc + (size_t)row * 2048 + h * 64 + ch * 8); R.wf[p] = T[768 + row]; R.wb[p] = T[896 + row]; } }
    R.atF = T[127 * 4]; R.atB = T[2];
}
DEV void s1_store(Frame& F, const S1Regs& R, LAS unsigned char* Bi, LAS unsigned char* XF, LAS unsigned char* XB) {
    { const int ch = F.tid & 15, r0 = F.tid >> 4;
#pragma unroll
      for (int p = 0; p < 4; ++p) *(LAS u32x4*)(Bi + (r0 + 32 * p) * 320 + ch * 16) = R.bq[p]; }
    { const int ch = F.tid & 7, r0 = F.tid >> 3;
#pragma unroll
      for (int p = 0; p < 2; ++p) { const int row = r0 + 64 * p; const u32x4 r = R.xq[p]; const float wf = R.wf[p], wb = R.wb[p];
          const float v[8] = {bf2f(r.x & 0xffffu), bf2f(r.x >> 16), bf2f(r.y & 0xffffu), bf2f(r.y >> 16), bf2f(r.z & 0xffffu), bf2f(r.z >> 16), bf2f(r.w & 0xffffu), bf2f(r.w >> 16)};
          u32x4 o; o.x = pkbf(v[0] * wf, v[1] * wf); o.y = pkbf(v[2] * wf, v[3] * wf); o.z = pkbf(v[4] * wf, v[5] * wf); o.w = pkbf(v[6] * wf, v[7] * wf);
          *(LAS u32x4*)(XF + row * 192 + ch * 16) = o;
          o.x = pkbf(v[0] * wb, v[1] * wb); o.y = pkbf(v[2] * wb, v[3] * wb); o.z = pkbf(v[4] * wb, v[5] * wb); o.w = pkbf(v[6] * wb, v[7] * wb);
          *(LAS u32x4*)(XB + row * 192 + ch * 16) = o; } }
}
DEV void sin_store(Frame& F, const f32x16& S, int ck, int h, int dir, int wpi, int wni) {
    bf16* o = (bf16*)(F.ws + WS_SINB) + ((size_t)(ck * 16 + h) * 2 + dir) * 8192 + (32 * wpi) * 128 + 32 * wni + (F.lane & 31);
    const int hh = F.lane >> 5;
#pragma unroll
    for (int r = 0; r < 16; r += 2) { const unsigned w = pkbf(S[r], S[r + 1]); o[crow(r, hh) * 128] = (bf16)(w & 0xffffu); o[crow(r + 1, hh) * 128] = (bf16)(w >> 16); }
}
DEV void s1_ctx_unit(Frame& F, int layer, int seq, int h) {
    LAS unsigned char* Bi = F.lds + 4096; LAS unsigned char* XF = Bi + 128 * 320; LAS unsigned char* XB = XF + 128 * 192;
    const int hh = F.lane >> 5, wpi = F.wave >> 2, wni = F.wave & 3;
    f32x16 sf[2], sb[2]; float aF[2], aB[2];
    S1Regs R;
    s1_load(F, 2 * seq, h, R);
#pragma unroll
    for (int c = 0; c < 2; ++c) {
        __syncthreads();
        s1_store(F, R, Bi, XF, XB);
        aF[c] = R.atF; aB[c] = R.atB;
        __syncthreads();
        if (c == 0) s1_load(F, 2 * seq + 1, h, R);
#pragma unroll
        for (int r = 0; r < 16; ++r) { sf[c][r] = 0.f; sb[c][r] = 0.f; }
#pragma unroll
        for (int ks = 0; ks < 8; ++ks) {
            const int k0 = 16 * ks + 8 * hh;
            const bf16x8 b = tr2(Bi, 320, k0, k0 + 4, 32 * wni, F.lane);
            const bf16x8 xf = tr2(XF, 192, k0, k0 + 4, 32 * wpi, F.lane);
            const bf16x8 xb = tr2(XB, 192, k0, k0 + 4, 32 * wpi, F.lane);
            sf[c] = MFMA32(xf, b, sf[c]); sb[c] = MFMA32(xb, b, sb[c]);
        }
    }
    sin_store(F, sf[0], 2 * seq + 1, h, 0, wpi, wni);
    sin_store(F, sb[1], 2 * seq, h, 1, wpi, wni);
    const float eF = __expf(aF[1]), eB = __expf(aB[0]);
    float* o = F.out + (size_t)10485760 + ((size_t)((seq * 4 + layer) * 2) * 16 + h) * 8192 + (32 * wpi) * 128 + 32 * wni + (F.lane & 31);
#pragma unroll
    for (int r = 0; r < 16; ++r) { const int p = crow(r, hh); o[p * 128] = eF * sf[0][r] + sf[1][r]; o[(size_t)16 * 8192 + p * 128] = eB * sb[1][r] + sb[0][r]; }
}
DEV void s1_lat_unit(Frame& F, int layer, int lb, int h, int dir) {
    LAS unsigned char* Bi = F.lds + 4096; LAS unsigned char* XF = Bi + 128 * 320; LAS unsigned char* XB = XF + 128 * 192;
    const int hh = F.lane >> 5, wpi = F.wave >> 2, wni = F.wave & 3;
    const LAS unsigned char* XA = dir ? XB : XF;
    S1Regs R;
    s1_load(F, 64 + 8 * lb + (dir ? 7 : 0), h, R);
    f32x16 S;
    { const float* s0 = F.in[IN_STATE + F.z] + ((size_t)((lb * 4 + layer) * 2 + dir) * 16 + h) * 8192 + (32 * wpi) * 128 + 32 * wni + (F.lane & 31);
#pragma unroll
      for (int r = 0; r < 16; ++r) S[r] = s0[crow(r, hh) * 128]; }
#pragma unroll 1
    for (int i = 0; i < 8; ++i) {
        const int ck = 64 + 8 * lb + (dir ? 7 - i : i);
        sin_store(F, S, ck, h, dir, wpi, wni);
        if (i == 7) break;
        __syncthreads();
        s1_store(F, R, Bi, XF, XB);
        const float e = __expf(dir ? R.atB : R.atF);
        __syncthreads();
        if (i < 6) s1_load(F, 64 + 8 * lb + (dir ? 6 - i : i + 1), h, R);
        f32x16 st;
#pragma unroll
        for (int r = 0; r < 16; ++r) st[r] = 0.f;
#pragma unroll
        for (int ks = 0; ks < 8; ++ks) {
            const int k0 = 16 * ks + 8 * hh;
            const bf16x8 b = tr2(Bi, 320, k0, k0 + 4, 32 * wni, F.lane);
            const bf16x8 xa = tr2(XA, 192, k0, k0 + 4, 32 * wpi, F.lane);
            st = MFMA32(xa, b, st);
        }
#pragma unroll
        for (int r = 0; r < 16; ++r) S[r] = e * S[r] + st[r];
    }
}

template <int NC>
DEV void stage_copy(Frame& F, const bf16* src, LAS unsigned char* img, int pitch) {
    constexpr int CPR = NC / 8, RPP = 512 / CPR;
    const int ch = F.tid % CPR, r0 = F.tid / CPR;
#pragma unroll
    for (int p = 0; p < 128 / RPP; ++p) { const int row = r0 + p * RPP; *(LAS u32x4*)(img + row * pitch + ch * 16) = *(const u32x4*)(src + (size_t)row * 2048 + ch * 8); }
}

struct S2Head { u32x4 xq[2], sq[4]; };
DEV void s2_head_load(Frame& F, const ChunkGeo& geo, int ck, int h, S2Head& H) {
    const bool nzf = ck >= 64 || (ck & 1) == 1, nzb = ck >= 64 || (ck & 1) == 0;
    const bf16* xc = (const bf16*)(F.ws + WS_XBCS) + (size_t)ck * 128 * 2048;
    { const int ch = F.tid & 7, r0 = F.tid >> 3;
#pragma unroll
      for (int p = 0; p < 2; ++p) H.xq[p] = *(const u32x4*)(xc + (size_t)(r0 + 64 * p) * 2048 + h * 64 + ch * 8); }
    { const bf16* S = (const bf16*)(F.ws + WS_SINB) + (size_t)(ck * 16 + h) * 2 * 8192;
      const int ch = F.tid & 15, r0 = F.tid >> 4;
#pragma unroll
      for (int p = 0; p < 4; ++p) { H.sq[p] = (u32x4){0u, 0u, 0u, 0u}; if (p < 2 ? nzf : nzb) H.sq[p] = *(const u32x4*)(S + (size_t)(r0 + 32 * p) * 128 + ch * 8); } }
}
DEV void s2_head_store(Frame& F, const S2Head& H, LAS unsigned char* Xi, LAS unsigned char* Si) {
    { const int ch = F.tid & 7, r0 = F.tid >> 3;
#pragma unroll
      for (int p = 0; p < 2; ++p) *(LAS u32x4*)(Xi + (r0 + 64 * p) * 192 + ch * 16) = H.xq[p]; }
    { const int ch = F.tid & 15, r0 = F.tid >> 4;
#pragma unroll
      for (int p = 0; p < 4; ++p) *(LAS u32x4*)(Si + (r0 + 32 * p) * 272 + ch * 16) = H.sq[p]; }
}
DEV void s2_unit(Frame& F, int layer, int ck, int g, int hp, bool dummy) {
    LAS float* tb0 = (LAS float*)F.lds;
    LAS unsigned char* Ci = F.lds + 12288;
    LAS unsigned char* Bi = Ci + 128 * 272;
    LAS unsigned char* Xi = Bi + 128 * 272;
    LAS unsigned char* Si = Xi + 128 * 192;
    LAS unsigned char* stg = Ci;
    bf16* AM = (bf16*)(F.ws + WS_AMG);
    float* SSQ = dummy ? (float*)(F.ws + WS_CTL + CTL_DUMMY) : (float*)(F.ws + WS_CTL + CTL_SSQ) + layer * NTOK;
    const int hh = F.lane >> 5, li = F.wave & 3, sh = F.wave >> 2, l31 = F.lane & 31, l = 32 * li + l31;
    const ChunkGeo geo = chunk_geo(ck, layer);
    const bool has_in = ck >= 64 || (ck & 1) == (sh ^ 1);
    S2Head H;
    {
        const bf16* xc = (const bf16*)(F.ws + WS_XBCS) + (size_t)ck * 128 * 2048;
        u32x4 cq[4], bq[4];
        { const int ch = F.tid & 15, r0 = F.tid >> 4;
#pragma unroll
          for (int p = 0; p < 4; ++p) { cq[p] = *(const u32x4*)(xc + (size_t)(r0 + 32 * p) * 2048 + 1536 + g * 128 + ch * 8); bq[p] = *(const u32x4*)(xc + (size_t)(r0 + 32 * p) * 2048 + 1024 + g * 128 + ch * 8); } }
        const u32x4* tsrc = (const u32x4*)((const float*)(F.ws + WS_TB) + (size_t)(ck * 16 + 4 * g + 2 * hp) * TBW);
        const u32x4 tq = tsrc[F.tid]; u32x4 tq2 = {0u, 0u, 0u, 0u}; if (F.tid < 256) tq2 = tsrc[512 + F.tid];
        s2_head_load(F, geo, ck, 4 * g + 2 * hp, H);
        { const int ch = F.tid & 15, r0 = F.tid >> 4;
#pragma unroll
          for (int p = 0; p < 4; ++p) { *(LAS u32x4*)(Ci + (r0 + 32 * p) * 272 + ch * 16) = cq[p]; *(LAS u32x4*)(Bi + (r0 + 32 * p) * 272 + ch * 16) = bq[p]; } }
        *(LAS u32x4*)(tb0 + F.tid * 4) = tq; if (F.tid < 256) *(LAS u32x4*)(tb0 + 2048 + F.tid * 4) = tq2;
        s2_head_store(F, H, Xi, Si);
    }
    __syncthreads();
    bf16x8 cf[8];
#pragma unroll
    for (int ks = 0; ks < 8; ++ks) cf[ks] = *(const LAS bf16x8*)(Ci + l * 272 + (16 * ks + 8 * hh) * 2);
    f32x16 gt[2];
#pragma unroll
    for (int sj = 0; sj < 2; ++sj) {
#pragma unroll
        for (int r = 0; r < 16; ++r) gt[sj][r] = 0.f;
#pragma unroll
        for (int ks = 0; ks < 8; ++ks) { const bf16x8 a = *(const LAS bf16x8*)(Bi + (32 * (2 * sh + sj) + l31) * 272 + (16 * ks + 8 * hh) * 2); gt[sj] = MFMA32(a, cf[ks], gt[sj]); }
    }
#pragma unroll 1
    for (int j = 0; j < 2; ++j) {
        const int h = 4 * g + 2 * hp + j;
        const LAS float* tb = tb0 + TBW * j;
        u32x2 zq[4];
#pragma unroll
        for (int v = 0; v < 4; ++v) zq[v] = *(const u32x2*)((const bf16*)(F.ws + WS_PROJ) + (size_t)geo_row(geo, geo.pos0 + F.wave * 16 + 4 * v + (F.lane >> 4)) * NPROJ + PC_ZM + h * 64 + 4 * (F.lane & 15));
        if (j == 0) s2_head_load(F, geo, ck, h + 1, H);
        const float dsk = F.in[IN_DSKIP + F.z][layer * 16 + h];
        const float acFl = tb[4 * l], acBl = tb[4 * l + 2];
        f32x16 accd[2];
#pragma unroll
        for (int r = 0; r < 16; ++r) { accd[0][r] = 0.f; accd[1][r] = 0.f; }
        if (has_in) {
#pragma unroll
            for (int pi = 0; pi < 2; ++pi) {
#pragma unroll
                for (int ks = 0; ks < 8; ++ks) { const bf16x8 sb = *(const LAS bf16x8*)(Si + sh * (64 * 272) + (32 * pi + l31) * 272 + (16 * ks + 8 * hh) * 2); accd[pi] = MFMA32(cf[ks], sb, accd[pi]); }
#pragma unroll
                for (int r = 0; r < 16; ++r) accd[pi][r] *= tb[512 + sh * 128 + 32 * li + crow(r, hh)];
            }
        }
#pragma unroll
        for (int sj = 0; sj < 2; ++sj) {
            const int si = 2 * sh + sj;
            float m[16];
            if (si != li) {
                const int dofs = si < li ? 0 : 128;
                const float f2 = si < li ? __expf(tb[4 * (32 * li)] - tb[4 * (32 * si + 31)]) : __expf(tb[4 * (32 * li + 31) + 2] - tb[4 * (32 * si) + 2]);
                const float c = tb[1280 + dofs + l] * f2;
#pragma unroll
                for (int q4 = 0; q4 < 4; ++q4) { const f32x4 gs = *(const LAS f32x4*)(tb + 1024 + dofs + 32 * si + 8 * q4 + 4 * hh);
                    m[4 * q4] = gt[sj][4 * q4] * (c * gs.x); m[4 * q4 + 1] = gt[sj][4 * q4 + 1] * (c * gs.y); m[4 * q4 + 2] = gt[sj][4 * q4 + 2] * (c * gs.z); m[4 * q4 + 3] = gt[sj][4 * q4 + 3] * (c * gs.w); }
            } else {
#pragma unroll
                for (int r = 0; r < 16; ++r) {
                    const int s = 32 * si + crow(r, hh);
                    const f32x4 ts = *(const LAS f32x4*)(tb + 4 * s);
                    const float wf = __expf(fminf(acFl - ts.x, 0.f)) * ts.y, wb = __expf(fminf(acBl - ts.z, 0.f)) * ts.w;
                    const float w = l > s ? wf : (l < s ? wb : ts.y + ts.w);
                    m[r] = gt[sj][r] * w + (l == s ? dsk : 0.f);
                }
            }
#pragma unroll
            for (int t = 0; t < 2; ++t) {
                const bf16x8 ma = pack8(m[8 * t], m[8 * t + 1], m[8 * t + 2], m[8 * t + 3], m[8 * t + 4], m[8 * t + 5], m[8 * t + 6], m[8 * t + 7]);
                const int r0 = 32 * si + 16 * t + 4 * hh;
#pragma unroll
                for (int pi = 0; pi < 2; ++pi) { const bf16x8 xb = tr2(Xi, 192, r0, r0 + 8, 32 * pi, F.lane); accd[pi] = MFMA32(ma, xb, accd[pi]); }
            }
        }
        __syncthreads();
#pragma unroll
        for (int pi = 0; pi < 2; ++pi)
#pragma unroll
            for (int r = 0; r < 16; ++r) *(LAS float*)(stg + sh * (128 * 272) + (32 * li + crow(r, hh)) * 272 + (32 * pi + l31) * 4) = accd[pi][r];
        if (j == 0) s2_head_store(F, H, Xi, Si);
        __syncthreads();
        const int c4 = F.lane & 15;
        const f32x4 nw = *(const f32x4*)(F.in[IN_SSMNW + F.z] + layer * D + h * 64 + 4 * c4);
#pragma unroll
        for (int v = 0; v < 4; ++v) {
            const int lr = F.wave * 16 + 4 * v + (F.lane >> 4);
            const f32x4 y0 = *(const LAS f32x4*)(stg + lr * 272 + c4 * 16), y1 = *(const LAS f32x4*)(stg + 128 * 272 + lr * 272 + c4 * 16);
            const int row = geo_row(geo, geo.pos0 + lr);
            const u32x2 zr = zq[v];
            f32x4 y = y0 + y1;
            y.x *= bf2f(zr.x & 0xffffu); y.y *= bf2f(zr.x >> 16); y.z *= bf2f(zr.y & 0xffffu); y.w *= bf2f(zr.y >> 16);
            float q = (y.x * y.x + y.y * y.y) + (y.z * y.z + y.w * y.w);
            q += shfl_x(q, 1, F.lane); q += shfl_x(q, 2, F.lane); q += shfl_x(q, 4, F.lane); q += shfl_x(q, 8, F.lane);
            if (c4 == 0) atomicAdd(SSQ + row, q);
            y = y * nw;
            u32x2 o; o.x = pkbf(y.x, y.y); o.y = pkbf(y.z, y.w);
            *(u32x2*)(AM + (size_t)row * 2048 + h * 64 + 4 * c4) = o;
        }
        if (j == 0) __syncthreads();
    }
}

DEV void gmlp_unit(Frame& F, int layer, int vb) {
    LAS unsigned char* Vi = F.lds;
    LAS unsigned char* stg = F.lds + 128 * 320;
    LAS unsigned char* Wi = stg + 128 * 528;
    const bf16* proj = (const bf16*)(F.ws + WS_PROJ);
    const float* gsum = (const float*)(F.ws + WS_CTL + CTL_GSUM) + (size_t)layer * NTOK * 2;
    bf16* ag = (bf16*)(F.ws + WS_AMG) + 1024;
    const int hh = F.lane >> 5, ti = F.wave >> 1, cj = F.wave & 1, l31 = F.lane & 31;
    {
        const int ck = vb >> 3, g = vb & 7;
        u32x2 uq[8];
#pragma unroll
        for (int v = 0; v < 8; ++v) { const size_t ro = (size_t)(ck * 128 + F.wave * 16 + 2 * v + hh) * NPROJ + g * 128 + 4 * l31; uq[v] = *(const u32x2*)(proj + ro + PC_U); }
        {
            const bf16* wsrc = (const bf16*)(F.ws + WS_WSPB) + (size_t)(layer * 8 + g) * 128 * 128;
            const int ch = F.tid & 15, r0 = F.tid >> 4;
            u32x4 wq[4];
#pragma unroll
            for (int p = 0; p < 4; ++p) wq[p] = *(const u32x4*)(wsrc + (size_t)(r0 + 32 * p) * 128 + ch * 8);
#pragma unroll
            for (int p = 0; p < 4; ++p) *(LAS u32x4*)(Wi + (r0 + 32 * p) * 272 + ch * 16) = wq[p];
        }
        {
            const int s = F.tid >> 2, c0 = (F.tid & 3) * 32, row = ck * 128 + s;
            const float mu = gsum[row * 2] * (1.f / D), rstd = rsqrtf(fmaxf(gsum[row * 2 + 1] * (1.f / D) - mu * mu, 0.f) + EPS);
#pragma unroll
            for (int j = 0; j < 4; ++j) {
                const u32x4 r = *(const u32x4*)(proj + (size_t)row * NPROJ + PC_V + g * 128 + c0 + 8 * j);
                float v[8] = {bf2f(r.x & 0xffffu), bf2f(r.x >> 16), bf2f(r.y & 0xffffu), bf2f(r.y >> 16), bf2f(r.z & 0xffffu), bf2f(r.z >> 16), bf2f(r.w & 0xffffu), bf2f(r.w >> 16)};
#pragma unroll
                for (int c = 0; c < 8; ++c) v[c] = (v[c] - mu) * rstd;
                u32x4 o; o.x = pkbf(v[0], v[1]); o.y = pkbf(v[2], v[3]); o.z = pkbf(v[4], v[5]); o.w = pkbf(v[6], v[7]);
                *(LAS u32x4*)(Vi + s * 320 + (c0 + 8 * j) * 2) = o;
            }
        }
        __syncthreads();
        f32x16 acc[2];
#pragma unroll
        for (int r = 0; r < 16; ++r) { acc[0][r] = 0.f; acc[1][r] = 0.f; }
#pragma unroll
        for (int ks = 0; ks < 8; ++ks) {
            const int k0 = 16 * ks + 8 * hh;
            const bf16x8 a = *(const LAS bf16x8*)(Wi + (32 * ti + l31) * 272 + k0 * 2);
#pragma unroll
            for (int c = 0; c < 2; ++c) { const bf16x8 b = tr2(Vi, 320, k0, k0 + 4, 64 * cj + 32 * c, F.lane); acc[c] = MFMA32(a, b, acc[c]); }
        }
#pragma unroll
        for (int c = 0; c < 2; ++c)
#pragma unroll
            for (int r = 0; r < 16; ++r) *(LAS float*)(stg + (32 * ti + crow(r, hh)) * 528 + (64 * cj + 32 * c + l31) * 4) = acc[c][r];
        __syncthreads();
        const float* bsp = F.in[IN_BSP + F.z] + (layer * 8 + g) * 128;
        const float* wrs = (const float*)(F.ws + WS_WSPR) + (layer * 8 + g) * 128;
        const f32x4 lw = *(const f32x4*)(F.in[IN_LNW + F.z] + layer * D + g * 128 + 4 * l31), lb = *(const f32x4*)(F.in[IN_LNB + F.z] + layer * D + g * 128 + 4 * l31);
#pragma unroll
        for (int v = 0; v < 8; ++v) {
            const int t = F.wave * 16 + 2 * v + hh, row = ck * 128 + t;
            const f32x4 sv = *(const LAS f32x4*)(stg + t * 528 + l31 * 16) * lw + lb * wrs[t] + bsp[t];
            const u32x2 ur = uq[v];
            u32x2 o;
            o.x = pkbf(bf2f(ur.x & 0xffffu) * sv.x, bf2f(ur.x >> 16) * sv.y);
            o.y = pkbf(bf2f(ur.y & 0xffffu) * sv.z, bf2f(ur.y >> 16) * sv.w);
            *(u32x2*)(ag + (size_t)row * 2048 + g * 128 + 4 * l31) = o;
        }
    }
}

constexpr int CW_QUEUE = 8192;
DEV void ph_queue(const Frame& F0, int layer, int which, int qidx, bool dummy) {
    Frame F = launder(F0);
    asm volatile("" : "+s"(layer));
    unsigned* head = (unsigned*)(F.ws + WS_CTL) + CW_QUEUE + 64 * qidx;
    volatile LAS unsigned* slot = (volatile LAS unsigned*)(F.lds + LDS_BYTES - 256) + 16;
    const int N = which == 0 ? 64 + 512 : 640 + 640;
    (void)head;
    int it = F.bid;
    while (it < N) {
        unsigned nxt = 0u;
        Frame Fi = launder(F);
        if (Fi.tid == 0) nxt = (unsigned)Fi.G + atomicAdd((unsigned*)(Fi.ws + WS_CTL) + CW_QUEUE + 64 * qidx, 1u);
        if (which == 0) {
            if (it < 64) s1_lat_unit(Fi, layer, it >> 5, (it >> 1) & 15, it & 1);
            else s1_ctx_unit(Fi, layer, (it - 64) >> 4, (it - 64) & 15);
        } else {
            if (it < 640) s2_unit(Fi, layer, it >> 3, (it >> 1) & 3, it & 1, dummy);
            else gmlp_unit(Fi, layer, it - 640);
        }
        __syncthreads();
        if (nxt != 0u) *slot = nxt;
        __syncthreads();
        it = (int)*slot;
    }
}

DEV void ph_dt(const Frame& F0, int layer) {
    Frame F = launder(F0);
    asm volatile("" : "+s"(layer));
    LAS unsigned char* Ai = F.lds;
    LAS unsigned char* Wi = F.lds + 40 * 2064;
    LAS float* red = (LAS float*)F.lds;
    const int hh = F.lane >> 5, l31 = F.lane & 31;
    unsigned* head = (unsigned*)(F.ws + WS_CTL) + CW_QUEUE + 64 * (16 + layer);
    volatile LAS unsigned* slot = (volatile LAS unsigned*)(F.lds + LDS_BYTES - 256) + 16;
    (void)head; (void)slot;
    for (int u = F.bid; u < NTOK / 40; u += F.G) {
        __syncthreads();
        {   const bf16* A = (const bf16*)(F.ws + WS_HBUF) + (size_t)u * 40 * D;
            const bf16* W = (const bf16*)(F.ws + WS_WDT) + (size_t)layer * 32 * 1024;
            u32x4 aq[10], wq[8];
#pragma unroll
            for (int j = 0; j < 10; ++j) { const int c = F.tid + 512 * j; aq[j] = *(const u32x4*)(A + (size_t)(c >> 7) * D + (c & 127) * 8); }
#pragma unroll
            for (int j = 0; j < 8; ++j) { const int c = F.tid + 512 * j; wq[j] = *(const u32x4*)(W + (size_t)(c >> 7) * 1024 + (c & 127) * 8); }
#pragma unroll
            for (int j = 0; j < 10; ++j) { const int c = F.tid + 512 * j; *(LAS u32x4*)(Ai + (c >> 7) * 2064 + (c & 127) * 16) = aq[j]; }
#pragma unroll
            for (int j = 0; j < 8; ++j) { const int c = F.tid + 512 * j; *(LAS u32x4*)(Wi + (c >> 7) * 2064 + (c & 127) * 16) = wq[j]; }
        }
        __syncthreads();
        f32x16 acc[2];
#pragma unroll
        for (int r = 0; r < 16; ++r) { acc[0][r] = 0.f; acc[1][r] = 0.f; }
#pragma unroll
        for (int ks = 0; ks < 8; ++ks) {
            const int kb = (128 * F.wave + 16 * ks + 8 * hh) * 2;
            const bf16x8 b = *(const LAS bf16x8*)(Wi + l31 * 2064 + kb);
            const bf16x8 a0 = *(const LAS bf16x8*)(Ai + l31 * 2064 + kb), a1 = *(const LAS bf16x8*)(Ai + (32 + l31) * 2064 + kb);
            acc[0] = MFMA32(a0, b, acc[0]); acc[1] = MFMA32(a1, b, acc[1]);
        }
        __syncthreads();
#pragma unroll
        for (int t = 0; t < 2; ++t)
#pragma unroll
            for (int r = 0; r < 16; ++r) red[((F.wave * 2 + t) * 32 + crow(r, hh)) * 32 + l31] = acc[t][r];
        __syncthreads();
        for (int o = F.tid; o < 40 * 32; o += 512) {
            const int r = o >> 5, j = o & 31, t = r >> 5, rr = r & 31;
            float v = 0.f;
#pragma unroll
            for (int w = 0; w < 8; ++w) v += red[((w * 2 + t) * 32 + rr) * 32 + j];
            const int row = u * 40 + r;
            const float rs = rsqrtf(((const float*)(F.ws + WS_CTL + CTL_SSQX))[(size_t)layer * NTOK + row] * (1.f / D) + EPS);
            const float swv = ((const float*)(F.ws + WS_CTL + CTL_SW))[(size_t)(layer * 3 + (row < NCTX ? 0 : 1 + ((row - NCTX) >> 10))) * DIN + 3072 + j];
            ((float*)(F.ws + WS_DTRAW))[(size_t)row * 32 + j] = v * rs + swv;
        }
    }
}

#define XB_TMO      128
#define XB_XCNT(j)  (256  + 64 * (j))
#define XB_XSUB(j)  (1280 + 64 * (j))
#define XB_XGEN(j)  (2304 + 64 * (j))
#define XB_TOP      3328
#define XB_TOPGEN   3392
#define XCD_BAR_WORDS 3456
#define XB_SPIN_CAP (1u << 18)

__device__ __forceinline__ unsigned xb_ld(unsigned* p)              { return __hip_atomic_load(p, __ATOMIC_RELAXED, __HIP_MEMORY_SCOPE_AGENT); }
__device__ __forceinline__ unsigned xb_add(unsigned* p, unsigned v) { return __hip_atomic_fetch_add(p, v, __ATOMIC_RELAXED, __HIP_MEMORY_SCOPE_AGENT); }
__device__ __forceinline__ unsigned xb_xcc_id() { return (unsigned)__builtin_amdgcn_s_getreg((3 << 11) | 20) & 0xFu; }
#define XB_SPIN(cond, bar) do { unsigned _sp = 0; while (cond) { __builtin_amdgcn_s_sleep(1); \
    if ((++_sp & 255u) == 0u) { if (xb_ld(&(bar)[XB_TMO])) break; if (_sp > XB_SPIN_CAP) { atomicAdd(&(bar)[XB_TMO], 1u); break; } } } } while (0)

struct XcdBarrier {
    unsigned* bar; unsigned x;
    volatile LAS unsigned* st;
};

__device__ __forceinline__ XcdBarrier xcd_barrier_post(unsigned* bar, volatile LAS unsigned* st) {
    XcdBarrier b; b.bar = bar; b.x = xb_xcc_id(); b.st = st;
    if (threadIdx.x == 0) (void)xb_add(&bar[XB_XCNT(b.x)], 1u);
    return b;
}
__device__ __forceinline__ void xcd_barrier_complete(unsigned* bar, unsigned x, unsigned& nloc, unsigned& nx) {
    const unsigned G = gridDim.x * gridDim.y * gridDim.z;
    unsigned sum, cnt, mine, sp = 0u;
    for (;;) {
        sum = 0u; cnt = 0u; mine = 0u;
#pragma unroll
        for (unsigned j = 0; j < 16; ++j) { const unsigned c = xb_ld(&bar[XB_XCNT(j)]); sum += c; cnt += (c > 0u) ? 1u : 0u; mine = (j == x) ? c : mine; }
        if (sum == G) break;
        __builtin_amdgcn_s_sleep(1);
        if ((++sp & 255u) == 0u) { if (xb_ld(&bar[XB_TMO])) break; if (sp > XB_SPIN_CAP) { atomicAdd(&bar[XB_TMO], 1u); break; } }
    }
    nloc = mine > 0u ? mine : 1u; nx = cnt > 0u ? cnt : 1u;
}

__device__ __forceinline__ void xcd_barrier(const XcdBarrier& b) {
    asm volatile("s_waitcnt vmcnt(0)" ::: "memory");
    __syncthreads();
    if (threadIdx.x == 0) {
        unsigned* bar = b.bar;
        __builtin_amdgcn_s_waitcnt(0);
        unsigned nloc = b.st[0], nx = b.st[1];
        if (nloc == 0u) { xcd_barrier_complete(bar, b.x, nloc, nx); b.st[0] = nloc; b.st[1] = nx; }
        const unsigned old = xb_add(&bar[XB_XSUB(b.x)], 1u);
        const unsigned gen = old / nloc;
        if (old + 1u == (gen + 1u) * nloc) {
            __builtin_amdgcn_fence(__ATOMIC_RELEASE, "agent");
            asm volatile("s_waitcnt vmcnt(0)" ::: "memory");
            const unsigned og = xb_add(&bar[XB_TOP], 1u);
            const unsigned tg = og / nx;
            if (og + 1u == (tg + 1u) * nx) xb_add(&bar[XB_TOPGEN], 1u);
            else XB_SPIN(xb_ld(&bar[XB_TOPGEN]) == tg, bar);
            __builtin_amdgcn_fence(__ATOMIC_ACQUIRE, "agent");
            xb_add(&bar[XB_XGEN(b.x)], 1u);
            asm volatile("s_waitcnt vmcnt(0)" ::: "memory");
        } else {
            XB_SPIN(xb_ld(&bar[XB_XGEN(b.x)]) == gen, bar);
            __builtin_amdgcn_fence(__ATOMIC_ACQUIRE, "agent");
            asm volatile("s_waitcnt vmcnt(0)" ::: "memory");
        }
    }
    __syncthreads();
}

struct EpiIn {
    static constexpr bool PERM = true, AFTER_DRAIN = false, HAS_MID = false;
    bf16* O; const float* ssqx; const float* sw; float* gsum;
    __device__ __forceinline__ void operator()(const f32x4 (&acc)[2][2][4][2], const pg8::Unit& u, int wr, int wc, int fr, int fq) const {
        int row0 = u.pm * 256 + wr * 64 + fr, cl = wc * 32 + 8 * fq;
        asm volatile("" : "+v"(row0), "+v"(cl));
        const int mv = u.pm < 32 ? 0 : 1 + ((u.pm - 32) >> 2);
        const int kind = u.pn < 8 ? 0 : u.pn < 12 ? 1 : u.pn < 20 ? 2 : u.pn < 24 ? 3 : 4;
        int nat[2], oc[2];
        if (u.pn < 12) { nat[0] = u.pn * 256; nat[1] = nat[0] + 128; oc[0] = nat[0]; oc[1] = nat[1]; }
        else if (u.pn < 20) { nat[0] = 3104 + (u.pn - 12) * 128; nat[1] = 5152 + (u.pn - 12) * 128; oc[0] = PC_U + (u.pn - 12) * 128; oc[1] = oc[0]; }
        else if (u.pn < 24) { nat[0] = 4128 + (u.pn - 20) * 256; nat[1] = nat[0] + 128; oc[0] = PC_V + (u.pn - 20) * 256; oc[1] = oc[0] + 128; }
        else { nat[0] = 6176 + (u.pn - 24) * 128; nat[1] = 7200 + (u.pn - 24) * 128; oc[0] = PC_GLM + (u.pn - 24) * 128; oc[1] = PC_GLG + (u.pn - 24) * 128; }
        f32x4 bv[2][2];
#pragma unroll
        for (int bj = 0; bj < 2; ++bj)
#pragma unroll
            for (int n = 0; n < 2; ++n) bv[bj][n] = *(const f32x4*)(sw + mv * DIN + nat[bj] + cl + 4 * n);
        float rs8[8];
#pragma unroll
        for (int i = 0; i < 8; ++i) rs8[i] = ssqx[row0 + (i >> 2) * 128 + (i & 3) * 16];
#pragma unroll
        for (int i = 0; i < 8; ++i) rs8[i] = rsqrtf(rs8[i] * (1.f / D) + EPS);
#pragma unroll
        for (int ai = 0; ai < 2; ++ai)
#pragma unroll
            for (int m = 0; m < 4; ++m) {
                const int r = row0 + ai * 128 + m * 16;
                const float rs = rs8[ai * 4 + m];
                float v[2][8];
#pragma unroll
                for (int bj = 0; bj < 2; ++bj)
#pragma unroll
                    for (int j = 0; j < 4; ++j) { v[bj][j] = acc[ai][bj][m][0][j] * rs + bv[bj][0][j]; v[bj][4 + j] = acc[ai][bj][m][1][j] * rs + bv[bj][1][j]; }
                if (kind == 2) {
#pragma unroll
                    for (int j = 0; j < 8; ++j) v[0][j] = gelu_f(v[0][j]) * silu_f(v[1][j]);
                    u32x4 w; w.x = pkbf(v[0][0], v[0][1]); w.y = pkbf(v[0][2], v[0][3]); w.z = pkbf(v[0][4], v[0][5]); w.w = pkbf(v[0][6], v[0][7]);
                    *(u32x4*)(O + (size_t)r * NPROJ + oc[0] + cl) = w;
                } else {
                    float s1 = 0.f, s2 = 0.f;
                    if (kind == 4) {
#pragma unroll
                        for (int j = 0; j < 8; ++j) { const float em = __expf(-v[0][j]), eg = __expf(-v[1][j]); v[1][j] = __builtin_amdgcn_rcpf(1.f + eg); v[0][j] = (1.f + eg) * __builtin_amdgcn_rcpf(1.f + em); }
                    }
#pragma unroll
                    for (int bj = 0; bj < 2; ++bj) {
                        if (kind == 1) {
#pragma unroll
                            for (int j = 0; j < 8; ++j) v[bj][j] = silu_f(v[bj][j]);
                        } else if (kind == 3) {
#pragma unroll
                            for (int j = 0; j < 8; ++j) { v[bj][j] = gelu_f(v[bj][j]); s1 += v[bj][j]; s2 += v[bj][j] * v[bj][j]; }
                        }
                        u32x4 w; w.x = pkbf(v[bj][0], v[bj][1]); w.y = pkbf(v[bj][2], v[bj][3]); w.z = pkbf(v[bj][4], v[bj][5]); w.w = pkbf(v[bj][6], v[bj][7]);
                        *(u32x4*)(O + (size_t)r * NPROJ + oc[bj] + cl) = w;
                    }
                    if (kind == 3) {
                        const int ln = fr + 16 * fq; s1 += shfl_x(s1, 16, ln); s1 += shfl_x(s1, 32, ln); s2 += shfl_x(s2, 16, ln); s2 += shfl_x(s2, 32, ln);
                        if (fq == 0) { atomicAdd(gsum + 2 * r, s1); atomicAdd(gsum + 2 * r + 1, s2); }
                    }
                }
            }
    }
};
struct EpiMerge {
    static constexpr bool PERM = true, AFTER_DRAIN = false, HAS_MID = true;
    bf16* O; const bf16* proj; const float* ssq;
    __device__ __forceinline__ void mid(f32x4 (&acc)[2][2][4][2], const pg8::Unit& u, int wr, int wc, int fr, int fq) const {
        int row0 = u.pm * 256 + wr * 64 + fr, col0 = u.pn * 256 + wc * 32 + 8 * fq;
        asm volatile("" : "+v"(row0), "+v"(col0));
        u32x4 g[8][2]; float rs8[8];
#pragma unroll
        for (int i = 0; i < 8; ++i) { const int r = row0 + (i >> 2) * 128 + (i & 3) * 16; rs8[i] = ssq[r];
#pragma unroll
            for (int bj = 0; bj < 2; ++bj) g[i][bj] = *(const u32x4*)(proj + (size_t)r * NPROJ + PC_GLM + col0 + bj * 128); }
#pragma unroll
        for (int i = 0; i < 8; ++i) { const int ai = i >> 2, m = i & 3; const float rs = rsqrtf(rs8[i] * (1.f / D) + EPS);
#pragma unroll
            for (int bj = 0; bj < 2; ++bj) { const u32x4 q = g[i][bj];
                acc[ai][bj][m][0][0] *= bf2f(q.x & 0xffffu) * rs; acc[ai][bj][m][0][1] *= bf2f(q.x >> 16) * rs; acc[ai][bj][m][0][2] *= bf2f(q.y & 0xffffu) * rs; acc[ai][bj][m][0][3] *= bf2f(q.y >> 16) * rs;
                acc[ai][bj][m][1][0] *= bf2f(q.z & 0xffffu) * rs; acc[ai][bj][m][1][1] *= bf2f(q.z >> 16) * rs; acc[ai][bj][m][1][2] *= bf2f(q.w & 0xffffu) * rs; acc[ai][bj][m][1][3] *= bf2f(q.w >> 16) * rs; } }
    }
    __device__ __forceinline__ void operator()(const f32x4 (&acc)[2][2][4][2], const pg8::Unit& u, int wr, int wc, int fr, int fq) const {
        int row0 = u.pm * 256 + wr * 64 + fr, col0 = u.pn * 256 + wc * 32 + 8 * fq;
        asm volatile("" : "+v"(row0), "+v"(col0));
        u32x4 g[8][2];
#pragma unroll
        for (int i = 0; i < 8; ++i) { const int r = row0 + (i >> 2) * 128 + (i & 3) * 16;
#pragma unroll
            for (int bj = 0; bj < 2; ++bj) g[i][bj] = *(const u32x4*)(proj + (size_t)r * NPROJ + PC_GLG + col0 + bj * 128); }
#pragma unroll
        for (int i = 0; i < 8; ++i) { const int ai = i >> 2, m = i & 3, r = row0 + ai * 128 + m * 16;
#pragma unroll
            for (int bj = 0; bj < 2; ++bj) { const u32x4 q = g[i][bj]; u32x4 w;
                w.x = pkbf(acc[ai][bj][m][0][0] * bf2f(q.x & 0xffffu), acc[ai][bj][m][0][1] * bf2f(q.x >> 16));
                w.y = pkbf(acc[ai][bj][m][0][2] * bf2f(q.y & 0xffffu), acc[ai][bj][m][0][3] * bf2f(q.y >> 16));
                w.z = pkbf(acc[ai][bj][m][1][0] * bf2f(q.z & 0xffffu), acc[ai][bj][m][1][1] * bf2f(q.z >> 16));
                w.w = pkbf(acc[ai][bj][m][1][2] * bf2f(q.w & 0xffffu), acc[ai][bj][m][1][3] * bf2f(q.w >> 16));
                *(u32x4*)(O + (size_t)r * D + col0 + bj * 128) = w; } }
    }
};
struct EpiOut {
    static constexpr bool PERM = true, AFTER_DRAIN = false, HAS_MID = false;
    const float* xp; const float* xs; const float* xold; float* xnew; bf16* hx; const float* mod; const float* gn; float* ssqn;
    __device__ __forceinline__ void operator()(const f32x4 (&acc)[2][2][4][2], const pg8::Unit& u, int wr, int wc, int fr, int fq) const {
        int row0 = u.pm * 256 + wr * 64 + fr, col0 = u.pn * 256 + wc * 32 + 8 * fq;
        asm volatile("" : "+v"(row0), "+v"(col0));
        const int mv = u.pm < 32 ? 0 : 1 + ((u.pm - 32) >> 2);
        const float* xo = xold ? xold : (u.pm < 32 ? xp : xs - (size_t)NCTX * D);
        const float* gate = mod + mv * 3072 + 2048 + col0;
        f32x4 ga[2][2];
#pragma unroll
        for (int bj = 0; bj < 2; ++bj)
#pragma unroll
            for (int n = 0; n < 2; ++n) ga[bj][n] = *(const f32x4*)(gate + bj * 128 + 4 * n);
#pragma unroll
        for (int ai = 0; ai < 2; ++ai) {
            f32x4 x[4][2][2];
#pragma unroll
            for (int m = 0; m < 4; ++m)
#pragma unroll
                for (int bj = 0; bj < 2; ++bj)
#pragma unroll
                    for (int n = 0; n < 2; ++n) x[m][bj][n] = *(const f32x4*)(xo + (size_t)(row0 + ai * 128 + m * 16) * D + col0 + bj * 128 + 4 * n);
#pragma unroll
            for (int m = 0; m < 4; ++m) {
                const int r = row0 + ai * 128 + m * 16;
                float q = 0.f;
#pragma unroll
                for (int bj = 0; bj < 2; ++bj) {
                    const size_t off = (size_t)r * D + col0 + bj * 128;
                    const f32x4 n0 = x[m][bj][0] + ga[bj][0] * acc[ai][bj][m][0], n1 = x[m][bj][1] + ga[bj][1] * acc[ai][bj][m][1];
                    *(f32x4*)(xnew + off) = n0; *(f32x4*)(xnew + off + 4) = n1;
                    q += (n0.x * n0.x + n0.y * n0.y) + (n0.z * n0.z + n0.w * n0.w) + (n1.x * n1.x + n1.y * n1.y) + (n1.z * n1.z + n1.w * n1.w);
                    if (gn) { const f32x4 h0 = n0 * *(const f32x4*)(gn + mv * 1024 + col0 + bj * 128), h1 = n1 * *(const f32x4*)(gn + mv * 1024 + col0 + bj * 128 + 4);
                        u32x4 w; w.x = pkbf(h0.x, h0.y); w.y = pkbf(h0.z, h0.w); w.z = pkbf(h1.x, h1.y); w.w = pkbf(h1.z, h1.w);
                        *(u32x4*)(hx + off) = w; }
                }
                { const int ln = fr + 16 * fq; q += shfl_x(q, 16, ln); q += shfl_x(q, 32, ln); }
                if (fq == 0) atomicAdd(ssqn + r, q);
            }
            asm volatile("" ::: "memory");
        }
    }
};

constexpr int CW_BAR = 4096;
constexpr int MISC_OFF = LDS_BYTES - 256;

__global__ void __launch_bounds__(512, 2) mega(Args args) {
    extern __shared__ __attribute__((aligned(16))) unsigned char lds[];
    Frame F;
    F.lds = (LAS unsigned char*)lds; F.tid = threadIdx.x; F.lane = F.tid & 63; F.wave = __builtin_amdgcn_readfirstlane(F.tid >> 6);
    F.G = gridDim.x; F.bid = blockIdx.x; F.in = args.in; F.out = args.out; F.ws = args.ws; F.z = 0;
    volatile LAS unsigned* MISC = (volatile LAS unsigned*)(F.lds + MISC_OFF);
    if (F.tid < 64) MISC[F.tid] = 0u;
    __syncthreads();
    (void)xcd_barrier_post((unsigned*)(F.ws + WS_CTL) + CW_BAR, MISC + 8);
#define GRID_BAR() do { Frame Fb = launder(F); XcdBarrier b_; b_.bar = (unsigned*)(Fb.ws + WS_CTL) + CW_BAR; b_.x = xb_xcc_id(); b_.st = (volatile LAS unsigned*)(Fb.lds + MISC_OFF) + 8; xcd_barrier(b_); } while (0)
    ph_mod(F); GRID_BAR();
    ph_cvt(F, 0, 0, F.G); ph_gn(F); ph_prep0(F); GRID_BAR();
    for (int layer = 0; layer < DEPTH; ++layer) {
        { Frame Fg = launder(F);
          pg8::Gemm g{(const bf16*)(Fg.ws + WS_HBUF), (const bf16*)(Fg.ws + WS_WIN) + (size_t)layer * NPROJ * 1024, NTOK, NPROJ, D};
          pg8::StaticOrder S; S.init(NTOK, NPROJ, Fg.G, Fg.bid);
          EpiIn E{(bf16*)(Fg.ws + WS_PROJ), (const float*)(Fg.ws + WS_CTL + CTL_SSQX) + (size_t)layer * NTOK, (const float*)(Fg.ws + WS_CTL + CTL_SW) + (size_t)layer * 3 * DIN,
                  (float*)(Fg.ws + WS_CTL + CTL_GSUM) + (size_t)layer * NTOK * 2};
          pg8::gemm_phase<EpiIn, pg8::StaticOrder, true, true>(Fg.lds, g, S, E, Fg.wave); }
        ph_dt(F, layer);
        GRID_BAR();
        ph_b0(F, layer); GRID_BAR();
        if (DUP_MASK & 1) { ph_b0(F, layer); GRID_BAR(); }
        ph_queue(F, layer, 0, layer, false); GRID_BAR();
        if (DUP_MASK & 2) { ph_queue(F, layer, 0, 8 + layer, false); GRID_BAR(); }
        ph_queue(F, layer, 1, 4 + layer, false); GRID_BAR();
        if (DUP_MASK & 4) { ph_queue(F, layer, 1, 12 + layer, true); GRID_BAR(); }
        { Frame Fg = launder(F);
          pg8::Gemm g{(const bf16*)(Fg.ws + WS_AMG), (const bf16*)(Fg.ws + WS_WMG) + (size_t)layer * 1024 * 2048, NTOK, D, 2048};
          pg8::StaticOrder S; S.init(NTOK, D, Fg.G, Fg.bid);
          EpiMerge E{(bf16*)(Fg.ws + WS_MRG), (const bf16*)(Fg.ws + WS_PROJ), (const float*)(Fg.ws + WS_CTL + CTL_SSQ) + (size_t)layer * NTOK};
          pg8::gemm_phase<EpiMerge, pg8::StaticOrder, true, true>(Fg.lds, g, S, E, Fg.wave); }
        if (layer + 1 < DEPTH) ph_cvt(F, layer + 1, 160, F.G - 160);
        GRID_BAR();
        { Frame Fg = launder(F);
          pg8::Gemm g{(const bf16*)(Fg.ws + WS_MRG), (const bf16*)(Fg.ws + WS_WO) + (size_t)layer * 1024 * 1024, NTOK, D, D};
          pg8::StaticOrder S; S.init(NTOK, D, Fg.G, Fg.bid);
          EpiOut E{Fg.in[IN_XP + Fg.z], Fg.in[IN_XS + Fg.z], layer == 0 ? nullptr : (const float*)(Fg.ws + WS_XBUF), (float*)(Fg.ws + WS_XBUF), (bf16*)(Fg.ws + WS_HBUF),
                   (const float*)(Fg.ws + WS_MOD) + (size_t)layer * 3 * 3072, layer + 1 < DEPTH ? (const float*)(Fg.ws + WS_GN) + (size_t)(layer + 1) * 3 * 1024 : nullptr,
                   (float*)(Fg.ws + WS_CTL + CTL_SSQX) + (size_t)(layer + 1) * NTOK};
          pg8::gemm_phase<EpiOut, pg8::StaticOrder, true, true>(Fg.lds, g, S, E, Fg.wave); }
        GRID_BAR();
    }
    ph_final(F);
}

extern "C" void kernel_launch(void* const* d_in, const int* in_sizes, int n_in, void* d_out, int out_size, void* d_ws, size_t ws_size, hipStream_t stream) {
    static int grid = 0;
    if (grid == 0) {
        if (n_in != 23 || ws_size < WS_END) { fprintf(stderr, "kernel_launch: need 23 inputs and %zu bytes of workspace; got %d, %zu\n", (size_t)WS_END, n_in, ws_size); grid = -1; return; }
        int dev = 0, cus = 0;
        if (hipGetDevice(&dev) != hipSuccess || hipDeviceGetAttribute(&cus, hipDeviceAttributeMultiprocessorCount, dev) != hipSuccess) { grid = -1; return; }
        if (hipFuncSetAttribute((const void*)mega, hipFuncAttributeMaxDynamicSharedMemorySize, LDS_BYTES) != hipSuccess) { fprintf(stderr, "kernel_launch: hipFuncSetAttribute failed\n"); grid = -1; return; }
        grid = cus;
    }
    if (grid < 0) return;
    if (hipMemsetAsync((char*)d_ws + WS_CTL, 0, CTL_BYTES, stream) != hipSuccess) return;
    Args a{};
    for (int i = 0; i < 23; ++i) a.in[i] = (const float*)d_in[i];
    a.out = (float*)d_out; a.ws = (unsigned char*)d_ws;
    hipLaunchKernelGGL(mega, dim3(grid), dim3(512), LDS_BYTES, stream, a);
}
```
